# Optimizing an MI355X kernel written in HIP

```python
import jax
import jax.numpy as jnp
from jax import lax
import numpy as np

D_MODEL = 4096
BATCH = 8
SEQ = 2048
DEPTH = 2

HEAD_DIM = 128
N_HEADS_TOTAL = D_MODEL // HEAD_DIM
MLA_HEADS = N_HEADS_TOTAL // 4
MLA_Q_LORA = D_MODEL // 4
MLA_KV_LORA = D_MODEL // 8
MLA_NOPE_DIM = 128
MLA_ROPE_DIM = 64
MLA_V_DIM = 128
MLA_QK_DIM = MLA_NOPE_DIM + MLA_ROPE_DIM
ROPE_THETA = 10000.0
SWA_HEADS = N_HEADS_TOTAL // 2
SWA_KV_HEADS = max(1, SWA_HEADS // 8)
WINDOW = 128
FOX_HEADS = N_HEADS_TOTAL // 4
Q_BLOCK = 128
N_BRANCH = 3
FFN_HIDDEN = ((8 * D_MODEL // 3 + 255) // 256) * 256
RMS_EPS = 1e-6
MAX_POS_OFFSET = 1024

IN_SPLITS = (
    MLA_Q_LORA,
    MLA_KV_LORA,
    MLA_ROPE_DIM,
    SWA_HEADS * HEAD_DIM,
    SWA_KV_HEADS * HEAD_DIM,
    SWA_KV_HEADS * HEAD_DIM,
    FOX_HEADS * HEAD_DIM,
    FOX_HEADS * HEAD_DIM,
    FOX_HEADS * HEAD_DIM,
    FOX_HEADS,
    N_BRANCH * D_MODEL,
)
IN_WIDTH = sum(IN_SPLITS)
MLA_OUT = MLA_HEADS * MLA_V_DIM
SWA_OUT = SWA_HEADS * HEAD_DIM
FOX_OUT = FOX_HEADS * HEAD_DIM
MIX_WIDTH = MLA_OUT + SWA_OUT + FOX_OUT

kernel_name = "hybrid_mla_swa_fox_gated_block"


def rms_norm(x, gain):
    xf = x.astype(jnp.float32)
    y = xf * lax.rsqrt(jnp.mean(xf * xf, axis=-1, keepdims=True) + RMS_EPS)
    return (y * gain.astype(jnp.float32)).astype(x.dtype)


def split_points():
    pts, acc = [], 0
    for s in IN_SPLITS[:-1]:
        acc += s
        pts.append(acc)
    return pts


def apply_rope(x, positions):
    half = x.shape[-1] // 2
    inv_freq = ROPE_THETA ** (-jnp.arange(half, dtype=jnp.float32) / half)
    ang = positions.astype(jnp.float32)[..., None] * inv_freq
    cos = jnp.cos(ang)[:, :, None, :]
    sin = jnp.sin(ang)[:, :, None, :]
    xf = x.astype(jnp.float32)
    x1, x2 = xf[..., :half], xf[..., half:]
    out = jnp.concatenate([x1 * cos - x2 * sin, x2 * cos + x1 * sin], axis=-1)
    return out.astype(x.dtype)


def alibi_slopes(n_heads):
    return 2.0 ** (-8.0 * jnp.arange(1, n_heads + 1, dtype=jnp.float32) / n_heads)


def causal_block_attention(q, k, v, scale, log_decay=None):
    B, S, H, _ = q.shape
    nb = S // Q_BLOCK
    qb = jnp.moveaxis(q.reshape(B, nb, Q_BLOCK, H, -1), 1, 0)
    key_idx = jnp.arange(S)

    def attend(blk, qi, fq):
        s = jnp.einsum("bqhd,bshd->bhqs", qi, k).astype(jnp.float32) * scale
        if fq is not None:
            s = s + jnp.transpose(fq, (0, 2, 1))[..., None] - fk
        q_idx = blk * Q_BLOCK + jnp.arange(Q_BLOCK)
        s = jnp.where(key_idx[None, :] <= q_idx[:, None], s, -jnp.inf)
        p = jax.nn.softmax(s, axis=-1)
        return jnp.einsum("bhqs,bshd->bqhd", p.astype(v.dtype), v)

    blocks = jnp.arange(nb)
    if log_decay is None:
        out = lax.map(lambda a: attend(a[0], a[1], None), (blocks, qb))
    else:
        ld = log_decay.astype(jnp.float32)
        fk = jnp.transpose(ld, (0, 2, 1))[:, :, None, :]
        fqb = jnp.moveaxis(ld.reshape(B, nb, Q_BLOCK, H), 1, 0)
        out = lax.map(lambda a: attend(a[0], a[1], a[2]), (blocks, qb, fqb))
    return jnp.moveaxis(out, 0, 1).reshape(B, S, -1)


def sliding_window_attention(q, k, v, positions, sinks, slopes):
    B, S, H, Dh = q.shape
    KVH = k.shape[2]
    G = H // KVH
    nb = S // WINDOW
    qb = q.reshape(B, nb, WINDOW, KVH, G, Dh)

    def with_prev(t):
        tb = t.reshape((B, nb, WINDOW) + t.shape[2:])
        prev = jnp.concatenate([jnp.zeros_like(tb[:, :1]), tb[:, :-1]], axis=1)
        return jnp.concatenate([prev, tb], axis=2)

    kw, vw, pw = with_prev(k), with_prev(v), with_prev(positions)
    qpos = positions.reshape(B, nb, WINDOW)
    s = jnp.einsum("bnqkgd,bnskd->bnkgqs", qb, kw).astype(jnp.float32) * (Dh ** -0.5)
    i = jnp.arange(WINDOW)[:, None]
    j = jnp.arange(2 * WINDOW)[None, :]
    d_idx = i + WINDOW - j
    blk = jnp.arange(nb)[:, None, None]
    valid = (d_idx >= 0) & (d_idx < WINDOW) & ((blk > 0) | (j >= WINDOW))
    dist = (qpos[:, :, :, None] - pw[:, :, None, :]).astype(jnp.float32)
    m_h = slopes.reshape(KVH, G)[None, None, :, :, None, None]
    s = s - m_h * dist[:, :, None, None]
    s = jnp.where(valid[None, :, None, None], s, -jnp.inf)
    sink = sinks.astype(jnp.float32).reshape(KVH, G)[None, None, :, :, None, None]
    mx = jnp.maximum(jnp.max(s, axis=-1, keepdims=True), sink)
    e = jnp.exp(s - mx)
    p = e / (jnp.sum(e, axis=-1, keepdims=True) + jnp.exp(sink - mx))
    o = jnp.einsum("bnkgqs,bnskd->bnqkgd", p.astype(v.dtype), vw)
    return o.reshape(B, S, H * Dh)


def hybrid_mixer(h, positions, w_in, g_q_lora, w_uq, g_kv_lora, w_ukv, b_forget, swa_sinks, w_branch, w_out):
    B, S, _ = h.shape
    proj = h @ w_in
    (cq, ckv, kr, q_swa, k_swa, v_swa, q_fox, k_fox, v_fox, z_fox, gate_logits) = jnp.split(
        proj, split_points(), axis=-1)

    q = (rms_norm(cq, g_q_lora) @ w_uq).reshape(B, S, MLA_HEADS, MLA_QK_DIM)
    q = jnp.concatenate([q[..., :MLA_NOPE_DIM], apply_rope(q[..., MLA_NOPE_DIM:], positions)], axis=-1)
    kv = (rms_norm(ckv, g_kv_lora) @ w_ukv).reshape(B, S, MLA_HEADS, MLA_NOPE_DIM + MLA_V_DIM)
    k_nope, v = kv[..., :MLA_NOPE_DIM], kv[..., MLA_NOPE_DIM:]
    k_rope = apply_rope(kr[:, :, None, :], positions)
    k = jnp.concatenate([k_nope, jnp.broadcast_to(k_rope, (B, S, MLA_HEADS, MLA_ROPE_DIM))], axis=-1)
    o_mla = causal_block_attention(q, k, v, MLA_QK_DIM ** -0.5)

    o_swa = sliding_window_attention(
        q_swa.reshape(B, S, SWA_HEADS, HEAD_DIM),
        k_swa.reshape(B, S, SWA_KV_HEADS, HEAD_DIM),
        v_swa.reshape(B, S, SWA_KV_HEADS, HEAD_DIM),
        positions, swa_sinks, alibi_slopes(SWA_HEADS))

    log_f = jax.nn.log_sigmoid((z_fox + b_forget).astype(jnp.float32))
    cum_log_f = lax.cumsum(log_f, axis=1)
    o_fox = causal_block_attention(
        q_fox.reshape(B, S, FOX_HEADS, HEAD_DIM),
        k_fox.reshape(B, S, FOX_HEADS, HEAD_DIM),
        v_fox.reshape(B, S, FOX_HEADS, HEAD_DIM),
        HEAD_DIM ** -0.5, log_decay=cum_log_f)

    gates = jax.nn.sigmoid(gate_logits).reshape(B, S, N_BRANCH, D_MODEL)
    r1 = MLA_OUT
    r2 = MLA_OUT + SWA_OUT
    merged = (gates[:, :, 0] * (o_mla @ w_branch[:r1])
              + gates[:, :, 1] * (o_swa @ w_branch[r1:r2])
              + gates[:, :, 2] * (o_fox @ w_branch[r2:]))
    return merged @ w_out


def setup_inputs(seed: int = 0) -> dict:
    key = jax.random.key(seed)
    ks = jax.random.split(key, 20)
    L, D = DEPTH, D_MODEL

    def normal(k, shape, scale):
        return jax.random.normal(k, shape, jnp.float32) * scale

    def gain(k, n):
        return 1.0 + 0.05 * jax.random.normal(k, (L, n), jnp.float32)

    x = normal(ks[0], (BATCH, SEQ, D), 1.0)
    offsets = jax.random.randint(ks[1], (BATCH, 1), 0, MAX_POS_OFFSET, dtype=jnp.int32)
    positions = offsets + jnp.arange(SEQ, dtype=jnp.int32)[None, :]
    return {
        "x": x,
        "positions": positions,
        "g_mix_pre": gain(ks[2], D),
        "g_mix_post": gain(ks[3], D),
        "g_ffn_pre": gain(ks[4], D),
        "g_ffn_post": gain(ks[5], D),
        "w_in": normal(ks[6], (L, D, IN_WIDTH), D ** -0.5),
        "g_q_lora": gain(ks[7], MLA_Q_LORA),
        "w_uq": normal(ks[8], (L, MLA_Q_LORA, MLA_HEADS * MLA_QK_DIM), MLA_Q_LORA ** -0.5),
        "g_kv_lora": gain(ks[9], MLA_KV_LORA),
        "w_ukv": normal(ks[10], (L, MLA_KV_LORA, MLA_HEADS * (MLA_NOPE_DIM + MLA_V_DIM)), MLA_KV_LORA ** -0.5),
        "b_forget": 2.0 + 0.5 * jax.random.normal(ks[11], (L, FOX_HEADS), jnp.float32),
        "swa_sinks": normal(ks[12], (L, SWA_HEADS), 0.5),
        "w_branch": normal(ks[13], (L, MIX_WIDTH, D), MIX_WIDTH ** -0.5),
        "w_out": normal(ks[14], (L, D, D), D ** -0.5),
        "w_gate_up": normal(ks[15], (L, D, 2 * FFN_HIDDEN), D ** -0.5),
        "w_down": normal(ks[16], (L, FFN_HIDDEN, D), FFN_HIDDEN ** -0.5),
    }


def reference(x, positions, g_mix_pre, g_mix_post, g_ffn_pre, g_ffn_post, w_in, g_q_lora, w_uq,
              g_kv_lora, w_ukv, b_forget, swa_sinks, w_branch, w_out, w_gate_up, w_down):
    for l in range(DEPTH):
        h = rms_norm(x, g_mix_pre[l])
        m = hybrid_mixer(h, positions, w_in[l], g_q_lora[l], w_uq[l], g_kv_lora[l], w_ukv[l],
                         b_forget[l], swa_sinks[l], w_branch[l], w_out[l])
        x = x + rms_norm(m, g_mix_post[l])
        h = rms_norm(x, g_ffn_pre[l])
        gate, up = jnp.split(h @ w_gate_up[l], 2, axis=-1)
        x = x + rms_norm((jax.nn.silu(gate) * up) @ w_down[l], g_ffn_post[l])
    return x
```

```cpp
#include <hip/hip_runtime.h>
#include <cstdio>
#include <cstdint>
namespace pg8 {
#define PG8_LAS __attribute__((address_space(3)))
typedef unsigned short bf16_t;
typedef short bf16x8 __attribute__((ext_vector_type(8)));
typedef float f32x4 __attribute__((ext_vector_type(4)));
typedef unsigned u32x4 __attribute__((ext_vector_type(4)));
constexpr int BM = 256, BK = 64, HALF = 128, HTB = HALF * BK * 2  , STAGE_BYTES = 8 * HTB, NXCD = 8, WGM = 8;

__host__ __device__ __forceinline__ int lds_byte(int r, int c) { const int st = (r >> 4) * 2 + (c >> 5), rr = r & 15, cc = c & 31, ob = rr * 64 + cc * 2; return st * 1024 + (ob ^ (((ob >> 9) & 1) << 5)); }
__host__ __device__ __forceinline__ void stage_rc(int b, int& R, int& C) { const int st = b / 1024, sb = b % 1024, swz = sb ^ (((sb >> 9) & 1) << 5); R = (st >> 1) * 16 + swz / 64; C = (st & 1) * 32 + (swz % 64) / 2; }
__host__ __device__ __forceinline__ int perm32(int rho) { const int n = rho >> 4, i = rho & 15; return 8 * (i >> 2) + 4 * n + (i & 3); }

struct Unit { int pm, pn; };
struct Gemm { const bf16_t* A; const bf16_t* Bt; int M, N, K; };

struct StaticOrder {
    int nM, nN, nwg, G, c;
    __host__ __device__ void init(int M, int N, int G_, int c_) { nM = M / BM; nN = N / BM; nwg = nM * nN; G = G_; c = c_; }
    __host__ __device__ bool next(int i, Unit& u) const {
        const long L = (long)i * G + c; if (L >= nwg) return false;
        int wgid = (int)L; { const int q = nwg / NXCD, r = nwg % NXCD, xcd = wgid % NXCD, off = wgid / NXCD; wgid = (xcd < r ? xcd * (q + 1) : r * (q + 1) + (xcd - r) * q) + off; }
        const int nig = WGM * nN, gid = wgid / nig, fm = gid * WGM, gsz = (nM - fm) < WGM ? (nM - fm) : WGM;
        u.pm = fm + ((wgid % nig) % gsz); u.pn = (wgid % nig) / gsz; return true;
    }
    __device__ __forceinline__ void a_ready(const Unit&) const {}
    __device__ __forceinline__ void done(const Unit&) const {}
};

__device__ __forceinline__ unsigned cvt_pk_bf16(float lo, float hi) { unsigned r; asm volatile("v_cvt_pk_bf16_f32 %0, %1, %2" : "=v"(r) : "v"(lo), "v"(hi)); return r; }
typedef float f32x2 __attribute__((ext_vector_type(2)));
__device__ __forceinline__ float sigmoid_f(float v) { return __builtin_amdgcn_rcpf(1.0f + __builtin_amdgcn_exp2f(-1.4426950408889634f * v)); }
__device__ __forceinline__ u32x4 pack8_bf16(const f32x4 v0, const f32x4 v1) { u32x4 w; w.x = cvt_pk_bf16(v0[0], v0[1]); w.y = cvt_pk_bf16(v0[2], v0[3]); w.z = cvt_pk_bf16(v1[0], v1[1]); w.w = cvt_pk_bf16(v1[2], v1[3]); return w; }
__device__ __forceinline__ float bf_lo(unsigned w) { return __uint_as_float(w << 16); }
__device__ __forceinline__ float bf_hi(unsigned w) { return __uint_as_float(w & 0xffff0000u); }

struct EpiInproj {
    static constexpr bool PERM = true, AFTER_DRAIN = false;
    bf16_t* P; float* misc; int ldp; int gate_t0;
    __device__ __forceinline__ void operator()(const f32x4 (&acc)[2][2][4][2], const Unit& u, int wr, int wc, int fr, int fq) const {
        const int row0 = u.pm * BM + wr * 64 + fr, cl = wc * 32 + 8 * fq;
        if (u.pn == 6) {
#pragma unroll
            for (int ai = 0; ai < 2; ++ai)
#pragma unroll
                for (int m = 0; m < 4; ++m) { float* rowp = misc + (size_t)(row0 + ai * HALF + m * 16) * 256 + cl;
#pragma unroll
                    for (int bj = 0; bj < 2; ++bj) { *(f32x4*)(rowp + bj * HALF) = acc[ai][bj][m][0]; *(f32x4*)(rowp + bj * HALF + 4) = acc[ai][bj][m][1]; } }
        } else {
            const bool sg = u.pn >= gate_t0;
#pragma unroll
            for (int ai = 0; ai < 2; ++ai)
#pragma unroll
                for (int m = 0; m < 4; ++m) { bf16_t* rowp = P + (size_t)(row0 + ai * HALF + m * 16) * ldp + u.pn * BM + cl;
#pragma unroll
                    for (int bj = 0; bj < 2; ++bj) { f32x4 v0 = acc[ai][bj][m][0], v1 = acc[ai][bj][m][1];
                        if (sg) {
#pragma unroll
                            for (int e = 0; e < 4; ++e) { v0[e] = sigmoid_f(v0[e]); v1[e] = sigmoid_f(v1[e]); } }
                        *(u32x4*)(rowp + bj * HALF) = pack8_bf16(v0, v1); } }
        }
    }
};
struct EpiSplitBf16 {
    static constexpr bool PERM = true, AFTER_DRAIN = false;
    bf16_t* O0; bf16_t* O1; int split; int ldc;
    __device__ __forceinline__ void operator()(const f32x4 (&acc)[2][2][4][2], const Unit& u, int wr, int wc, int fr, int fq) const {
        const int row0 = u.pm * BM + wr * 64 + fr; bf16_t* base = u.pn < split ? O0 : O1; const int col0 = (u.pn < split ? u.pn : u.pn - split) * BM + wc * 32 + 8 * fq;
#pragma unroll
        for (int ai = 0; ai < 2; ++ai)
#pragma unroll
            for (int m = 0; m < 4; ++m) { bf16_t* rowp = base + (size_t)(row0 + ai * HALF + m * 16) * ldc + col0;
#pragma unroll
                for (int bj = 0; bj < 2; ++bj) *(u32x4*)(rowp + bj * HALF) = pack8_bf16(acc[ai][bj][m][0], acc[ai][bj][m][1]); }
    }
};
struct EpiQup {
    static constexpr bool PERM = true, AFTER_DRAIN = false;
    bf16_t* QN; bf16_t* QR; const float* cs; const float* sn;
    __device__ __forceinline__ void operator()(const f32x4 (&acc)[2][2][4][2], const Unit& u, int wr, int wc, int fr, int fq) const {
        const int row0 = u.pm * BM + wr * 64 + fr;
        if (u.pn < 4) {
            const int col0 = u.pn * BM + wc * 32 + 8 * fq;
#pragma unroll
            for (int ai = 0; ai < 2; ++ai)
#pragma unroll
                for (int m = 0; m < 4; ++m) { bf16_t* rowp = QN + (size_t)(row0 + ai * HALF + m * 16) * 1024 + col0;
#pragma unroll
                    for (int bj = 0; bj < 2; ++bj) *(u32x4*)(rowp + bj * HALF) = pack8_bf16(acc[ai][bj][m][0], acc[ai][bj][m][1]); }
        } else {
            const int col0 = (u.pn - 4) * BM + wc * 32 + 8 * fq;
#pragma unroll
            for (int ai = 0; ai < 2; ++ai)
#pragma unroll
                for (int m = 0; m < 4; ++m) { const int row = row0 + ai * HALF + m * 16;
#pragma unroll
                    for (int bj = 0; bj < 2; ++bj) { const int c = col0 + bj * HALF, i0 = (c & 63) >> 1;
                        const f32x4 cv = *(const f32x4*)(cs + (size_t)row * 32 + i0), sv = *(const f32x4*)(sn + (size_t)row * 32 + i0);
                        const f32x4 a = acc[ai][bj][m][0], b = acc[ai][bj][m][1]; f32x4 o0, o1;
                        o0[0] = a[0] * cv[0] - a[1] * sv[0]; o0[1] = a[1] * cv[0] + a[0] * sv[0]; o0[2] = a[2] * cv[1] - a[3] * sv[1]; o0[3] = a[3] * cv[1] + a[2] * sv[1];
                        o1[0] = b[0] * cv[2] - b[1] * sv[2]; o1[1] = b[1] * cv[2] + b[0] * sv[2]; o1[2] = b[2] * cv[3] - b[3] * sv[3]; o1[3] = b[3] * cv[3] + b[2] * sv[3];
                        *(u32x4*)(QR + (size_t)row * 512 + c) = pack8_bf16(o0, o1); } }
        }
    }
};
template <int MODE> struct EpiBranch {
    static constexpr bool PERM = true, AFTER_DRAIN = false;
    const bf16_t* G; int ldg; float* T; bf16_t* MRG; int ldc;
    __device__ __forceinline__ void operator()(const f32x4 (&acc)[2][2][4][2], const Unit& u, int wr, int wc, int fr, int fq) const {
        const int row0 = u.pm * BM + wr * 64 + fr, col0 = u.pn * BM + wc * 32 + 8 * fq;
#pragma unroll
        for (int ai = 0; ai < 2; ++ai)
#pragma unroll
            for (int m = 0; m < 4; ++m) { const size_t row = (size_t)(row0 + ai * HALF + m * 16);
#pragma unroll
                for (int bj = 0; bj < 2; ++bj) { const int c = col0 + bj * HALF;
                    const u32x4 gw = *(const u32x4*)(G + row * ldg + c);
                    f32x4 v0 = acc[ai][bj][m][0], v1 = acc[ai][bj][m][1];
                    v0[0] *= bf_lo(gw.x); v0[1] *= bf_hi(gw.x); v0[2] *= bf_lo(gw.y); v0[3] *= bf_hi(gw.y);
                    v1[0] *= bf_lo(gw.z); v1[1] *= bf_hi(gw.z); v1[2] *= bf_lo(gw.w); v1[3] *= bf_hi(gw.w);
                    float* tp = T + row * ldc + c;
                    if (MODE >= 1) { v0 += *(const f32x4*)tp; v1 += *(const f32x4*)(tp + 4); }
                    if (MODE <= 1) { *(f32x4*)tp = v0; *(f32x4*)(tp + 4) = v1; }
                    else *(u32x4*)(MRG + row * ldc + c) = pack8_bf16(v0, v1); } }
    }
};
struct EpiSwiglu {
    static constexpr bool PERM = true, AFTER_DRAIN = false;
    bf16_t* H; int ldh;
    __device__ __forceinline__ void operator()(const f32x4 (&acc)[2][2][4][2], const Unit& u, int wr, int wc, int fr, int fq) const {
        const int row0 = u.pm * BM + wr * 64 + fr, col0 = u.pn * HALF + wc * 32 + 8 * fq;
#pragma unroll
        for (int ai = 0; ai < 2; ++ai)
#pragma unroll
            for (int m = 0; m < 4; ++m) { f32x4 o0, o1; const f32x4 g0 = acc[ai][0][m][0], g1 = acc[ai][0][m][1], u0 = acc[ai][1][m][0], u1 = acc[ai][1][m][1];
#pragma unroll
                for (int e = 0; e < 4; ++e) { o0[e] = g0[e] * sigmoid_f(g0[e]) * u0[e]; o1[e] = g1[e] * sigmoid_f(g1[e]) * u1[e]; }
                *(u32x4*)(H + (size_t)(row0 + ai * HALF + m * 16) * ldh + col0) = pack8_bf16(o0, o1); }
    }
};
struct EpiF32 {
    static constexpr bool PERM = false, AFTER_DRAIN = false;
    float* C; int ldc;
    __device__ __forceinline__ void operator()(const f32x4 (&acc)[2][2][4][2], const Unit& u, int wr, int wc, int fr, int fq) const {
        const int row0 = u.pm * BM + wr * 64 + fr, col0 = u.pn * BM + wc * 32 + 4 * fq;
#pragma unroll
        for (int ai = 0; ai < 2; ++ai)
#pragma unroll
            for (int m = 0; m < 4; ++m) { float* rowp = C + (size_t)(row0 + ai * HALF + m * 16) * ldc + col0;
#pragma unroll
                for (int bj = 0; bj < 2; ++bj)
#pragma unroll
                    for (int n = 0; n < 2; ++n) *(f32x4*)(rowp + bj * HALF + n * 16) = acc[ai][bj][m][n]; }
    }
};

template <class Epi, class Sched, bool ALIGN_EPI = false, bool SP2 = false>
__device__ __forceinline__ void gemm_phase(PG8_LAS unsigned char* lds, const Gemm g, const Sched& S, const Epi& E) {
    int tid_ = threadIdx.x; asm volatile("" : "+v"(tid_));
    const int tid = tid_, wid = __builtin_amdgcn_readfirstlane(tid >> 6), lane = tid & 63, wr = wid >> 2, wc = wid & 3, fr = lane & 15, fq = lane >> 4;
    const int K = g.K, nt = K / BK;
    unsigned voffA[2], voffB[2];
#pragma unroll
    for (int i = 0; i < 2; ++i) { int R, C; stage_rc(tid * 16 + i * 8192, R, C); const int Rb = Epi::PERM ? ((R & ~31) + perm32(R & 31)) : R;
        voffA[i] = (unsigned)(R * K + C) * 2u; voffB[i] = (unsigned)(Rb * K + C) * 2u; }
    const size_t kstep = (size_t)(BK * 2);
    const size_t hstep = (size_t)HALF * K * 2;
    const size_t tstep = 2 * hstep;
    const unsigned ldsw = (unsigned)wid * 1024u;
    const int aoff = lds_byte(wr * 64 + fr, fq * 8), boff = lds_byte(wc * 32 + fr, fq * 8);
#define PG8_SA(b, h) (((b) * 2 + (h)) * HTB)
#define PG8_SB(b, h) ((4 + (b) * 2 + (h)) * HTB)
#define PG8_STAGE(bufoff, gbase, voff) do { _Pragma("unroll") for (int _i = 0; _i < 2; ++_i) \
        __builtin_amdgcn_global_load_lds((const unsigned*)((const char*)(gbase) + (voff)[_i]), (PG8_LAS unsigned*)(lds + (bufoff) + ldsw + _i * 8192), 16, 0, 0); } while (0)
#define PG8_LDA(dst, b, h) do { _Pragma("unroll") for (int m = 0; m < 4; ++m) _Pragma("unroll") for (int k = 0; k < 2; ++k) dst[m][k] = *(const PG8_LAS bf16x8*)(lds + PG8_SA(b, h) + aoff + m * 2048 + k * 1024); } while (0)
#define PG8_LDB(dst, b, h) do { _Pragma("unroll") for (int n = 0; n < 2; ++n) _Pragma("unroll") for (int k = 0; k < 2; ++k) dst[n][k] = *(const PG8_LAS bf16x8*)(lds + PG8_SB(b, h) + boff + n * 2048 + k * 1024); } while (0)
#define PG8_MMA(ai, bj, At, Bt) do { __builtin_amdgcn_s_setprio(1); _Pragma("unroll") for (int m = 0; m < 4; ++m) _Pragma("unroll") for (int n = 0; n < 2; ++n) _Pragma("unroll") for (int k = 0; k < 2; ++k) \
        acc[ai][bj][m][n] = __builtin_amdgcn_mfma_f32_16x16x32_bf16(Bt[n][k], At[m][k], acc[ai][bj][m][n], 0, 0, 0); __builtin_amdgcn_s_setprio(0); } while (0)
#define PG8_WAIT_V(n) asm volatile("s_waitcnt vmcnt(" #n ")" ::: "memory")
#define PG8_WAIT_L(n) asm volatile("s_waitcnt lgkmcnt(" #n ")" ::: "memory")
#define PG8_BAR __builtin_amdgcn_s_barrier()
#define PG8_SCHED __builtin_amdgcn_sched_barrier(0)
    Unit cur, nxt; int ui = 0;
    if (!S.next(0, cur)) return;
    f32x4 acc[2][2][4][2];
#pragma unroll
    for (int a = 0; a < 2; ++a)
#pragma unroll
        for (int b = 0; b < 2; ++b)
#pragma unroll
            for (int m = 0; m < 4; ++m)
#pragma unroll
                for (int n = 0; n < 2; ++n) acc[a][b][m][n] = (f32x4){0.f, 0.f, 0.f, 0.f};
    bf16x8 At[4][2], B0[2][2], B1[2][2];
    const char* cA = (const char*)g.A + (size_t)cur.pm * tstep; const char* cB = (const char*)g.Bt + (size_t)cur.pn * tstep;
    S.a_ready(cur);
    if constexpr (SP2) {
        PG8_STAGE(PG8_SB(0, 0), cB, voffB); PG8_STAGE(PG8_SB(0, 1), cB + hstep, voffB); PG8_STAGE(PG8_SA(0, 0), cA, voffA); PG8_STAGE(PG8_SA(0, 1), cA + hstep, voffA);
        if (wr == 1) PG8_BAR;
        PG8_WAIT_V(2); PG8_BAR;
        PG8_STAGE(PG8_SB(1, 0), cB + kstep, voffB); PG8_STAGE(PG8_SA(1, 0), cA + kstep, voffA); PG8_STAGE(PG8_SB(1, 1), cB + hstep + kstep, voffB);
        PG8_WAIT_V(6); PG8_BAR;
    } else {
        PG8_STAGE(PG8_SB(0, 0), cB, voffB); PG8_STAGE(PG8_SA(0, 0), cA, voffA); PG8_STAGE(PG8_SB(0, 1), cB + hstep, voffB); PG8_STAGE(PG8_SA(0, 1), cA + hstep, voffA);
        if (wr == 1) PG8_BAR;
        PG8_WAIT_V(4); PG8_BAR;
        PG8_STAGE(PG8_SB(1, 0), cB + kstep, voffB); PG8_STAGE(PG8_SA(1, 0), cA + kstep, voffA); PG8_STAGE(PG8_SB(1, 1), cB + hstep + kstep, voffB);
        PG8_WAIT_V(6); PG8_BAR;
    }
    for (;;) {
        const bool has_next = S.next(ui + 1, nxt);
        const char* nA = has_next ? (const char*)g.A + (size_t)nxt.pm * tstep : cA; const char* nB = has_next ? (const char*)g.Bt + (size_t)nxt.pn * tstep : cB;
        for (int t = 0; t < nt; t += 2) {
            const bool last = (t == nt - 2);
            const char* a1 = cA + (size_t)(t + 1) * kstep;
            const char* a2 = last ? nA : cA + (size_t)(t + 2) * kstep; const char* b2 = last ? nB : cB + (size_t)(t + 2) * kstep;
            const char* a3 = a2 + kstep; const char* b3 = b2 + kstep;
            if (last && has_next) S.a_ready(nxt);
            if constexpr (SP2) {
            PG8_LDB(B0, 0, 0); PG8_LDB(B1, 0, 1); PG8_SCHED; PG8_LDA(At, 0, 0); PG8_STAGE(PG8_SA(1, 1), a1 + hstep, voffA);
            PG8_WAIT_V(8); PG8_WAIT_L(0); PG8_BAR; PG8_MMA(0, 0, At, B0); PG8_MMA(0, 1, At, B1); PG8_BAR; PG8_SCHED;
            PG8_LDA(At, 0, 1); PG8_STAGE(PG8_SB(0, 0), b2, voffB); PG8_STAGE(PG8_SB(0, 1), b2 + hstep, voffB); PG8_STAGE(PG8_SA(0, 0), a2, voffA);
            PG8_WAIT_V(8); PG8_WAIT_L(0); PG8_BAR; PG8_MMA(1, 0, At, B0); PG8_MMA(1, 1, At, B1); PG8_BAR; PG8_SCHED;
            PG8_LDB(B0, 1, 0); PG8_LDB(B1, 1, 1); PG8_SCHED; PG8_LDA(At, 1, 0); PG8_STAGE(PG8_SA(0, 1), a2 + hstep, voffA);
            PG8_WAIT_V(8); PG8_WAIT_L(0); PG8_BAR; PG8_MMA(0, 0, At, B0); PG8_MMA(0, 1, At, B1); PG8_BAR; PG8_SCHED;
            PG8_LDA(At, 1, 1); PG8_STAGE(PG8_SB(1, 0), b3, voffB); PG8_STAGE(PG8_SB(1, 1), b3 + hstep, voffB); PG8_STAGE(PG8_SA(1, 0), a3, voffA);
            PG8_WAIT_V(8); PG8_WAIT_L(0); PG8_BAR; PG8_MMA(1, 0, At, B0); PG8_MMA(1, 1, At, B1); PG8_BAR; PG8_SCHED;
            } else {
            PG8_LDB(B0, 0, 0); PG8_SCHED; PG8_LDA(At, 0, 0); PG8_STAGE(PG8_SA(1, 1), a1 + hstep, voffA);
            PG8_WAIT_L(8); PG8_BAR; PG8_WAIT_L(0); PG8_MMA(0, 0, At, B0); PG8_BAR; PG8_SCHED;
            PG8_LDB(B1, 0, 1); PG8_STAGE(PG8_SB(0, 0), b2, voffB);
            PG8_BAR; PG8_WAIT_L(0); PG8_MMA(0, 1, At, B1); PG8_BAR;
            PG8_LDA(At, 0, 1); PG8_STAGE(PG8_SA(0, 0), a2, voffA);
            PG8_BAR; PG8_WAIT_L(0); PG8_MMA(1, 0, At, B0); PG8_BAR; PG8_SCHED;
            PG8_STAGE(PG8_SB(0, 1), b2 + hstep, voffB);
            PG8_WAIT_V(6); PG8_BAR; PG8_MMA(1, 1, At, B1); PG8_BAR;
            PG8_LDB(B0, 1, 0); PG8_SCHED; PG8_LDA(At, 1, 0); PG8_STAGE(PG8_SA(0, 1), a2 + hstep, voffA);
            PG8_WAIT_L(8); PG8_BAR; PG8_WAIT_L(0); PG8_MMA(0, 0, At, B0); PG8_BAR; PG8_SCHED;
            PG8_LDB(B1, 1, 1); PG8_STAGE(PG8_SB(1, 0), b3, voffB);
            PG8_BAR; PG8_WAIT_L(0); PG8_MMA(0, 1, At, B1); PG8_BAR;
            PG8_LDA(At, 1, 1); PG8_STAGE(PG8_SA(1, 0), a3, voffA);
            PG8_BAR; PG8_WAIT_L(0); PG8_MMA(1, 0, At, B0); PG8_BAR; PG8_SCHED;
            PG8_STAGE(PG8_SB(1, 1), b3 + hstep, voffB);
            PG8_WAIT_V(6); PG8_BAR; PG8_MMA(1, 1, At, B1); PG8_BAR;
            }
        }
        if constexpr (ALIGN_EPI) { if (wr == 0) PG8_BAR; }
        if constexpr (!Epi::AFTER_DRAIN) { E(acc, cur, wr, wc, fr, fq); S.done(cur); }
        if (!has_next) break;
#pragma unroll
        for (int a = 0; a < 2; ++a)
#pragma unroll
            for (int b = 0; b < 2; ++b)
#pragma unroll
                for (int m = 0; m < 4; ++m)
#pragma unroll
                    for (int n = 0; n < 2; ++n) acc[a][b][m][n] = (f32x4){0.f, 0.f, 0.f, 0.f};
        cur = nxt; cA = nA; cB = nB; ++ui;
        if constexpr (ALIGN_EPI) { if (wr == 1) PG8_BAR; }
    }
    PG8_WAIT_V(0);
    if constexpr (!ALIGN_EPI) { if (wr == 0) PG8_BAR; }
    PG8_BAR;
    if constexpr (Epi::AFTER_DRAIN) { E.fused(acc, cur, wr, wc, fr, fq, lds, wid, lane); S.done(cur); }
#undef PG8_SA
#undef PG8_SB
#undef PG8_STAGE
#undef PG8_LDA
#undef PG8_LDB
#undef PG8_MMA
#undef PG8_WAIT_V
#undef PG8_WAIT_L
#undef PG8_BAR
#undef PG8_SCHED
}
}

constexpr int NWAVES = 8;
#ifndef MK_PER_PHASE
#define MK_PER_PHASE 0
#endif

constexpr int DM = 4096, NBATCH = 8, SEQ = 2048, M = NBATCH * SEQ, DEPTH = 2;
constexpr int NIN_SRC = 19528, NIN = 19712;
constexpr int FF = 11008;
constexpr float RMS_EPS = 1e-6f;
constexpr int PC_CQ = 0, PC_CKV = 1024, PC_MISC = 1536  , PC_QSWA = 1792, PC_KSWA = 3840, PC_VSWA = 4096, PC_QFOX = 4352, PC_KFOX = 5376, PC_VFOX = 6400, PC_GATE = 7424;
constexpr int GATE_TILE0 = PC_GATE / 256;
static_assert(PC_GATE + 3 * DM == NIN && NIN % 256 == 0 && PC_MISC / 256 == 6, "in-projection map");

constexpr size_t MiB = 1u << 20;
constexpr size_t WS_CTL = 0, CTL_ZERO_BYTES = 1 * MiB;
constexpr size_t SZ_WIN = (size_t)NIN * DM * 2, SZ_WUQ = (size_t)1536 * 1024 * 2, SZ_WUKV = (size_t)2048 * 512 * 2, SZ_WB = (size_t)DM * DM * 2, SZ_WOUT = (size_t)DM * DM * 2,
                 SZ_WGU = (size_t)2 * FF * DM * 2, SZ_WD = (size_t)DM * FF * 2;
constexpr size_t WL_WIN = 0, WL_WUQ = WL_WIN + SZ_WIN, WL_WUKV = WL_WUQ + SZ_WUQ, WL_WB = WL_WUKV + SZ_WUKV, WL_WOUT = WL_WB + SZ_WB, WL_WGU = WL_WOUT + SZ_WOUT, WL_WD = WL_WGU + SZ_WGU,
                 WL_SIZE = WL_WD + SZ_WD;
constexpr size_t WS_W = 1 * MiB;
constexpr size_t WS_ROPE = WS_W + DEPTH * WL_SIZE;
constexpr size_t WS_HB = WS_ROPE + 4 * MiB;
constexpr size_t WS_PB = WS_HB + (size_t)M * DM * 2;
constexpr size_t WS_MISC = WS_PB + (size_t)M * NIN * 2;
constexpr size_t WS_CQN = WS_MISC + (size_t)M * 256 * 4;
constexpr size_t WS_CKVN = WS_CQN + (size_t)M * 1024 * 2;
constexpr size_t WS_KR = WS_CKVN + (size_t)M * 512 * 2;
constexpr size_t WS_LF = WS_KR + (size_t)M * 64 * 2;
constexpr size_t WS_FC = WS_LF + (size_t)M * 8 * 4;
constexpr size_t WS_QN = WS_FC + (size_t)M * 8 * 4;
constexpr size_t WS_QR = WS_QN + (size_t)M * 1024 * 2;
constexpr size_t WS_KN = WS_QR + (size_t)M * 512 * 2;
constexpr size_t WS_VM = WS_KN + (size_t)M * 1024 * 2;
constexpr size_t WS_OM = WS_VM + (size_t)M * 1024 * 2;
constexpr size_t WS_OS = WS_OM + (size_t)M * 1024 * 2;
constexpr size_t WS_OF = WS_OS + (size_t)M * 2048 * 2;
constexpr size_t WS_TM = WS_OF + (size_t)M * 1024 * 2;
constexpr size_t WS_END = WS_TM + (size_t)M * DM * 4;
static_assert(WS_END <= (size_t)2752 * MiB, "d_ws map exceeds the guaranteed workspace");
static_assert((size_t)M * FF * 2 <= (size_t)M * NIN * 2, "HID overlays P");
constexpr int CW_TMO = 0, CW_CODE = 1;
constexpr int CW_BAR = 4096;

constexpr int RING_OFF = 0, RING_BYTES = 131072;
constexpr int LDSCTL_OFF = RING_BYTES, MISC_OFF = LDSCTL_OFF + 320;
constexpr int LDS_BYTES = 147456;
static_assert(MISC_OFF + 128 <= LDS_BYTES, "LDS map");

#define GAS __attribute__((address_space(1)))
#define LAS __attribute__((address_space(3)))
typedef unsigned short bf16;
typedef unsigned v4u __attribute__((ext_vector_type(4)));
typedef float f32x4 __attribute__((ext_vector_type(4)));
typedef short bf16x8 __attribute__((ext_vector_type(8)));
typedef GAS unsigned gu32;
typedef GAS unsigned long long gu64;
#define RLX_AGENT __ATOMIC_RELAXED, __HIP_MEMORY_SCOPE_AGENT
#define LDS_WAIT() asm volatile("s_waitcnt lgkmcnt(0)" ::: "memory")
#define VM_WAIT() asm volatile("s_waitcnt vmcnt(0)" ::: "memory")
__device__ __forceinline__ unsigned long long rt() { return __builtin_amdgcn_s_memrealtime(); }
__device__ __forceinline__ unsigned f2bf(float f) { unsigned u = __builtin_bit_cast(unsigned, f); return (u + 0x7fffu + ((u >> 16) & 1u)) >> 16; }
__device__ __forceinline__ unsigned pk2(float lo, float hi) { return f2bf(lo) | (f2bf(hi) << 16); }

#define XB_TMO      128
#define XB_XCNT(j)  (256  + 64 * (j))
#define XB_XSUB(j)  (1280 + 64 * (j))
#define XB_XGEN(j)  (2304 + 64 * (j))
#define XB_TOP      3328
#define XB_TOPGEN   3392
#define XCD_BAR_WORDS 3456
#define XB_SPIN_CAP (1u << 23)

__device__ __forceinline__ unsigned xb_ld(unsigned* p)              { return __hip_atomic_load(p, __ATOMIC_RELAXED, __HIP_MEMORY_SCOPE_AGENT); }
__device__ __forceinline__ unsigned xb_add(unsigned* p, unsigned v) { return __hip_atomic_fetch_add(p, v, __ATOMIC_RELAXED, __HIP_MEMORY_SCOPE_AGENT); }
__device__ __forceinline__ unsigned xb_xcc_id() { return (unsigned)__builtin_amdgcn_s_getreg((3 << 11) | 20) & 0xFu; }
#define XB_SPIN(cond, bar) do { unsigned _sp = 0; while (cond) { __builtin_amdgcn_s_sleep(1); \
    if ((++_sp & 255u) == 0u) { if (xb_ld(&(bar)[XB_TMO])) break; if (_sp > XB_SPIN_CAP) { atomicAdd(&(bar)[XB_TMO], 1u); break; } } } } while (0)

struct XcdBarrier {
    unsigned* bar; unsigned x;
    volatile LAS unsigned* st;
};

__device__ __forceinline__ XcdBarrier xcd_barrier_post(unsigned* bar, volatile LAS unsigned* st) {
    XcdBarrier b; b.bar = bar; b.x = xb_xcc_id(); b.st = st;
    if (threadIdx.x == 0) (void)xb_add(&bar[XB_XCNT(b.x)], 1u);
    return b;
}
__device__ __forceinline__ void xcd_barrier_complete(unsigned* bar, unsigned x, unsigned& nloc, unsigned& nx) {
    const unsigned G = gridDim.x * gridDim.y * gridDim.z;
    unsigned sum, cnt, mine, sp = 0u;
    for (;;) {
        sum = 0u; cnt = 0u; mine = 0u;
#pragma unroll
        for (unsigned j = 0; j < 16; ++j) { const unsigned c = xb_ld(&bar[XB_XCNT(j)]); sum += c; cnt += (c > 0u) ? 1u : 0u; mine = (j == x) ? c : mine; }
        if (sum == G) break;
        __builtin_amdgcn_s_sleep(1);
        if ((++sp & 255u) == 0u) { if (xb_ld(&bar[XB_TMO])) break; if (sp > XB_SPIN_CAP) { atomicAdd(&bar[XB_TMO], 1u); break; } }
    }
    nloc = mine > 0u ? mine : 1u; nx = cnt > 0u ? cnt : 1u;
}

__device__ __forceinline__ void xcd_barrier(const XcdBarrier& b) {
    asm volatile("s_waitcnt vmcnt(0)" ::: "memory");
    __syncthreads();
    if (threadIdx.x == 0) {
        unsigned* bar = b.bar;
        __builtin_amdgcn_s_waitcnt(0);
        unsigned nloc = b.st[0], nx = b.st[1];
        if (nloc == 0u) { xcd_barrier_complete(bar, b.x, nloc, nx); b.st[0] = nloc; b.st[1] = nx; }
        const unsigned old = xb_add(&bar[XB_XSUB(b.x)], 1u);
        const unsigned gen = old / nloc;
        if (old + 1u == (gen + 1u) * nloc) {
            __builtin_amdgcn_fence(__ATOMIC_RELEASE, "agent");
            asm volatile("s_waitcnt vmcnt(0)" ::: "memory");
            const unsigned og = xb_add(&bar[XB_TOP], 1u);
            const unsigned tg = og / nx;
            if (og + 1u == (tg + 1u) * nx) xb_add(&bar[XB_TOPGEN], 1u);
            else XB_SPIN(xb_ld(&bar[XB_TOPGEN]) == tg, bar);
            __builtin_amdgcn_fence(__ATOMIC_ACQUIRE, "agent");
            xb_add(&bar[XB_XGEN(b.x)], 1u);
            asm volatile("s_waitcnt vmcnt(0)" ::: "memory");
        } else {
            XB_SPIN(xb_ld(&bar[XB_XGEN(b.x)]) == gen, bar);
            __builtin_amdgcn_fence(__ATOMIC_ACQUIRE, "agent");
            asm volatile("s_waitcnt vmcnt(0)" ::: "memory");
        }
    }
    __syncthreads();
}

struct Frame {
    LAS unsigned char* lds;
    int tid, lane, wave;
};
__device__ __forceinline__ float wave_sum(float v) {
#pragma unroll
    for (int o = 1; o < 64; o <<= 1) v += __shfl_xor(v, o);
    return v;
}
__device__ __forceinline__ float wave_max(float v) {
#pragma unroll
    for (int o = 1; o < 64; o <<= 1) v = fmaxf(v, __shfl_xor(v, o));
    return v;
}
__device__ __forceinline__ float bfl(unsigned w) { return __uint_as_float(w << 16); }
__device__ __forceinline__ float bfh(unsigned w) { return __uint_as_float(w & 0xffff0000u); }

__device__ __forceinline__ void sincos_f(float x, float& s, float& c) {
    const float k = rintf(x * 0.636619772367581f);
    float r = fmaf(k, -1.5703125f, x); r = fmaf(k, -4.837512969970703125e-4f, r); r = fmaf(k, -7.549789948768648e-8f, r);
    const int q = (int)k & 3; const float z = r * r;
    const float sp = fmaf(r * z, fmaf(z, fmaf(z, -1.9515295891e-4f, 8.3321608736e-3f), -1.6666654611e-1f), r);
    const float cp = fmaf(z * z, fmaf(z, fmaf(z, 2.443315711809948e-5f, -1.388731625493765e-3f), 4.166664568298827e-2f), fmaf(z, -0.5f, 1.0f));
    float ss = (q & 1) ? cp : sp, cc = (q & 1) ? sp : cp;
    if (q & 2) ss = -ss; if ((q + 1) & 2) cc = -cc;
    s = ss; c = cc;
}

__device__ __forceinline__ void tr_item(const float* W, int ldw, int K, bf16* WT, int k0, int dst_row0, int src_col0, int nvalid, int mode, LAS float* scr, int lane) {
    const int c = lane & 31; const int scol = mode ? src_col0 + 32 * (c & 1) + (c >> 1) : src_col0 + c; const bool ok = mode ? true : (c < nvalid);
    const float* src = W + (size_t)(k0 + (lane >> 5)) * ldw + scol;
#pragma unroll 8
    for (int i = 0; i < 32; ++i) { const int kk = 2 * i + (lane >> 5); scr[kk * 33 + c] = ok ? src[(size_t)(2 * i) * ldw] : 0.f; }
    LDS_WAIT(); asm volatile("" ::: "memory");
    const int cc = lane & 7;
#pragma unroll
    for (int j = 0; j < 4; ++j) { const int n = (lane >> 3) + 8 * j; const LAS float* s = scr + (8 * cc) * 33 + n;
        v4u o; o.x = pk2(s[0 * 33], s[1 * 33]); o.y = pk2(s[2 * 33], s[3 * 33]); o.z = pk2(s[4 * 33], s[5 * 33]); o.w = pk2(s[6 * 33], s[7 * 33]);
        *(GAS v4u*)(WT + (size_t)(dst_row0 + n) * K + k0 + 8 * cc) = o; }
    LDS_WAIT(); asm volatile("" ::: "memory");
}
#define PTR_FIELDS(X) X(const float*, x) X(const int*, pos) X(const float*, g_mix_pre) X(const float*, g_mix_post) X(const float*, g_ffn_pre) X(const float*, g_ffn_post) X(const float*, w_in) \
    X(const float*, g_q_lora) X(const float*, w_uq) X(const float*, g_kv_lora) X(const float*, w_ukv) X(const float*, b_forget) X(const float*, swa_sinks) X(const float*, w_branch) X(const float*, w_out) \
    X(const float*, w_gate_up) X(const float*, w_down) X(float*, out) X(unsigned char*, ws)
constexpr int N_PTRS = 19;
struct Ptrs {
#define X(T, n) T n;
    PTR_FIELDS(X)
#undef X
    int ph_lo, ph_hi;
};
static_assert(sizeof(Ptrs) == N_PTRS * 8 + 8, "Ptrs has no padding");
struct PA : Ptrs { int G, bx, vcu; };
__device__ __forceinline__ unsigned long long ld_u64u(const LAS unsigned* w) { const unsigned lo = (unsigned)__builtin_amdgcn_readfirstlane((int)w[0]), hi = (unsigned)__builtin_amdgcn_readfirstlane((int)w[1]); return ((unsigned long long)hi << 32) | lo; }
__device__ __forceinline__ void park_args(const Ptrs& A0, LAS unsigned* argw) {
    LAS unsigned long long* a64 = (LAS unsigned long long*)argw; int i = 0;
#define X(T, n) a64[i++] = (unsigned long long)A0.n;
    PTR_FIELDS(X)
#undef X
    const int G = gridDim.x, bx = blockIdx.x;
    argw[2 * N_PTRS + 0] = (unsigned)G; argw[2 * N_PTRS + 1] = (unsigned)bx; argw[2 * N_PTRS + 2] = (unsigned)((G % 8 == 0) ? (bx % 8) * (G / 8) + bx / 8 : bx);
}
__device__ __forceinline__ PA load_args(const LAS unsigned* argw) {
    asm volatile("" ::: "memory");
    PA A; int i = 0;
#define X(T, n) A.n = (T)(GAS unsigned char*)ld_u64u(argw + 2 * (i++));
    PTR_FIELDS(X)
#undef X
    A.G = __builtin_amdgcn_readfirstlane((int)argw[2 * N_PTRS + 0]); A.bx = __builtin_amdgcn_readfirstlane((int)argw[2 * N_PTRS + 1]); A.vcu = __builtin_amdgcn_readfirstlane((int)argw[2 * N_PTRS + 2]);
    A.ph_lo = 0; A.ph_hi = 0;
    return A;
}
__device__ __forceinline__ void p0_convert(Frame& F, const PA& A) {
    LAS float* scr = (LAS float*)(F.lds + RING_OFF + F.wave * 16384);
    const int gw = A.vcu * NWAVES + F.wave, NGW = A.G * NWAVES;
    constexpr int NB_IN = NIN / 32, NB_UQ = 1536 / 32, NB_UKV = 2048 / 32, NB_D = DM / 32, NB_GU = 2 * FF / 32;
    constexpr int I_IN = (DM / 64) * NB_IN, I_UQ = (1024 / 64) * NB_UQ, I_UKV = (512 / 64) * NB_UKV, I_B0 = (1024 / 64) * NB_D, I_B1 = (2048 / 64) * NB_D, I_B2 = I_B0,
                  I_OUT = (DM / 64) * NB_D, I_GU = (DM / 64) * NB_GU, I_D = (FF / 64) * NB_D;
    constexpr int I_LAYER = I_IN + I_UQ + I_UKV + I_B0 + I_B1 + I_B2 + I_OUT + I_GU + I_D;
    for (int it = gw; it < DEPTH * I_LAYER; it += NGW) {
        const int l = it / I_LAYER; int r = it - l * I_LAYER;
        unsigned char* wl = A.ws + WS_W + (size_t)l * WL_SIZE;
        if (r < I_IN) { const int kb = r / NB_IN, nb = r - kb * NB_IN, n0 = nb * 32; int sc, nv;
            if (n0 < 1600) { sc = n0; nv = 32; } else if (n0 < 1632) { sc = 7232; nv = 8; } else if (n0 < PC_QSWA) { sc = 0; nv = 0; } else if (n0 < PC_GATE) { sc = n0 - 192; nv = 32; } else { sc = n0 - 184; nv = 32; }
            tr_item(A.w_in + (size_t)l * DM * NIN_SRC, NIN_SRC, DM, (bf16*)(wl + WL_WIN), kb * 64, n0, sc, nv, 0, scr, F.lane); continue; } r -= I_IN;
        if (r < I_UQ) { const int kb = r / NB_UQ, nb = r - kb * NB_UQ, n0 = nb * 32; int sc, mode;
            if (n0 < 1024) { sc = 192 * (n0 >> 7) + (n0 & 127); mode = 0; } else { const int q = n0 - 1024; sc = 192 * (q >> 6) + 128 + 16 * ((q >> 5) & 1); mode = 1; }
            tr_item(A.w_uq + (size_t)l * 1024 * 1536, 1536, 1024, (bf16*)(wl + WL_WUQ), kb * 64, n0, sc, 32, mode, scr, F.lane); continue; } r -= I_UQ;
        if (r < I_UKV) { const int kb = r / NB_UKV, nb = r - kb * NB_UKV, n0 = nb * 32; const int q = n0 & 1023;
            const int sc = 256 * (q >> 7) + (q & 127) + (n0 >= 1024 ? 128 : 0);
            tr_item(A.w_ukv + (size_t)l * 512 * 2048, 2048, 512, (bf16*)(wl + WL_WUKV), kb * 64, n0, sc, 32, 0, scr, F.lane); continue; } r -= I_UKV;
        if (r < I_B0) { const int kb = r / NB_D, nb = r - kb * NB_D;
            tr_item(A.w_branch + (size_t)l * DM * DM, DM, 1024, (bf16*)(wl + WL_WB), kb * 64, nb * 32, nb * 32, 32, 0, scr, F.lane); continue; } r -= I_B0;
        if (r < I_B1) { const int kb = r / NB_D, nb = r - kb * NB_D;
            tr_item(A.w_branch + (size_t)l * DM * DM + (size_t)1024 * DM, DM, 2048, (bf16*)(wl + WL_WB) + (size_t)DM * 1024, kb * 64, nb * 32, nb * 32, 32, 0, scr, F.lane); continue; } r -= I_B1;
        if (r < I_B2) { const int kb = r / NB_D, nb = r - kb * NB_D;
            tr_item(A.w_branch + (size_t)l * DM * DM + (size_t)3072 * DM, DM, 1024, (bf16*)(wl + WL_WB) + (size_t)DM * 3072, kb * 64, nb * 32, nb * 32, 32, 0, scr, F.lane); continue; } r -= I_B2;
        if (r < I_OUT) { const int kb = r / NB_D, nb = r - kb * NB_D;
            tr_item(A.w_out + (size_t)l * DM * DM, DM, DM, (bf16*)(wl + WL_WOUT), kb * 64, nb * 32, nb * 32, 32, 0, scr, F.lane); continue; } r -= I_OUT;
        if (r < I_GU) { const int kb = r / NB_GU, nb = r - kb * NB_GU, n0 = nb * 32;
            const int sc = ((n0 >> 7) & 1) * FF + 128 * (n0 >> 8) + (n0 & 127);
            tr_item(A.w_gate_up + (size_t)l * DM * 2 * FF, 2 * FF, DM, (bf16*)(wl + WL_WGU), kb * 64, n0, sc, 32, 0, scr, F.lane); continue; } r -= I_GU;
        { const int kb = r / NB_D, nb = r - kb * NB_D;
            tr_item(A.w_down + (size_t)l * FF * DM, DM, FF, (bf16*)(wl + WL_WD), kb * 64, nb * 32, nb * 32, 32, 0, scr, F.lane); }
    }
    float* cs = (float*)(A.ws + WS_ROPE); float* sn = cs + (size_t)M * 32;
    for (int e = (A.vcu * NWAVES * 64) + F.tid; e < M * 32; e += A.G * NWAVES * 64) { const int m = e >> 5, i = e & 31;
        const float inv = __builtin_amdgcn_exp2f(-(float)i * 0.41524101186092f); const float ang = (float)A.pos[m] * inv; float s, c; sincos_f(ang, s, c); cs[e] = c; sn[e] = s; }
}
__device__ __forceinline__ void norm_rows(Frame& F, const PA& A, const float* x, const float* g, bf16* hout) {
    const int gw = A.vcu * NWAVES + F.wave, NGW = A.G * NWAVES;
    for (int m = gw; m < M; m += NGW) {
        const GAS f32x4* xr = (const GAS f32x4*)(x + (size_t)m * DM) + F.lane; const GAS f32x4* gr = (const GAS f32x4*)g + F.lane;
        f32x4 v[16]; float s = 0.f;
#pragma unroll
        for (int j = 0; j < 16; ++j) { v[j] = xr[64 * j]; s += (v[j].x * v[j].x + v[j].y * v[j].y) + (v[j].z * v[j].z + v[j].w * v[j].w); }
        const float rstd = 1.0f / sqrtf(wave_sum(s) * (1.f / DM) + RMS_EPS);
        GAS unsigned long long* o8 = (GAS unsigned long long*)(hout + (size_t)m * DM) + F.lane;
#pragma unroll
        for (int j = 0; j < 16; ++j) { const f32x4 gg = gr[64 * j]; o8[64 * j] = (unsigned long long)pk2(v[j].x * rstd * gg.x, v[j].y * rstd * gg.y) | ((unsigned long long)pk2(v[j].z * rstd * gg.z, v[j].w * rstd * gg.w) << 32); }
    }
}
__device__ __forceinline__ void resid_norm_rows(Frame& F, const PA& A, const float* xsrc, const float* mo, const float* ga, float* xdst, const float* gb, bf16* hout) {
    const int gw = A.vcu * NWAVES + F.wave, NGW = A.G * NWAVES;
    for (int m = gw; m < M; m += NGW) {
        const GAS f32x4* mr = (const GAS f32x4*)(mo + (size_t)m * DM) + F.lane; const GAS f32x4* xr = (const GAS f32x4*)(xsrc + (size_t)m * DM) + F.lane;
        const GAS f32x4* gar = (const GAS f32x4*)ga + F.lane;
        f32x4 v[16]; float s = 0.f;
#pragma unroll
        for (int j = 0; j < 16; ++j) { v[j] = mr[64 * j]; s += (v[j].x * v[j].x + v[j].y * v[j].y) + (v[j].z * v[j].z + v[j].w * v[j].w); }
        const float rstd = 1.0f / sqrtf(wave_sum(s) * (1.f / DM) + RMS_EPS);
        GAS f32x4* xo = (GAS f32x4*)(xdst + (size_t)m * DM) + F.lane; float s2 = 0.f;
#pragma unroll
        for (int j = 0; j < 16; ++j) { const f32x4 gg = gar[64 * j]; const f32x4 xx = xr[64 * j]; f32x4 o;
            o.x = xx.x + v[j].x * rstd * gg.x; o.y = xx.y + v[j].y * rstd * gg.y; o.z = xx.z + v[j].z * rstd * gg.z; o.w = xx.w + v[j].w * rstd * gg.w;
            xo[64 * j] = o; v[j] = o; s2 += (o.x * o.x + o.y * o.y) + (o.z * o.z + o.w * o.w); }
        if (hout) {
            const float rstd2 = 1.0f / sqrtf(wave_sum(s2) * (1.f / DM) + RMS_EPS); const GAS f32x4* gbr = (const GAS f32x4*)gb + F.lane;
            GAS unsigned long long* o8 = (GAS unsigned long long*)(hout + (size_t)m * DM) + F.lane;
#pragma unroll
            for (int j = 0; j < 16; ++j) { const f32x4 gg = gbr[64 * j]; o8[64 * j] = (unsigned long long)pk2(v[j].x * rstd2 * gg.x, v[j].y * rstd2 * gg.y) | ((unsigned long long)pk2(v[j].z * rstd2 * gg.z, v[j].w * rstd2 * gg.w) << 32); }
        }
    }
}
__device__ __forceinline__ void mla_prep_rows(Frame& F, const PA& A, int l) {
    const int gw = A.vcu * NWAVES + F.wave, NGW = A.G * NWAVES;
    const bf16* P = (const bf16*)(A.ws + WS_PB); const float* misc = (const float*)(A.ws + WS_MISC);
    bf16* CQN = (bf16*)(A.ws + WS_CQN); bf16* CKVN = (bf16*)(A.ws + WS_CKVN); bf16* KR = (bf16*)(A.ws + WS_KR); float* LF = (float*)(A.ws + WS_LF);
    const float* cs = (const float*)(A.ws + WS_ROPE); const float* sn = cs + (size_t)M * 32;
    const float* gq = A.g_q_lora + (size_t)l * 1024; const float* gkv = A.g_kv_lora + (size_t)l * 512; const float* bf = A.b_forget + (size_t)l * 8;
    for (int m = gw; m < M; m += NGW) {
        const bf16* pr = P + (size_t)m * NIN;
        {
            const v4u a = *(const GAS v4u*)(pr + PC_CQ + 8 * F.lane), b = *(const GAS v4u*)(pr + PC_CQ + 512 + 8 * F.lane);
            float v[16] = {bfl(a.x), bfh(a.x), bfl(a.y), bfh(a.y), bfl(a.z), bfh(a.z), bfl(a.w), bfh(a.w), bfl(b.x), bfh(b.x), bfl(b.y), bfh(b.y), bfl(b.z), bfh(b.z), bfl(b.w), bfh(b.w)};
            float s = 0.f;
#pragma unroll
            for (int j = 0; j < 16; ++j) s += v[j] * v[j];
            const float rstd = 1.0f / sqrtf(wave_sum(s) * (1.f / 1024.f) + RMS_EPS);
            const f32x4 g0 = *(const GAS f32x4*)(gq + 8 * F.lane), g1 = *(const GAS f32x4*)(gq + 8 * F.lane + 4), g2 = *(const GAS f32x4*)(gq + 512 + 8 * F.lane), g3 = *(const GAS f32x4*)(gq + 512 + 8 * F.lane + 4);
            v4u o0, o1;
            o0.x = pk2(v[0] * rstd * g0.x, v[1] * rstd * g0.y); o0.y = pk2(v[2] * rstd * g0.z, v[3] * rstd * g0.w); o0.z = pk2(v[4] * rstd * g1.x, v[5] * rstd * g1.y); o0.w = pk2(v[6] * rstd * g1.z, v[7] * rstd * g1.w);
            o1.x = pk2(v[8] * rstd * g2.x, v[9] * rstd * g2.y); o1.y = pk2(v[10] * rstd * g2.z, v[11] * rstd * g2.w); o1.z = pk2(v[12] * rstd * g3.x, v[13] * rstd * g3.y); o1.w = pk2(v[14] * rstd * g3.z, v[15] * rstd * g3.w);
            *(GAS v4u*)(CQN + (size_t)m * 1024 + 8 * F.lane) = o0; *(GAS v4u*)(CQN + (size_t)m * 1024 + 512 + 8 * F.lane) = o1;
        }
        {
            const v4u a = *(const GAS v4u*)(pr + PC_CKV + 8 * F.lane);
            float v[8] = {bfl(a.x), bfh(a.x), bfl(a.y), bfh(a.y), bfl(a.z), bfh(a.z), bfl(a.w), bfh(a.w)};
            float s = 0.f;
#pragma unroll
            for (int j = 0; j < 8; ++j) s += v[j] * v[j];
            const float rstd = 1.0f / sqrtf(wave_sum(s) * (1.f / 512.f) + RMS_EPS);
            const f32x4 g0 = *(const GAS f32x4*)(gkv + 8 * F.lane), g1 = *(const GAS f32x4*)(gkv + 8 * F.lane + 4);
            v4u o0;
            o0.x = pk2(v[0] * rstd * g0.x, v[1] * rstd * g0.y); o0.y = pk2(v[2] * rstd * g0.z, v[3] * rstd * g0.w); o0.z = pk2(v[4] * rstd * g1.x, v[5] * rstd * g1.y); o0.w = pk2(v[6] * rstd * g1.z, v[7] * rstd * g1.w);
            *(GAS v4u*)(CKVN + (size_t)m * 512 + 8 * F.lane) = o0;
        }
        const float* mr = misc + (size_t)m * 256;
        if (F.lane < 32) { const int i = F.lane; const float x1 = mr[i], x2 = mr[32 + i], c = cs[(size_t)m * 32 + i], s = sn[(size_t)m * 32 + i];
            *(GAS unsigned*)(KR + (size_t)m * 64 + 2 * i) = pk2(x1 * c - x2 * s, x2 * c + x1 * s); }
        else if (F.lane < 40) { const int h = F.lane - 32; const float z = mr[64 + h] + bf[h];
            LF[(size_t)m * 8 + h] = fminf(z, 0.f) - log1pf(expf(-fabsf(z))); }
    }
}
__device__ __forceinline__ void fox_scan(Frame& F, const PA& A) {
    const int gw = A.vcu * NWAVES + F.wave;
    if (gw >= NBATCH * 8) return;
    const int b = gw >> 3, h = gw & 7;
    const float* LF = (const float*)(A.ws + WS_LF) + ((size_t)b * SEQ + 32 * F.lane) * 8 + h; float* FC = (float*)(A.ws + WS_FC) + ((size_t)b * SEQ + 32 * F.lane) * 8 + h;
    float v[32]; float run = 0.f;
#pragma unroll
    for (int j = 0; j < 32; ++j) { run += LF[j * 8]; v[j] = run; }
    float incl = run;
#pragma unroll
    for (int o = 1; o < 64; o <<= 1) { const float t = __shfl_up(incl, o); if (F.lane >= o) incl += t; }
    const float excl = incl - run;
#pragma unroll
    for (int j = 0; j < 32; ++j) FC[j * 8] = v[j] + excl;
}

template <int TYPE>
__device__ __forceinline__ void naive_attn_unit(const PA& A, int l, int m, int head, LAS float* qs, LAS float* sc, int lane) {
    constexpr int DK = TYPE == 0 ? 192 : 128;
    const int b = m / SEQ, t = m - b * SEQ;
    const bf16* P = (const bf16*)(A.ws + WS_PB);
    const float scale = TYPE == 0 ? 0.07216878364870323f : 0.08838834764831845f;
    if (TYPE == 0) { const bf16* qn = (const bf16*)(A.ws + WS_QN) + (size_t)m * 1024 + 128 * head; const bf16* qr = (const bf16*)(A.ws + WS_QR) + (size_t)m * 512 + 64 * head;
        qs[lane] = bfl((unsigned)qn[lane]) * scale; qs[64 + lane] = bfl((unsigned)qn[64 + lane]) * scale; qs[128 + lane] = bfl((unsigned)qr[lane]) * scale; }
    else { const bf16* q = P + (size_t)m * NIN + (TYPE == 1 ? PC_QSWA : PC_QFOX) + 128 * head; qs[lane] = bfl((unsigned)q[lane]) * scale; qs[64 + lane] = bfl((unsigned)q[64 + lane]) * scale; }
    LDS_WAIT(); asm volatile("" ::: "memory");
    const int s_lo = TYPE == 1 ? (t >= 127 ? t - 127 : 0) : 0;
    const int nk = t - s_lo + 1;
    const float slope = TYPE == 1 ? exp2f(-8.0f * (float)(head + 1) / 16.0f) : 0.f;
    const float sink = TYPE == 1 ? A.swa_sinks[l * 16 + head] : 0.f;
    const float* FC = (const float*)(A.ws + WS_FC);
    float mx = -3.0e38f;
    for (int i = lane; i < nk; i += 64) {
        const int s = s_lo + i; const size_t row = (size_t)b * SEQ + s;
        float dot = 0.f;
        if (TYPE == 0) {
            const bf16* kn = (const bf16*)(A.ws + WS_KN) + row * 1024 + 128 * head; const bf16* kr = (const bf16*)(A.ws + WS_KR) + row * 64;
            for (int d = 0; d < 128; d += 8) { const v4u w = *(const GAS v4u*)(kn + d); const LAS float* q = qs + d;
                dot += q[0] * bfl(w.x) + q[1] * bfh(w.x) + q[2] * bfl(w.y) + q[3] * bfh(w.y) + q[4] * bfl(w.z) + q[5] * bfh(w.z) + q[6] * bfl(w.w) + q[7] * bfh(w.w); }
            for (int d = 0; d < 64; d += 8) { const v4u w = *(const GAS v4u*)(kr + d); const LAS float* q = qs + 128 + d;
                dot += q[0] * bfl(w.x) + q[1] * bfh(w.x) + q[2] * bfl(w.y) + q[3] * bfh(w.y) + q[4] * bfl(w.z) + q[5] * bfh(w.z) + q[6] * bfl(w.w) + q[7] * bfh(w.w); }
        } else {
            const bf16* k = P + row * NIN + (TYPE == 1 ? PC_KSWA + 128 * (head >> 3) : PC_KFOX + 128 * head);
            for (int d = 0; d < 128; d += 8) { const v4u w = *(const GAS v4u*)(k + d); const LAS float* q = qs + d;
                dot += q[0] * bfl(w.x) + q[1] * bfh(w.x) + q[2] * bfl(w.y) + q[3] * bfh(w.y) + q[4] * bfl(w.z) + q[5] * bfh(w.z) + q[6] * bfl(w.w) + q[7] * bfh(w.w); }
            if (TYPE == 1) dot -= slope * (float)(A.pos[m] - A.pos[row]);
            if (TYPE == 2) dot += FC[(size_t)m * 8 + head] - FC[row * 8 + head];
        }
        sc[i] = dot; mx = fmaxf(mx, dot);
    }
    mx = wave_max(mx); if (TYPE == 1) mx = fmaxf(mx, sink);
    float sum = 0.f;
    for (int i = lane; i < nk; i += 64) { const float e = __expf(sc[i] - mx); sc[i] = e; sum += e; }
    sum = wave_sum(sum); if (TYPE == 1) sum += __expf(sink - mx);
    LDS_WAIT(); asm volatile("" ::: "memory");
    const bf16* vbase; int ldv;
    if (TYPE == 0) { vbase = (const bf16*)(A.ws + WS_VM) + 128 * head; ldv = 1024; } else if (TYPE == 1) { vbase = P + PC_VSWA + 128 * (head >> 3); ldv = NIN; } else { vbase = P + PC_VFOX + 128 * head; ldv = NIN; }
    vbase += ((size_t)b * SEQ + s_lo) * ldv + 2 * lane;
    float o0 = 0.f, o1 = 0.f;
    int i = 0;
    for (; i + 4 <= nk; i += 4) {
        const unsigned w0 = *(const GAS unsigned*)(vbase + (size_t)(i + 0) * ldv), w1 = *(const GAS unsigned*)(vbase + (size_t)(i + 1) * ldv), w2 = *(const GAS unsigned*)(vbase + (size_t)(i + 2) * ldv), w3 = *(const GAS unsigned*)(vbase + (size_t)(i + 3) * ldv);
        const float p0 = sc[i], p1 = sc[i + 1], p2 = sc[i + 2], p3 = sc[i + 3];
        o0 += p0 * bfl(w0) + p1 * bfl(w1) + p2 * bfl(w2) + p3 * bfl(w3); o1 += p0 * bfh(w0) + p1 * bfh(w1) + p2 * bfh(w2) + p3 * bfh(w3);
    }
    for (; i < nk; ++i) { const unsigned w0 = *(const GAS unsigned*)(vbase + (size_t)i * ldv); const float p0 = sc[i]; o0 += p0 * bfl(w0); o1 += p0 * bfh(w0); }
    const float inv = 1.0f / sum;
    bf16* op; if (TYPE == 0) op = (bf16*)(A.ws + WS_OM) + (size_t)m * 1024 + 128 * head; else if (TYPE == 1) op = (bf16*)(A.ws + WS_OS) + (size_t)m * 2048 + 128 * head; else op = (bf16*)(A.ws + WS_OF) + (size_t)m * 1024 + 128 * head;
    *(GAS unsigned*)(op + 2 * lane) = pk2(o0 * inv, o1 * inv);
    LDS_WAIT(); asm volatile("" ::: "memory");
}
__device__ __forceinline__ void naive_attn_phase(Frame& F, const PA& A, int l) {
    LAS float* qs = (LAS float*)(F.lds + RING_OFF + F.wave * 9216); LAS float* sc = qs + 256;
    const int gw = A.vcu * NWAVES + F.wave, NGW = A.G * NWAVES;
    for (int u = gw; u < M * 32; u += NGW) {
        const int head = (u + (u >> 11)) & 31, m = u >> 5;
        if (head < 8) naive_attn_unit<0>(A, l, m, head, qs, sc, F.lane);
        else if (head < 24) naive_attn_unit<1>(A, l, m, head - 8, qs, sc, F.lane);
        else naive_attn_unit<2>(A, l, m, head - 24, qs, sc, F.lane);
    }
}

constexpr int PH_PER_LAYER = 10, N_PHASES = 1 + DEPTH * PH_PER_LAYER;
#ifndef PHMASK
#define PHMASK 0x7ff
#endif
__device__ __forceinline__ Frame make_frame(LAS unsigned char* lds) {
    Frame F; F.lds = lds; int t = threadIdx.x; asm volatile("" : "+v"(t)); F.tid = t; F.lane = t & 63; F.wave = __builtin_amdgcn_readfirstlane(t >> 6); return F;
}
#define IN(k) (((PHMASK >> ((k) == 0 ? 10 : ((k) - 1) % PH_PER_LAYER)) & 1) && lo <= (k) && (k) < hi)
#define SEAM(k) do { if (IN(k) && IN((k) + 1)) { if (!MK_PER_PHASE) xcd_barrier(bar); } } while (0)
#define WSP(T, off) ((T)(A.ws + (off)))
#define PHASE_BEGIN const PA A = load_args(argw); Frame F = make_frame(ldsb)
template <int l>
__device__ __forceinline__ void layer_phases(LAS unsigned char* ldsb, const LAS unsigned* argw, const XcdBarrier& bar, const int lo, const int hi) {
        constexpr int pb = 1 + l * PH_PER_LAYER;
        if (IN(pb + 0)) {
            PHASE_BEGIN; unsigned char* wl = A.ws + WS_W + (size_t)l * WL_SIZE;
            pg8::Gemm g{WSP(const bf16*, WS_HB), (const bf16*)(wl + WL_WIN), M, NIN, DM}; pg8::StaticOrder S; S.init(M, NIN, A.G, A.bx);
            pg8::EpiInproj E{WSP(bf16*, WS_PB), WSP(float*, WS_MISC), NIN, GATE_TILE0};
            pg8::gemm_phase<pg8::EpiInproj, pg8::StaticOrder, true, true>(F.lds + RING_OFF, g, S, E);
        }
        SEAM(pb + 0);
        if (IN(pb + 1)) { PHASE_BEGIN; mla_prep_rows(F, A, l); }
        SEAM(pb + 1);
        if (IN(pb + 2)) {
            { PHASE_BEGIN; fox_scan(F, A); }
            { PHASE_BEGIN; unsigned char* wl = A.ws + WS_W + (size_t)l * WL_SIZE;
              pg8::Gemm g{WSP(const bf16*, WS_CQN), (const bf16*)(wl + WL_WUQ), M, 1536, 1024}; pg8::StaticOrder S; S.init(M, 1536, A.G, A.bx);
              pg8::EpiQup E{WSP(bf16*, WS_QN), WSP(bf16*, WS_QR), WSP(const float*, WS_ROPE), WSP(const float*, WS_ROPE) + (size_t)M * 32};
              pg8::gemm_phase<pg8::EpiQup, pg8::StaticOrder, true, true>(F.lds + RING_OFF, g, S, E); }
            __syncthreads();
            { PHASE_BEGIN; unsigned char* wl = A.ws + WS_W + (size_t)l * WL_SIZE;
              pg8::Gemm g{WSP(const bf16*, WS_CKVN), (const bf16*)(wl + WL_WUKV), M, 2048, 512}; pg8::StaticOrder S; S.init(M, 2048, A.G, A.bx);
              pg8::EpiSplitBf16 E{WSP(bf16*, WS_KN), WSP(bf16*, WS_VM), 4, 1024};
              pg8::gemm_phase<pg8::EpiSplitBf16, pg8::StaticOrder, true, true>(F.lds + RING_OFF, g, S, E); }
        }
        SEAM(pb + 2);
        if (IN(pb + 3)) { PHASE_BEGIN; naive_attn_phase(F, A, l); }
        SEAM(pb + 3);
        if (IN(pb + 4)) {
            { PHASE_BEGIN; const bf16* WB = (const bf16*)(A.ws + WS_W + (size_t)l * WL_SIZE + WL_WB);
              pg8::Gemm g{WSP(const bf16*, WS_OM), WB, M, DM, 1024}; pg8::StaticOrder S; S.init(M, DM, A.G, A.bx);
              pg8::EpiBranch<0> E{WSP(const bf16*, WS_PB) + PC_GATE, NIN, WSP(float*, WS_TM), WSP(bf16*, WS_HB), DM};
              pg8::gemm_phase<pg8::EpiBranch<0>, pg8::StaticOrder, true, true>(F.lds + RING_OFF, g, S, E); }
            __syncthreads();
            { PHASE_BEGIN; const bf16* WB = (const bf16*)(A.ws + WS_W + (size_t)l * WL_SIZE + WL_WB);
              pg8::Gemm g{WSP(const bf16*, WS_OS), WB + (size_t)DM * 1024, M, DM, 2048}; pg8::StaticOrder S; S.init(M, DM, A.G, A.bx);
              pg8::EpiBranch<1> E{WSP(const bf16*, WS_PB) + PC_GATE + DM, NIN, WSP(float*, WS_TM), WSP(bf16*, WS_HB), DM};
              pg8::gemm_phase<pg8::EpiBranch<1>, pg8::StaticOrder, true, true>(F.lds + RING_OFF, g, S, E); }
            __syncthreads();
            { PHASE_BEGIN; const bf16* WB = (const bf16*)(A.ws + WS_W + (size_t)l * WL_SIZE + WL_WB);
              pg8::Gemm g{WSP(const bf16*, WS_OF), WB + (size_t)DM * 3072, M, DM, 1024}; pg8::StaticOrder S; S.init(M, DM, A.G, A.bx);
              pg8::EpiBranch<2> E{WSP(const bf16*, WS_PB) + PC_GATE + 2 * DM, NIN, WSP(float*, WS_TM), WSP(bf16*, WS_HB), DM};
              pg8::gemm_phase<pg8::EpiBranch<2>, pg8::StaticOrder, true, true>(F.lds + RING_OFF, g, S, E); }
        }
        SEAM(pb + 4);
        if (IN(pb + 5)) {
            PHASE_BEGIN; unsigned char* wl = A.ws + WS_W + (size_t)l * WL_SIZE;
            pg8::Gemm g{WSP(const bf16*, WS_HB), (const bf16*)(wl + WL_WOUT), M, DM, DM}; pg8::StaticOrder S; S.init(M, DM, A.G, A.bx);
            pg8::EpiF32 E{WSP(float*, WS_TM), DM};
            pg8::gemm_phase<pg8::EpiF32, pg8::StaticOrder, true, true>(F.lds + RING_OFF, g, S, E);
        }
        SEAM(pb + 5);
        if (IN(pb + 6)) { PHASE_BEGIN; resid_norm_rows(F, A, l == 0 ? A.x : A.out, WSP(const float*, WS_TM), A.g_mix_post + (size_t)l * DM, A.out, A.g_ffn_pre + (size_t)l * DM, WSP(bf16*, WS_HB)); }
        SEAM(pb + 6);
        if (IN(pb + 7)) {
            PHASE_BEGIN; unsigned char* wl = A.ws + WS_W + (size_t)l * WL_SIZE;
            pg8::Gemm g{WSP(const bf16*, WS_HB), (const bf16*)(wl + WL_WGU), M, 2 * FF, DM}; pg8::StaticOrder S; S.init(M, 2 * FF, A.G, A.bx);
            pg8::EpiSwiglu E{WSP(bf16*, WS_PB), FF};
            pg8::gemm_phase<pg8::EpiSwiglu, pg8::StaticOrder, true, true>(F.lds + RING_OFF, g, S, E);
        }
        SEAM(pb + 7);
        if (IN(pb + 8)) {
            PHASE_BEGIN; unsigned char* wl = A.ws + WS_W + (size_t)l * WL_SIZE;
            pg8::Gemm g{WSP(const bf16*, WS_PB), (const bf16*)(wl + WL_WD), M, DM, FF}; pg8::StaticOrder S; S.init(M, DM, A.G, A.bx);
            pg8::EpiF32 E{WSP(float*, WS_TM), DM};
            pg8::gemm_phase<pg8::EpiF32, pg8::StaticOrder, true, true>(F.lds + RING_OFF, g, S, E);
        }
        SEAM(pb + 8);
        if (IN(pb + 9)) { PHASE_BEGIN;
            resid_norm_rows(F, A, A.out, WSP(const float*, WS_TM), A.g_ffn_post + (size_t)l * DM, A.out, A.g_mix_pre + (size_t)(l + 1 < DEPTH ? l + 1 : l) * DM, l + 1 < DEPTH ? WSP(bf16*, WS_HB) : (bf16*)nullptr); }
        SEAM(pb + 9);
}
__global__ void __launch_bounds__(NWAVES * 64, 2) fwd_kernel(Ptrs A0) {
    extern __shared__ __attribute__((aligned(16))) unsigned char lds[];
    LAS unsigned char* ldsb = (LAS unsigned char*)lds;
    LAS unsigned* argw = (LAS unsigned*)(ldsb + LDSCTL_OFF);
    volatile LAS unsigned* MISC = (volatile LAS unsigned*)(ldsb + MISC_OFF);
    for (int u = threadIdx.x; u < (LDS_BYTES - LDSCTL_OFF) / 4; u += NWAVES * 64) ((LAS unsigned*)(ldsb + LDSCTL_OFF))[u] = 0u;
    __syncthreads();
    if (threadIdx.x == 0) park_args(A0, argw);
    const int lo = A0.ph_lo, hi = A0.ph_hi;
    unsigned* barw = (unsigned*)(A0.ws + WS_CTL) + CW_BAR;
    __syncthreads();
    XcdBarrier bar; bar.bar = barw; bar.x = 0; bar.st = nullptr;
    if (!MK_PER_PHASE) bar = xcd_barrier_post(barw, MISC + 8);

    if (IN(0)) { PHASE_BEGIN; p0_convert(F, A); norm_rows(F, A, A.x, A.g_mix_pre, WSP(bf16*, WS_HB)); }
    SEAM(0);
    layer_phases<0>(ldsb, argw, bar, lo, hi);
    layer_phases<1>(ldsb, argw, bar, lo, hi);
    static_assert(DEPTH == 2, "two layers written out");
}
#undef IN
#undef SEAM
#undef WSP
#undef PHASE_BEGIN

extern "C" void kernel_launch(void* const* d_in, const int* in_sizes, int n_in, void* d_out, int out_size, void* d_ws, size_t ws_size, hipStream_t stream) {
    static int grid = 0;
    if (grid == 0) {
        if (n_in != 17 || in_sizes[0] != M * DM || out_size != M * DM || ws_size < WS_END) { fprintf(stderr, "kernel_launch: unexpected shapes (n_in %d, in0 %d, out %d, ws %zu < %zu); nothing launched\n", n_in, n_in > 0 ? in_sizes[0] : -1, out_size, ws_size, (size_t)WS_END); grid = -1; return; }
        int dev = 0, cus = 0, per_cu = 0;
        if (hipGetDevice(&dev) != hipSuccess || hipDeviceGetAttribute(&cus, hipDeviceAttributeMultiprocessorCount, dev) != hipSuccess) { fprintf(stderr, "kernel_launch: device query failed\n"); grid = -1; return; }
        if (hipFuncSetAttribute((const void*)fwd_kernel, hipFuncAttributeMaxDynamicSharedMemorySize, LDS_BYTES) != hipSuccess) { fprintf(stderr, "kernel_launch: hipFuncSetAttribute failed\n"); grid = -1; return; }
        if (hipOccupancyMaxActiveBlocksPerMultiprocessor(&per_cu, (const void*)fwd_kernel, NWAVES * 64, LDS_BYTES) != hipSuccess || per_cu < 1) { fprintf(stderr, "kernel_launch: occupancy query reports %d workgroups per CU\n", per_cu); }
        (void)hipGetLastError();
        grid = cus;
    }
    if (grid < 0) return;
    if (hipMemsetAsync((char*)d_ws + WS_CTL, 0, CTL_ZERO_BYTES, stream) != hipSuccess) { fprintf(stderr, "kernel_launch: memset failed\n"); return; }
    Ptrs a{};
    a.x = (const float*)d_in[0]; a.pos = (const int*)d_in[1]; a.g_mix_pre = (const float*)d_in[2]; a.g_mix_post = (const float*)d_in[3]; a.g_ffn_pre = (const float*)d_in[4]; a.g_ffn_post = (const float*)d_in[5];
    a.w_in = (const float*)d_in[6]; a.g_q_lora = (const float*)d_in[7]; a.w_uq = (const float*)d_in[8]; a.g_kv_lora = (const float*)d_in[9]; a.w_ukv = (const float*)d_in[10]; a.b_forget = (const float*)d_in[11];
    a.swa_sinks = (const float*)d_in[12]; a.w_branch = (const float*)d_in[13]; a.w_out = (const float*)d_in[14]; a.w_gate_up = (const float*)d_in[15]; a.w_down = (const float*)d_in[16];
    a.out = (float*)d_out; a.ws = (unsigned char*)d_ws;
#if MK_PER_PHASE
    for (int k = 0; k < N_PHASES; ++k) { a.ph_lo = k; a.ph_hi = k + 1; hipLaunchKernelGGL(fwd_kernel, dim3(grid), dim3(NWAVES * 64), LDS_BYTES, stream, a); }
#else
    a.ph_lo = 0; a.ph_hi = N_PHASES; hipLaunchKernelGGL(fwd_kernel, dim3(grid), dim3(NWAVES * 64), LDS_BYTES, stream, a);
#endif
    const hipError_t le = hipPeekAtLastError();
    if (le != hipSuccess) fprintf(stderr, "kernel_launch: launch failed: %s\n", hipGetErrorName(le));
}
```

```cpp
#include <hip/hip_runtime.h>
#include <cstdio>
#include <cstdint>
namespace pg8 {
#define PG8_LAS __attribute__((address_space(3)))
typedef unsigned short bf16_t;
typedef short bf16x8 __attribute__((ext_vector_type(8)));
typedef float f32x4 __attribute__((ext_vector_type(4)));
typedef unsigned u32x4 __attribute__((ext_vector_type(4)));
constexpr int BM = 256, BK = 64, HALF = 128, HTB = HALF * BK * 2  , STAGE_BYTES = 8 * HTB, NXCD = 8, WGM = 8;

__host__ __device__ __forceinline__ int lds_byte(int r, int c) { const int st = (r >> 4) * 2 + (c >> 5), rr = r & 15, cc = c & 31, ob = rr * 64 + cc * 2; return st * 1024 + (ob ^ (((ob >> 9) & 1) << 5)); }
__host__ __device__ __forceinline__ void stage_rc(int b, int& R, int& C) { const int st = b / 1024, sb = b % 1024, swz = sb ^ (((sb >> 9) & 1) << 5); R = (st >> 1) * 16 + swz / 64; C = (st & 1) * 32 + (swz % 64) / 2; }
__host__ __device__ __forceinline__ int perm32(int rho) { const int n = rho >> 4, i = rho & 15; return 8 * (i >> 2) + 4 * n + (i & 3); }

struct Unit { int pm, pn; };
struct Gemm { const bf16_t* A; const bf16_t* Bt; int M, N, K; };

struct StaticOrder {
    int nM, nN, nwg, G, c;
    __host__ __device__ void init(int M, int N, int G_, int c_) { nM = M / BM; nN = N / BM; nwg = nM * nN; G = G_; c = c_; }
    __host__ __device__ bool next(int i, Unit& u) const {
        const long L = (long)i * G + c; if (L >= nwg) return false;
        int wgid = (int)L; { const int q = nwg / NXCD, r = nwg % NXCD, xcd = wgid % NXCD, off = wgid / NXCD; wgid = (xcd < r ? xcd * (q + 1) : r * (q + 1) + (xcd - r) * q) + off; }
        const int nig = WGM * nN, gid = wgid / nig, fm = gid * WGM, gsz = (nM - fm) < WGM ? (nM - fm) : WGM;
        u.pm = fm + ((wgid % nig) % gsz); u.pn = (wgid % nig) / gsz; return true;
    }
    __device__ __forceinline__ void a_ready(const Unit&) const {}
    __device__ __forceinline__ void done(const Unit&) const {}
};
struct RangeOrder {
    StaticOrder S; int i0, i1;
    __host__ __device__ bool next(int i, Unit& u) const { return (i0 + i < i1) && S.next(i0 + i, u); }
    __device__ __forceinline__ void a_ready(const Unit&) const {}
    __device__ __forceinline__ void done(const Unit&) const {}
};
__device__ __forceinline__ unsigned cvt_pk_bf16(float lo, float hi) { unsigned r; asm volatile("v_cvt_pk_bf16_f32 %0, %1, %2" : "=v"(r) : "v"(lo), "v"(hi)); return r; }
typedef float f32x2 __attribute__((ext_vector_type(2)));
__device__ __forceinline__ float sigmoid_f(float v) { return __builtin_amdgcn_rcpf(1.0f + __builtin_amdgcn_exp2f(-1.4426950408889634f * v)); }
__device__ __forceinline__ u32x4 pack8_bf16(const f32x4 v0, const f32x4 v1) { u32x4 w; w.x = cvt_pk_bf16(v0[0], v0[1]); w.y = cvt_pk_bf16(v0[2], v0[3]); w.z = cvt_pk_bf16(v1[0], v1[1]); w.w = cvt_pk_bf16(v1[2], v1[3]); return w; }
__device__ __forceinline__ float bf_lo(unsigned w) { return __uint_as_float(w << 16); }
__device__ __forceinline__ float bf_hi(unsigned w) { return __uint_as_float(w & 0xffff0000u); }

__device__ __forceinline__ size_t gate_tile_elem(int gt, int pm, int wr, int wc, int fr, int fq) {
    const int i = gt >> 4, pn = gt & 15;
    return ((size_t)((i * 64 + pm) * 16 + pn) * 8 + (wr * 4 + wc)) * 8192 + (size_t)(fq * 16 + fr) * 8;
}
typedef unsigned v4u32_t __attribute__((__vector_size__(16)));
__device__ __forceinline__ void st_wt16(u32x4 v, __amdgpu_buffer_rsrc_t rsrc, int byte_off) { __builtin_amdgcn_raw_buffer_store_b128(__builtin_bit_cast(v4u32_t, v), rsrc, byte_off, 0, 16); }
struct EpiInproj {
    static constexpr bool PERM = true, AFTER_DRAIN = false, HAS_MID = false;
    bf16_t* P; float* misc; int ldp; int gate_t0; bf16_t* GT; PG8_LAS const float* rsl; int gt_bytes;
    __device__ __forceinline__ void operator()(const f32x4 (&acc)[2][2][4][2], const Unit& u, int wr, int wc, int fr, int fq) const {
        const int row0 = u.pm * BM + wr * 64 + fr, cl = wc * 32 + 8 * fq;
#define PG8_LOAD_RS float rs[2][4]; _Pragma("unroll") for (int ai = 0; ai < 2; ++ai) _Pragma("unroll") for (int m = 0; m < 4; ++m) rs[ai][m] = rsl[(u.pm & 7) * BM + wr * 64 + fr + ai * HALF + m * 16];
        if (u.pn == 6) {
            PG8_LOAD_RS
#pragma unroll
            for (int ai = 0; ai < 2; ++ai)
#pragma unroll
                for (int m = 0; m < 4; ++m) { float* rowp = misc + (size_t)(row0 + ai * HALF + m * 16) * 256 + cl;
#pragma unroll
                    for (int bj = 0; bj < 2; ++bj) { *(f32x4*)(rowp + bj * HALF) = acc[ai][bj][m][0] * rs[ai][m]; *(f32x4*)(rowp + bj * HALF + 4) = acc[ai][bj][m][1] * rs[ai][m]; } }
        } else if (u.pn < gate_t0) {
            PG8_LOAD_RS
#pragma unroll
            for (int ai = 0; ai < 2; ++ai)
#pragma unroll
                for (int m = 0; m < 4; ++m) { bf16_t* rowp = P + (size_t)(row0 + ai * HALF + m * 16) * ldp + u.pn * BM + cl;
#pragma unroll
                    for (int bj = 0; bj < 2; ++bj) *(u32x4*)(rowp + bj * HALF) = pack8_bf16(acc[ai][bj][m][0] * rs[ai][m], acc[ai][bj][m][1] * rs[ai][m]); }
        } else {
            PG8_LOAD_RS
            const size_t tpo = gate_tile_elem(u.pn - gate_t0, u.pm, wr, wc, fr, fq);
            const __amdgpu_buffer_rsrc_t gt_rsrc = __builtin_amdgcn_make_buffer_rsrc((void*)GT, 0, gt_bytes, 0x00020000);
#pragma unroll
            for (int ai = 0; ai < 2; ++ai)
#pragma unroll
                for (int m = 0; m < 4; ++m)
#pragma unroll
                    for (int bj = 0; bj < 2; ++bj) { f32x4 v0 = acc[ai][bj][m][0] * rs[ai][m], v1 = acc[ai][bj][m][1] * rs[ai][m];
#pragma unroll
                        for (int e = 0; e < 4; ++e) { v0[e] = fmaxf(sigmoid_f(v0[e]), 1e-20f); v1[e] = fmaxf(sigmoid_f(v1[e]), 1e-20f); }
                        st_wt16(pack8_bf16(v0, v1), gt_rsrc, (int)(tpo + (size_t)(((ai * 4 + m) * 2 + bj) * 512)) * 2); }
        }
    }
};
#undef PG8_LOAD_RS
struct EpiSplitBf16 {
    static constexpr bool PERM = true, AFTER_DRAIN = false, HAS_MID = false;
    bf16_t* O0; bf16_t* O1; int split; int ldc;
    __device__ __forceinline__ void operator()(const f32x4 (&acc)[2][2][4][2], const Unit& u, int wr, int wc, int fr, int fq) const {
        const int row0 = u.pm * BM + wr * 64 + fr; bf16_t* base = u.pn < split ? O0 : O1; const int col0 = (u.pn < split ? u.pn : u.pn - split) * BM + wc * 32 + 8 * fq;
#pragma unroll
        for (int ai = 0; ai < 2; ++ai)
#pragma unroll
            for (int m = 0; m < 4; ++m) { bf16_t* rowp = base + (size_t)(row0 + ai * HALF + m * 16) * ldc + col0;
#pragma unroll
                for (int bj = 0; bj < 2; ++bj) *(u32x4*)(rowp + bj * HALF) = pack8_bf16(acc[ai][bj][m][0], acc[ai][bj][m][1]); }
    }
};
struct EpiQup {
    static constexpr bool PERM = true, AFTER_DRAIN = false, HAS_MID = false;
    bf16_t* QN; bf16_t* QR; const float* cs; const float* sn;
    __device__ __forceinline__ void operator()(const f32x4 (&acc)[2][2][4][2], const Unit& u, int wr, int wc, int fr, int fq) const {
        const int row0 = u.pm * BM + wr * 64 + fr;
        if (u.pn < 4) {
            const int col0 = u.pn * BM + wc * 32 + 8 * fq;
#pragma unroll
            for (int ai = 0; ai < 2; ++ai)
#pragma unroll
                for (int m = 0; m < 4; ++m) { bf16_t* rowp = QN + (size_t)(row0 + ai * HALF + m * 16) * 1024 + col0;
#pragma unroll
                    for (int bj = 0; bj < 2; ++bj) *(u32x4*)(rowp + bj * HALF) = pack8_bf16(acc[ai][bj][m][0], acc[ai][bj][m][1]); }
        } else {
            const int col0 = (u.pn - 4) * BM + wc * 32 + 8 * fq;
#pragma unroll
            for (int ai = 0; ai < 2; ++ai)
#pragma unroll
                for (int m = 0; m < 4; ++m) { const int row = row0 + ai * HALF + m * 16;
#pragma unroll
                    for (int bj = 0; bj < 2; ++bj) { const int c = col0 + bj * HALF, i0 = (c & 63) >> 1;
                        const f32x4 cv = *(const f32x4*)(cs + (size_t)row * 32 + i0), sv = *(const f32x4*)(sn + (size_t)row * 32 + i0);
                        const f32x4 a = acc[ai][bj][m][0], b = acc[ai][bj][m][1]; f32x4 o0, o1;
                        o0[0] = a[0] * cv[0] - a[1] * sv[0]; o0[1] = a[1] * cv[0] + a[0] * sv[0]; o0[2] = a[2] * cv[1] - a[3] * sv[1]; o0[3] = a[3] * cv[1] + a[2] * sv[1];
                        o1[0] = b[0] * cv[2] - b[1] * sv[2]; o1[1] = b[1] * cv[2] + b[0] * sv[2]; o1[2] = b[2] * cv[3] - b[3] * sv[3]; o1[3] = b[3] * cv[3] + b[2] * sv[3];
                        *(u32x4*)(QR + (size_t)row * 512 + c) = pack8_bf16(o0, o1); } }
        }
    }
};
template <int MODE> struct EpiBranch {
    static constexpr bool PERM = true, AFTER_DRAIN = false, HAS_MID = false;
    const bf16_t* G; int ldg; float* T; bf16_t* MRG; int ldc;
    __device__ __forceinline__ void operator()(const f32x4 (&acc)[2][2][4][2], const Unit& u, int wr, int wc, int fr, int fq) const {
        const int row0 = u.pm * BM + wr * 64 + fr, col0 = u.pn * BM + wc * 32 + 8 * fq;
#pragma unroll
        for (int ai = 0; ai < 2; ++ai)
#pragma unroll
            for (int m = 0; m < 4; ++m) { const size_t row = (size_t)(row0 + ai * HALF + m * 16);
#pragma unroll
                for (int bj = 0; bj < 2; ++bj) { const int c = col0 + bj * HALF;
                    const u32x4 gw = *(const u32x4*)(G + row * ldg + c);
                    f32x4 v0 = acc[ai][bj][m][0], v1 = acc[ai][bj][m][1];
                    v0[0] *= bf_lo(gw.x); v0[1] *= bf_hi(gw.x); v0[2] *= bf_lo(gw.y); v0[3] *= bf_hi(gw.y);
                    v1[0] *= bf_lo(gw.z); v1[1] *= bf_hi(gw.z); v1[2] *= bf_lo(gw.w); v1[3] *= bf_hi(gw.w);
                    float* tp = T + row * ldc + c;
                    if (MODE >= 1) { v0 += *(const f32x4*)tp; v1 += *(const f32x4*)(tp + 4); }
                    if (MODE <= 1) { *(f32x4*)tp = v0; *(f32x4*)(tp + 4) = v1; }
                    else *(u32x4*)(MRG + row * ldc + c) = pack8_bf16(v0, v1); } }
    }
};
__device__ __forceinline__ void gate_load8(u32x4 (&g)[8], const bf16_t* tpm) {
    asm volatile(
        "global_load_dwordx4 %0, %8, off offset:-4096\n\t"  "global_load_dwordx4 %1, %8, off offset:-3072\n\t"
        "global_load_dwordx4 %2, %8, off offset:-2048\n\t"  "global_load_dwordx4 %3, %8, off offset:-1024\n\t"
        "global_load_dwordx4 %4, %8, off\n\t"               "global_load_dwordx4 %5, %8, off offset:1024\n\t"
        "global_load_dwordx4 %6, %8, off offset:2048\n\t"   "global_load_dwordx4 %7, %8, off offset:3072\n\t"
        "s_waitcnt vmcnt(0)"
        : "=&v"(g[0]), "=&v"(g[1]), "=&v"(g[2]), "=&v"(g[3]), "=&v"(g[4]), "=&v"(g[5]), "=&v"(g[6]), "=&v"(g[7])
        : "v"(tpm) : "memory");
}
__device__ __forceinline__ void gate_load16(u32x4 (&g)[16], const bf16_t* tp) {
    const bf16_t* tpa = tp + 4 * 512; const bf16_t* tpb = tp + 12 * 512;
    asm volatile(
        "global_load_dwordx4 %0, %16, off offset:-4096\n\t"  "global_load_dwordx4 %1, %16, off offset:-3072\n\t"
        "global_load_dwordx4 %2, %16, off offset:-2048\n\t"  "global_load_dwordx4 %3, %16, off offset:-1024\n\t"
        "global_load_dwordx4 %4, %16, off\n\t"               "global_load_dwordx4 %5, %16, off offset:1024\n\t"
        "global_load_dwordx4 %6, %16, off offset:2048\n\t"   "global_load_dwordx4 %7, %16, off offset:3072\n\t"
        "global_load_dwordx4 %8, %17, off offset:-4096\n\t"  "global_load_dwordx4 %9, %17, off offset:-3072\n\t"
        "global_load_dwordx4 %10, %17, off offset:-2048\n\t" "global_load_dwordx4 %11, %17, off offset:-1024\n\t"
        "global_load_dwordx4 %12, %17, off\n\t"              "global_load_dwordx4 %13, %17, off offset:1024\n\t"
        "global_load_dwordx4 %14, %17, off offset:2048\n\t"  "global_load_dwordx4 %15, %17, off offset:3072\n\t"
        "s_waitcnt vmcnt(0)"
        : "=&v"(g[0]), "=&v"(g[1]), "=&v"(g[2]), "=&v"(g[3]), "=&v"(g[4]), "=&v"(g[5]), "=&v"(g[6]), "=&v"(g[7]),
          "=&v"(g[8]), "=&v"(g[9]), "=&v"(g[10]), "=&v"(g[11]), "=&v"(g[12]), "=&v"(g[13]), "=&v"(g[14]), "=&v"(g[15])
        : "v"(tpa), "v"(tpb) : "memory");
}
struct EpiBranchFused {
    static constexpr bool PERM = true, AFTER_DRAIN = false, HAS_MID = true;
    static constexpr int T1 = 16, T2 = 48;
    const bf16_t* GT; bf16_t* MRG; int ldc;
    __device__ __forceinline__ void mid(f32x4 (&acc)[2][2][4][2], const Unit& u, int seg, int, int, int, int) const {
        int t_ = threadIdx.x; asm volatile("" : "+v"(t_));
        const int wid_ = __builtin_amdgcn_readfirstlane(t_ >> 6), wr = wid_ >> 2, wc = wid_ & 3, fr = t_ & 15, fq = (t_ & 63) >> 4;
#pragma unroll
        for (int pass = 0; pass < 2; ++pass) {
            u32x4 gw[16]; gate_load16(gw, GT + gate_tile_elem((seg + pass) * 16 + u.pn, u.pm, wr, wc, fr, fq));
#pragma unroll
            for (int ai = 0; ai < 2; ++ai)
#pragma unroll
                for (int m = 0; m < 4; ++m)
#pragma unroll
                    for (int bj = 0; bj < 2; ++bj) { const u32x4 w = gw[(ai * 4 + m) * 2 + bj];
                        f32x4 s0 = {bf_lo(w.x), bf_hi(w.x), bf_lo(w.y), bf_hi(w.y)}, s1 = {bf_lo(w.z), bf_hi(w.z), bf_lo(w.w), bf_hi(w.w)};
                        if (pass == 1) {
#pragma unroll
                            for (int e = 0; e < 4; ++e) { s0[e] = __builtin_amdgcn_rcpf(fmaxf(s0[e], 1e-30f)); s1[e] = __builtin_amdgcn_rcpf(fmaxf(s1[e], 1e-30f)); } }
                        acc[ai][bj][m][0] *= s0; acc[ai][bj][m][1] *= s1;
                        asm volatile("" : "+v"(acc[ai][bj][m][0]), "+v"(acc[ai][bj][m][1])); }
        }
    }
    __device__ __forceinline__ void operator()(const f32x4 (&acc)[2][2][4][2], const Unit& u, int, int, int, int) const {
        int t_ = threadIdx.x; asm volatile("" : "+v"(t_));
        const int wid_ = __builtin_amdgcn_readfirstlane(t_ >> 6), wr = wid_ >> 2, wc = wid_ & 3, fr = t_ & 15, fq = (t_ & 63) >> 4;
        const int row0 = u.pm * BM + wr * 64 + fr, col0 = u.pn * BM + wc * 32 + 8 * fq;
        u32x4 gw[16]; gate_load16(gw, GT + gate_tile_elem(2 * 16 + u.pn, u.pm, wr, wc, fr, fq));
#pragma unroll
        for (int ai = 0; ai < 2; ++ai) {
#pragma unroll
            for (int m = 0; m < 4; ++m) { const size_t row = (size_t)(row0 + ai * HALF + m * 16);
#pragma unroll
                for (int bj = 0; bj < 2; ++bj) { const int c = col0 + bj * HALF; const u32x4 g = gw[(ai * 4 + m) * 2 + bj];
                    f32x4 v0 = acc[ai][bj][m][0], v1 = acc[ai][bj][m][1];
                    v0[0] *= bf_lo(g.x); v0[1] *= bf_hi(g.x); v0[2] *= bf_lo(g.y); v0[3] *= bf_hi(g.y);
                    v1[0] *= bf_lo(g.z); v1[1] *= bf_hi(g.z); v1[2] *= bf_lo(g.w); v1[3] *= bf_hi(g.w);
                    *(u32x4*)(MRG + row * ldc + c) = pack8_bf16(v0, v1); } }
            __builtin_amdgcn_sched_barrier(0); }
    }
};
struct EpiSwiglu {
    static constexpr bool PERM = true, AFTER_DRAIN = false, HAS_MID = false;
    bf16_t* H; int ldh; PG8_LAS const float* rsl;
    __device__ __forceinline__ void operator()(const f32x4 (&acc)[2][2][4][2], const Unit& u, int wr, int wc, int fr, int fq) const {
        const int row0 = u.pm * BM + wr * 64 + fr, col0 = u.pn * HALF + wc * 32 + 8 * fq;
#pragma unroll
        for (int ai = 0; ai < 2; ++ai)
#pragma unroll
            for (int m = 0; m < 4; ++m) { f32x4 o0, o1; const float rs = rsl[(u.pm & 7) * BM + wr * 64 + fr + ai * HALF + m * 16]; const f32x4 g0 = acc[ai][0][m][0] * rs, g1 = acc[ai][0][m][1] * rs, u0 = acc[ai][1][m][0] * rs, u1 = acc[ai][1][m][1] * rs;
#pragma unroll
                for (int e = 0; e < 4; ++e) { o0[e] = g0[e] * sigmoid_f(g0[e]) * u0[e]; o1[e] = g1[e] * sigmoid_f(g1[e]) * u1[e]; }
                *(u32x4*)(H + (size_t)(row0 + ai * HALF + m * 16) * ldh + col0) = pack8_bf16(o0, o1); }
    }
};
struct EpiF32 {
    static constexpr bool PERM = false, AFTER_DRAIN = false, HAS_MID = false;
    float* C; int ldc;
    __device__ __forceinline__ void operator()(const f32x4 (&acc)[2][2][4][2], const Unit& u, int wr, int wc, int fr, int fq) const {
        const int row0 = u.pm * BM + wr * 64 + fr, col0 = u.pn * BM + wc * 32 + 4 * fq;
#pragma unroll
        for (int ai = 0; ai < 2; ++ai)
#pragma unroll
            for (int m = 0; m < 4; ++m) { float* rowp = C + (size_t)(row0 + ai * HALF + m * 16) * ldc + col0;
#pragma unroll
                for (int bj = 0; bj < 2; ++bj)
#pragma unroll
                    for (int n = 0; n < 2; ++n) *(f32x4*)(rowp + bj * HALF + n * 16) = acc[ai][bj][m][n]; }
    }
};

#define PG8_KTILE_PAIR \
            const bool last = (t == nt - 2); \
            const char* a1 = cA + (size_t)(t + 1) * kstepA; \
            const char* a2 = last ? nA : cA + (size_t)(t + 2) * kstepA; const char* b2 = last ? nB : cB + (size_t)(t + 2) * kstepB; \
            const char* a3 = a2 + kstepA; const char* b3 = b2 + kstepB; \
            if (last && has_next) S.a_ready(nxt); \
            if constexpr (SP2) { \
            PG8_LDB(B0, 0, 0); PG8_LDB(B1, 0, 1); PG8_SCHED; PG8_LDA(At, 0, 0); PG8_STAGE(PG8_SA(1, 1), a1 + hstepA, voffA); \
            PG8_WAIT_V(8); PG8_WAIT_L(0); PG8_BAR; PG8_MMA(0, 0, At, B0); PG8_MMA(0, 1, At, B1); PG8_BAR; PG8_SCHED; \
            PG8_LDA(At, 0, 1); PG8_STAGE(PG8_SB(0, 0), b2, voffB); PG8_STAGE(PG8_SB(0, 1), b2 + hstepB, voffB); PG8_STAGE(PG8_SA(0, 0), a2, voffA); \
            PG8_WAIT_V(8); PG8_WAIT_L(0); PG8_BAR; PG8_MMA(1, 0, At, B0); PG8_MMA(1, 1, At, B1); PG8_BAR; PG8_SCHED; \
            PG8_LDB(B0, 1, 0); PG8_LDB(B1, 1, 1); PG8_SCHED; PG8_LDA(At, 1, 0); PG8_STAGE(PG8_SA(0, 1), a2 + hstepA, voffA); \
            PG8_WAIT_V(8); PG8_WAIT_L(0); PG8_BAR; PG8_MMA(0, 0, At, B0); PG8_MMA(0, 1, At, B1); PG8_BAR; PG8_SCHED; \
            PG8_LDA(At, 1, 1); PG8_STAGE(PG8_SB(1, 0), b3, voffB); PG8_STAGE(PG8_SB(1, 1), b3 + hstepB, voffB); PG8_STAGE(PG8_SA(1, 0), a3, voffA); \
            PG8_WAIT_V(8); PG8_WAIT_L(0); PG8_BAR; PG8_MMA(1, 0, At, B0); PG8_MMA(1, 1, At, B1); PG8_BAR; PG8_SCHED; \
            } else { \
            PG8_LDB(B0, 0, 0); PG8_SCHED; PG8_LDA(At, 0, 0); PG8_STAGE(PG8_SA(1, 1), a1 + hstepA, voffA); \
            PG8_WAIT_L(8); PG8_BAR; PG8_WAIT_L(0); PG8_MMA(0, 0, At, B0); PG8_BAR; PG8_SCHED; \
            PG8_LDB(B1, 0, 1); PG8_STAGE(PG8_SB(0, 0), b2, voffB); \
            PG8_BAR; PG8_WAIT_L(0); PG8_MMA(0, 1, At, B1); PG8_BAR; \
            PG8_LDA(At, 0, 1); PG8_STAGE(PG8_SA(0, 0), a2, voffA); \
            PG8_BAR; PG8_WAIT_L(0); PG8_MMA(1, 0, At, B0); PG8_BAR; PG8_SCHED; \
            PG8_STAGE(PG8_SB(0, 1), b2 + hstepB, voffB); \
            PG8_WAIT_V(6); PG8_BAR; PG8_MMA(1, 1, At, B1); PG8_BAR; \
            PG8_LDB(B0, 1, 0); PG8_SCHED; PG8_LDA(At, 1, 0); PG8_STAGE(PG8_SA(0, 1), a2 + hstepA, voffA); \
            PG8_WAIT_L(8); PG8_BAR; PG8_WAIT_L(0); PG8_MMA(0, 0, At, B0); PG8_BAR; PG8_SCHED; \
            PG8_LDB(B1, 1, 1); PG8_STAGE(PG8_SB(1, 0), b3, voffB); \
            PG8_BAR; PG8_WAIT_L(0); PG8_MMA(0, 1, At, B1); PG8_BAR; \
            PG8_LDA(At, 1, 1); PG8_STAGE(PG8_SA(1, 0), a3, voffA); \
            PG8_BAR; PG8_WAIT_L(0); PG8_MMA(1, 0, At, B0); PG8_BAR; PG8_SCHED; \
            PG8_STAGE(PG8_SB(1, 1), b3 + hstepB, voffB); \
            PG8_WAIT_V(6); PG8_BAR; PG8_MMA(1, 1, At, B1); PG8_BAR; \
            }
template <class Epi, class Sched, bool ALIGN_EPI = false, bool SP2 = false>
__device__ __forceinline__ void gemm_phase(PG8_LAS unsigned char* lds, const Gemm g, const Sched& S, const Epi& E) {
    int tid_ = threadIdx.x; asm volatile("" : "+v"(tid_));
    const int tid = tid_, wid = __builtin_amdgcn_readfirstlane(tid >> 6), lane = tid & 63, wr = wid >> 2, wc = wid & 3, fr = lane & 15, fq = lane >> 4;
    const int K = g.K, nt = K / BK;
    unsigned voffA[2], voffB[2];
#define PG8_LANE_VOFF(tid__) do { _Pragma("unroll") for (int i = 0; i < 2; ++i) { int R, C; stage_rc((tid__) * 16 + i * 8192, R, C); const int Rb = Epi::PERM ? ((R & ~31) + perm32(R & 31)) : R; \
        voffA[i] = (unsigned)(R * K + C) * 2u; (void)Rb; voffB[i] = (unsigned)((tid__) * 16 + i * 8192); } } while (0)
    PG8_LANE_VOFF(tid);
    const size_t kstepA = (size_t)(BK * 2), kstepB = 2 * HTB;
    const size_t hstepA = (size_t)HALF * K * 2, hstepB = HTB;
    const size_t tstepA = 2 * hstepA, tstepB = (size_t)nt * 2 * HTB;
    const unsigned ldsw = (unsigned)wid * 1024u;
    int aoff = lds_byte(wr * 64 + fr, fq * 8), boff = lds_byte(wc * 32 + fr, fq * 8);
#define PG8_LANE_REBUILD() do { int t__ = threadIdx.x; asm volatile("" : "+v"(t__)); PG8_LANE_VOFF(t__); const int l__ = t__ & 63, w__ = __builtin_amdgcn_readfirstlane(t__ >> 6); \
        aoff = lds_byte((w__ >> 2) * 64 + (l__ & 15), (l__ >> 4) * 8); boff = lds_byte((w__ & 3) * 32 + (l__ & 15), (l__ >> 4) * 8); } while (0)
#define PG8_SA(b, h) (((b) * 2 + (h)) * HTB)
#define PG8_SB(b, h) ((4 + (b) * 2 + (h)) * HTB)
#define PG8_STAGE(bufoff, gbase, voff) do { _Pragma("unroll") for (int _i = 0; _i < 2; ++_i) \
        __builtin_amdgcn_global_load_lds((const unsigned*)((const char*)(gbase) + (voff)[_i]), (PG8_LAS unsigned*)(lds + (bufoff) + ldsw + _i * 8192), 16, 0, 0); } while (0)
#define PG8_LDA(dst, b, h) do { _Pragma("unroll") for (int m = 0; m < 4; ++m) _Pragma("unroll") for (int k = 0; k < 2; ++k) dst[m][k] = *(const PG8_LAS bf16x8*)(lds + PG8_SA(b, h) + aoff + m * 2048 + k * 1024); } while (0)
#define PG8_LDB(dst, b, h) do { _Pragma("unroll") for (int n = 0; n < 2; ++n) _Pragma("unroll") for (int k = 0; k < 2; ++k) dst[n][k] = *(const PG8_LAS bf16x8*)(lds + PG8_SB(b, h) + boff + n * 2048 + k * 1024); } while (0)
#define PG8_MMA(ai, bj, At, Bt) do { __builtin_amdgcn_s_setprio(1); _Pragma("unroll") for (int k = 0; k < 2; ++k) _Pragma("unroll") for (int m = 0; m < 4; ++m) _Pragma("unroll") for (int n = 0; n < 2; ++n) \
        acc[ai][bj][m][n] = __builtin_amdgcn_mfma_f32_16x16x32_bf16(Bt[n][k], At[m][k], acc[ai][bj][m][n], 0, 0, 0); __builtin_amdgcn_s_setprio(0); } while (0)
#define PG8_WAIT_V(n) asm volatile("s_waitcnt vmcnt(" #n ")" ::: "memory")
#define PG8_WAIT_L(n) asm volatile("s_waitcnt lgkmcnt(" #n ")" ::: "memory")
#define PG8_BAR __builtin_amdgcn_s_barrier()
#define PG8_SCHED __builtin_amdgcn_sched_barrier(0)
    Unit cur, nxt; int ui = 0;
    if (!S.next(0, cur)) return;
    f32x4 acc[2][2][4][2];
#pragma unroll
    for (int a = 0; a < 2; ++a)
#pragma unroll
        for (int b = 0; b < 2; ++b)
#pragma unroll
            for (int m = 0; m < 4; ++m)
#pragma unroll
                for (int n = 0; n < 2; ++n) acc[a][b][m][n] = (f32x4){0.f, 0.f, 0.f, 0.f};
    bf16x8 At[4][2], B0[2][2], B1[2][2];
    const char* cA = (const char*)g.A + (size_t)cur.pm * tstepA; const char* cB = (const char*)g.Bt + (size_t)cur.pn * tstepB;
    S.a_ready(cur);
    if constexpr (SP2) {
        PG8_STAGE(PG8_SB(0, 0), cB, voffB); PG8_STAGE(PG8_SB(0, 1), cB + hstepB, voffB); PG8_STAGE(PG8_SA(0, 0), cA, voffA); PG8_STAGE(PG8_SA(0, 1), cA + hstepA, voffA);
        if (wr == 1) PG8_BAR;
        PG8_WAIT_V(2); PG8_BAR;
        PG8_STAGE(PG8_SB(1, 0), cB + kstepB, voffB); PG8_STAGE(PG8_SA(1, 0), cA + kstepA, voffA); PG8_STAGE(PG8_SB(1, 1), cB + hstepB + kstepB, voffB);
        PG8_WAIT_V(6); PG8_BAR;
    } else {
        PG8_STAGE(PG8_SB(0, 0), cB, voffB); PG8_STAGE(PG8_SA(0, 0), cA, voffA); PG8_STAGE(PG8_SB(0, 1), cB + hstepB, voffB); PG8_STAGE(PG8_SA(0, 1), cA + hstepA, voffA);
        if (wr == 1) PG8_BAR;
        PG8_WAIT_V(4); PG8_BAR;
        PG8_STAGE(PG8_SB(1, 0), cB + kstepB, voffB); PG8_STAGE(PG8_SA(1, 0), cA + kstepA, voffA); PG8_STAGE(PG8_SB(1, 1), cB + hstepB + kstepB, voffB);
        PG8_WAIT_V(6); PG8_BAR;
    }
    for (;;) {
        const bool has_next = S.next(ui + 1, nxt);
        const char* nA = has_next ? (const char*)g.A + (size_t)nxt.pm * tstepA : cA; const char* nB = has_next ? (const char*)g.Bt + (size_t)nxt.pn * tstepB : cB;
        int t = 0;
        if constexpr (Epi::HAS_MID) {
            for (; t < Epi::T1; t += 2) { PG8_KTILE_PAIR }
            E.mid(acc, cur, 0, wr, wc, fr, fq); PG8_LANE_REBUILD();
            for (; t < Epi::T2; t += 2) { PG8_KTILE_PAIR }
            E.mid(acc, cur, 1, wr, wc, fr, fq); PG8_LANE_REBUILD();
        }
        for (; t < nt; t += 2) { PG8_KTILE_PAIR }
        if constexpr (ALIGN_EPI) { if (wr == 0) PG8_BAR; }
        if constexpr (!Epi::AFTER_DRAIN) { E(acc, cur, wr, wc, fr, fq); S.done(cur); }
        if (!has_next) break;
#pragma unroll
        for (int a = 0; a < 2; ++a)
#pragma unroll
            for (int b = 0; b < 2; ++b)
#pragma unroll
                for (int m = 0; m < 4; ++m)
#pragma unroll
                    for (int n = 0; n < 2; ++n) acc[a][b][m][n] = (f32x4){0.f, 0.f, 0.f, 0.f};
        cur = nxt; cA = nA; cB = nB; ++ui;
        if constexpr (ALIGN_EPI) { if (wr == 1) PG8_BAR; }
    }
    PG8_WAIT_V(0);
    if constexpr (!ALIGN_EPI) { if (wr == 0) PG8_BAR; }
    PG8_BAR;
    if constexpr (Epi::AFTER_DRAIN) { E.fused(acc, cur, wr, wc, fr, fq, lds, wid, lane); S.done(cur); }
#undef PG8_SA
#undef PG8_SB
#undef PG8_STAGE
#undef PG8_LDA
#undef PG8_LDB
#undef PG8_MMA
#undef PG8_WAIT_V
#undef PG8_WAIT_L
#undef PG8_BAR
#undef PG8_SCHED
#undef PG8_LANE_VOFF
#undef PG8_LANE_REBUILD
#undef PG8_KTILE_PAIR
}
}

constexpr int NWAVES = 8;
#ifndef ATT_MFMA_TYPES
#define ATT_MFMA_TYPES 7
#endif
#ifndef PROBE_REPEAT
#define PROBE_REPEAT 0
#endif
#ifndef CONV_IN_GEMM
#define CONV_IN_GEMM 0
#endif
#ifndef MK_PER_PHASE
#define MK_PER_PHASE 0
#endif

constexpr int DM = 4096, NBATCH = 8, SEQ = 2048, M = NBATCH * SEQ, DEPTH = 2;
constexpr int NIN_SRC = 19528, NIN = 19712;
constexpr int FF = 11008;
constexpr float RMS_EPS = 1e-6f;
constexpr int PC_CQ = 0, PC_CKV = 1024, PC_MISC = 1536  , PC_QSWA = 1792, PC_KSWA = 3840, PC_VSWA = 4096, PC_QFOX = 4352, PC_KFOX = 5376, PC_VFOX = 6400, PC_GATE = 7424;
constexpr int GATE_TILE0 = PC_GATE / 256;
static_assert(PC_GATE + 3 * DM == NIN && NIN % 256 == 0 && PC_MISC / 256 == 6, "in-projection map");
constexpr int NINP = PC_GATE;

constexpr size_t MiB = 1u << 20;
constexpr size_t WS_CTL = 0, CTL_ZERO_BYTES = 1 * MiB;
constexpr size_t SZ_WIN = (size_t)NIN * DM * 2, SZ_WUQ = (size_t)1536 * 1024 * 2, SZ_WUKV = (size_t)2048 * 512 * 2, SZ_WB = (size_t)DM * DM * 2, SZ_WOUT = (size_t)DM * DM * 2,
                 SZ_WGU = (size_t)2 * FF * DM * 2, SZ_WD = (size_t)DM * FF * 2;
constexpr size_t WL_WIN = 0, WL_WUQ = WL_WIN + SZ_WIN, WL_WUKV = WL_WUQ + SZ_WUQ, WL_WB = WL_WUKV + SZ_WUKV, WL_WOUT = WL_WB + SZ_WB, WL_WGU = WL_WOUT + SZ_WOUT, WL_WD = WL_WGU + SZ_WGU,
                 WL_SIZE = WL_WD + SZ_WD;
constexpr size_t WS_W = 1 * MiB;
constexpr size_t WS_ROPE = WS_W + DEPTH * WL_SIZE;
constexpr size_t WS_HB = WS_ROPE + 4 * MiB;
constexpr size_t WS_PB = WS_HB + (size_t)M * DM * 2;
constexpr size_t WS_GT = WS_PB + (size_t)M * NINP * 2;
constexpr size_t WS_MISC = WS_PB + (size_t)M * NIN * 2;
constexpr size_t WS_CQN = WS_MISC + (size_t)M * 256 * 4;
constexpr size_t WS_CKVN = WS_CQN + (size_t)M * 1024 * 2;
constexpr size_t WS_KR = WS_CKVN + (size_t)M * 512 * 2;
constexpr size_t WS_LF = WS_KR + (size_t)M * 64 * 2;
constexpr size_t WS_FC = WS_LF + (size_t)M * 8 * 4;
constexpr size_t WS_QN = WS_FC + (size_t)M * 8 * 4;
constexpr size_t WS_QR = WS_QN + (size_t)M * 1024 * 2;
constexpr size_t WS_KN = WS_QR + (size_t)M * 512 * 2;
constexpr size_t WS_VM = WS_KN + (size_t)M * 1024 * 2;
constexpr size_t WS_OM = WS_VM + (size_t)M * 1024 * 2;
constexpr size_t WS_OS = WS_OM + (size_t)M * 1024 * 2;
constexpr size_t WS_OF = WS_OS + (size_t)M * 2048 * 2;
constexpr size_t WS_TM = WS_OF + (size_t)M * 1024 * 2;
constexpr size_t WS_MRG = WS_TM + (size_t)M * DM * 4;
constexpr size_t WS_RS = WS_MRG + (size_t)M * DM * 2;
constexpr size_t WS_END = WS_RS + (size_t)M * 4;
static_assert(WS_END <= (size_t)2752 * MiB, "d_ws map exceeds the guaranteed workspace");
static_assert((size_t)M * FF * 2 <= (size_t)M * NIN * 2 && WS_GT + (size_t)3 * M * DM * 2 <= WS_MISC, "HID overlays P + GT");
constexpr int CW_TMO = 0, CW_CODE = 1;
constexpr int CW_BAR = 4096;

constexpr int RING_OFF = 0, RING_BYTES = 131072;
constexpr int LDSCTL_OFF = RING_BYTES, MISC_OFF = LDSCTL_OFF + 320;
constexpr int RS_OFF = 133120;
constexpr int LDS_BYTES = 147456;
static_assert(MISC_OFF + 128 <= RS_OFF && RS_OFF + 8192 <= LDS_BYTES, "LDS map");

#define GAS __attribute__((address_space(1)))
#define LAS __attribute__((address_space(3)))
typedef unsigned short bf16;
typedef unsigned v4u __attribute__((ext_vector_type(4)));
typedef unsigned v2u __attribute__((ext_vector_type(2)));
typedef float f32x4 __attribute__((ext_vector_type(4)));
typedef short bf16x8 __attribute__((ext_vector_type(8)));
typedef GAS unsigned gu32;
typedef GAS unsigned long long gu64;
#define RLX_AGENT __ATOMIC_RELAXED, __HIP_MEMORY_SCOPE_AGENT
#define LDS_WAIT() asm volatile("s_waitcnt lgkmcnt(0)" ::: "memory")
#define VM_WAIT() asm volatile("s_waitcnt vmcnt(0)" ::: "memory")
__device__ __forceinline__ unsigned long long rt() { return __builtin_amdgcn_s_memrealtime(); }
__device__ __forceinline__ unsigned f2bf(float f) { unsigned u = __builtin_bit_cast(unsigned, f); return (u + 0x7fffu + ((u >> 16) & 1u)) >> 16; }
__device__ __forceinline__ unsigned pk2(float lo, float hi) { return f2bf(lo) | (f2bf(hi) << 16); }

#define XB_TMO      128
#define XB_XCNT(j)  (256  + 64 * (j))
#define XB_XSUB(j)  (1280 + 64 * (j))
#define XB_XGEN(j)  (2304 + 64 * (j))
#define XB_TOP      3328
#define XB_TOPGEN   3392
#define XCD_BAR_WORDS 3456
#define XB_SPIN_CAP (1u << 23)

__device__ __forceinline__ unsigned xb_ld(unsigned* p)              { return __hip_atomic_load(p, __ATOMIC_RELAXED, __HIP_MEMORY_SCOPE_AGENT); }
__device__ __forceinline__ unsigned xb_add(unsigned* p, unsigned v) { return __hip_atomic_fetch_add(p, v, __ATOMIC_RELAXED, __HIP_MEMORY_SCOPE_AGENT); }
__device__ __forceinline__ unsigned xb_xcc_id() { return (unsigned)__builtin_amdgcn_s_getreg((3 << 11) | 20) & 0xFu; }
#define XB_SPIN(cond, bar) do { unsigned _sp = 0; while (cond) { __builtin_amdgcn_s_sleep(1); \
    if ((++_sp & 255u) == 0u) { if (xb_ld(&(bar)[XB_TMO])) break; if (_sp > XB_SPIN_CAP) { atomicAdd(&(bar)[XB_TMO], 1u); break; } } } } while (0)

struct XcdBarrier {
    unsigned* bar; unsigned x;
    volatile LAS unsigned* st;
};

__device__ __forceinline__ XcdBarrier xcd_barrier_post(unsigned* bar, volatile LAS unsigned* st) {
    XcdBarrier b; b.bar = bar; b.x = xb_xcc_id(); b.st = st;
    if (threadIdx.x == 0) (void)xb_add(&bar[XB_XCNT(b.x)], 1u);
    return b;
}
__device__ __forceinline__ void xcd_barrier_complete(unsigned* bar, unsigned x, unsigned& nloc, unsigned& nx) {
    const unsigned G = gridDim.x * gridDim.y * gridDim.z;
    unsigned sum, cnt, mine, sp = 0u;
    for (;;) {
        sum = 0u; cnt = 0u; mine = 0u;
#pragma unroll
        for (unsigned j = 0; j < 16; ++j) { const unsigned c = xb_ld(&bar[XB_XCNT(j)]); sum += c; cnt += (c > 0u) ? 1u : 0u; mine = (j == x) ? c : mine; }
        if (sum == G) break;
        __builtin_amdgcn_s_sleep(1);
        if ((++sp & 255u) == 0u) { if (xb_ld(&bar[XB_TMO])) break; if (sp > XB_SPIN_CAP) { atomicAdd(&bar[XB_TMO], 1u); break; } }
    }
    nloc = mine > 0u ? mine : 1u; nx = cnt > 0u ? cnt : 1u;
}

__device__ __forceinline__ void xcd_barrier(const XcdBarrier& b) {
    asm volatile("s_waitcnt vmcnt(0)" ::: "memory");
    __syncthreads();
    if (threadIdx.x == 0) {
        unsigned* bar = b.bar;
        __builtin_amdgcn_s_waitcnt(0);
        unsigned nloc = b.st[0], nx = b.st[1];
        if (nloc == 0u) { xcd_barrier_complete(bar, b.x, nloc, nx); b.st[0] = nloc; b.st[1] = nx; }
        const unsigned old = xb_add(&bar[XB_XSUB(b.x)], 1u);
        const unsigned gen = old / nloc;
        if (old + 1u == (gen + 1u) * nloc) {
            __builtin_amdgcn_fence(__ATOMIC_RELEASE, "agent");
            asm volatile("s_waitcnt vmcnt(0)" ::: "memory");
            const unsigned og = xb_add(&bar[XB_TOP], 1u);
            const unsigned tg = og / nx;
            if (og + 1u == (tg + 1u) * nx) xb_add(&bar[XB_TOPGEN], 1u);
            else XB_SPIN(xb_ld(&bar[XB_TOPGEN]) == tg, bar);
            __builtin_amdgcn_fence(__ATOMIC_ACQUIRE, "agent");
            xb_add(&bar[XB_XGEN(b.x)], 1u);
            asm volatile("s_waitcnt vmcnt(0)" ::: "memory");
        } else {
            XB_SPIN(xb_ld(&bar[XB_XGEN(b.x)]) == gen, bar);
            __builtin_amdgcn_fence(__ATOMIC_ACQUIRE, "agent");
            asm volatile("s_waitcnt vmcnt(0)" ::: "memory");
        }
    }
    __syncthreads();
}

struct Frame {
    LAS unsigned char* lds;
    int tid, lane, wave;
};
__device__ __forceinline__ float wave_sum(float v) {
#pragma unroll
    for (int o = 1; o < 64; o <<= 1) v += __shfl_xor(v, o);
    return v;
}
__device__ __forceinline__ float wave_max(float v) {
#pragma unroll
    for (int o = 1; o < 64; o <<= 1) v = fmaxf(v, __shfl_xor(v, o));
    return v;
}
__device__ __forceinline__ float bfl(unsigned w) { return __uint_as_float(w << 16); }
__device__ __forceinline__ float bfh(unsigned w) { return __uint_as_float(w & 0xffff0000u); }

__device__ __forceinline__ void sincos_f(float x, float& s, float& c) {
    const float k = rintf(x * 0.636619772367581f);
    float r = fmaf(k, -1.5703125f, x); r = fmaf(k, -4.837512969970703125e-4f, r); r = fmaf(k, -7.549789948768648e-8f, r);
    const int q = (int)k & 3; const float z = r * r;
    const float sp = fmaf(r * z, fmaf(z, fmaf(z, -1.9515295891e-4f, 8.3321608736e-3f), -1.6666654611e-1f), r);
    const float cp = fmaf(z * z, fmaf(z, fmaf(z, 2.443315711809948e-5f, -1.388731625493765e-3f), 4.166664568298827e-2f), fmaf(z, -0.5f, 1.0f));
    float ss = (q & 1) ? cp : sp, cc = (q & 1) ? sp : cp;
    if (q & 2) ss = -ss; if ((q + 1) & 2) cc = -cc;
    s = ss; c = cc;
}

#ifndef WEIGHT_DROP_BITS
#define WEIGHT_DROP_BITS 2
#endif
__device__ __forceinline__ unsigned f2bfw(float f, unsigned drop) { const unsigned SH = 16u + drop; unsigned u = __builtin_bit_cast(unsigned, f); return ((u + ((1u << (SH - 1u)) - 1u) + ((u >> SH) & 1u)) >> SH) << drop; }
__device__ __forceinline__ unsigned pk2w(float lo, float hi, unsigned drop) { return f2bfw(lo, drop) | (f2bfw(hi, drop) << 16); }
__device__ __forceinline__ void tr_item(const float* W, int ldw, int K, bf16* WT, int k0, int dst_row0, int src_col0, int nvalid, int mode, LAS float* scr, int lane, const float* gk = nullptr, unsigned drop = WEIGHT_DROP_BITS) {
    if (mode == 0) {
        const int r8 = lane >> 3, c4 = (lane & 7) * 4; const bool ok = c4 < nvalid;
        const float* src = W + (size_t)(k0 + r8) * ldw + src_col0 + c4;
        f32x4 v[8];
#pragma unroll
        for (int i = 0; i < 8; ++i) v[i] = ok ? *(const GAS f32x4*)(src + (size_t)(8 * i) * ldw) : (f32x4){0.f, 0.f, 0.f, 0.f};
        if (gk) {
#pragma unroll
            for (int i = 0; i < 8; ++i) v[i] = v[i] * gk[k0 + 8 * i + r8]; }
#pragma unroll
        for (int i = 0; i < 8; ++i) { LAS float* dd = scr + (8 * i + r8) * 33 + c4; dd[0] = v[i].x; dd[1] = v[i].y; dd[2] = v[i].z; dd[3] = v[i].w; }
    } else {
        const int c = lane & 31; const int scol = src_col0 + 32 * (c & 1) + (c >> 1);
        const float* src = W + (size_t)(k0 + (lane >> 5)) * ldw + scol;
#pragma unroll 8
        for (int i = 0; i < 32; ++i) { const int kk = 2 * i + (lane >> 5); scr[kk * 33 + c] = src[(size_t)(2 * i) * ldw]; }
    }
    LDS_WAIT(); asm volatile("" ::: "memory");
    const int cc = lane & 7;
#pragma unroll
    for (int j = 0; j < 4; ++j) { const int n = (lane >> 3) + 8 * j; const LAS float* s = scr + (8 * cc) * 33 + n;
        v4u o; o.x = pk2w(s[0 * 33], s[1 * 33], drop); o.y = pk2w(s[2 * 33], s[3 * 33], drop); o.z = pk2w(s[4 * 33], s[5 * 33], drop); o.w = pk2w(s[6 * 33], s[7 * 33], drop);
        const int w = dst_row0 + n, wl = w & 127, x = wl & 31, R = (wl & ~31) + ((((x >> 2) & 1) << 4) | ((x >> 3) << 2) | (x & 3));
        *(GAS v4u*)((GAS unsigned char*)WT + ((size_t)((w >> 8) * (K >> 6) + (k0 >> 6)) * 2 + ((w >> 7) & 1)) * 16384 + pg8::lds_byte(R, 8 * cc)) = o; }
    LDS_WAIT(); asm volatile("" ::: "memory");
}
#define PTR_FIELDS(X) X(const float*, x) X(const int*, pos) X(const float*, g_mix_pre) X(const float*, g_mix_post) X(const float*, g_ffn_pre) X(const float*, g_ffn_post) X(const float*, w_in) \
    X(const float*, g_q_lora) X(const float*, w_uq) X(const float*, g_kv_lora) X(const float*, w_ukv) X(const float*, b_forget) X(const float*, swa_sinks) X(const float*, w_branch) X(const float*, w_out) \
    X(const float*, w_gate_up) X(const float*, w_down) X(float*, out) X(unsigned char*, ws)
constexpr int N_PTRS = 19;
struct Ptrs {
#define X(T, n) T n;
    PTR_FIELDS(X)
#undef X
    int ph_lo, ph_hi;
};
static_assert(sizeof(Ptrs) == N_PTRS * 8 + 8, "Ptrs has no padding");
struct PA : Ptrs { int G, bx, vcu; };
__device__ __forceinline__ unsigned long long ld_u64u(const LAS unsigned* w) { const unsigned lo = (unsigned)__builtin_amdgcn_readfirstlane((int)w[0]), hi = (unsigned)__builtin_amdgcn_readfirstlane((int)w[1]); return ((unsigned long long)hi << 32) | lo; }
__device__ __forceinline__ void park_args(const Ptrs& A0, LAS unsigned* argw) {
    LAS unsigned long long* a64 = (LAS unsigned long long*)argw; int i = 0;
#define X(T, n) a64[i++] = (unsigned long long)A0.n;
    PTR_FIELDS(X)
#undef X
    const int G = gridDim.x, bx = blockIdx.x;
    argw[2 * N_PTRS + 0] = (unsigned)G; argw[2 * N_PTRS + 1] = (unsigned)bx; argw[2 * N_PTRS + 2] = (unsigned)((G % 8 == 0) ? (bx % 8) * (G / 8) + bx / 8 : bx);
}
__device__ __forceinline__ PA load_args(const LAS unsigned* argw) {
    asm volatile("" ::: "memory");
    PA A; int i = 0;
#define X(T, n) A.n = (T)(GAS unsigned char*)ld_u64u(argw + 2 * (i++));
    PTR_FIELDS(X)
#undef X
    A.G = __builtin_amdgcn_readfirstlane((int)argw[2 * N_PTRS + 0]); A.bx = __builtin_amdgcn_readfirstlane((int)argw[2 * N_PTRS + 1]); A.vcu = __builtin_amdgcn_readfirstlane((int)argw[2 * N_PTRS + 2]);
    A.ph_lo = 0; A.ph_hi = 0;
    return A;
}
namespace cv {
constexpr int NB_IN = NIN / 32, NB_UQ = 1536 / 32, NB_UKV = 2048 / 32, NB_D = DM / 32, NB_GU = 2 * FF / 32;
constexpr int I_IN = (DM / 64) * NB_IN, I_UQ = (1024 / 64) * NB_UQ, I_UKV = (512 / 64) * NB_UKV, I_B0 = (1024 / 64) * NB_D, I_B1 = (2048 / 64) * NB_D, I_B2 = I_B0,
              I_OUT = (DM / 64) * NB_D, I_GU = (DM / 64) * NB_GU, I_D = (FF / 64) * NB_D;
constexpr int O_B = I_IN + I_UQ + I_UKV, O_GU = O_B + I_B0 + I_B1 + I_B2 + I_OUT, O_D = O_GU + I_GU;
constexpr int I_LAYER = O_D + I_D;
#ifndef CONV_UNDER_ATTN
#define CONV_UNDER_ATTN 1
#endif
#ifndef TAIL_T0
#define TAIL_T0 30208
#endif
#ifndef TAIL_T1
#define TAIL_T1 16384
#endif
#ifndef TAIL_T2
#define TAIL_T2 28000
#endif
#ifndef TAIL_T3
#define TAIL_T3 16384
#endif
constexpr int T0_LO = I_LAYER - TAIL_T0, T0_HI = I_LAYER;
constexpr int T1_LO = I_LAYER + O_B, T1_HI = T1_LO + TAIL_T1;
constexpr int T2_LO = I_LAYER + O_GU, T2_HI = T2_LO + TAIL_T2;
constexpr int T3_LO = I_LAYER + O_D, T3_HI = T3_LO + TAIL_T3;
static_assert(T0_LO >= O_GU && T1_HI <= I_LAYER + O_GU && T2_HI <= I_LAYER + O_D && T3_HI <= 2 * I_LAYER && DEPTH == 2, "tail slots");
}
__device__ __forceinline__ void convert_one(const PA& A, const int it, LAS float* scr, const int lane) {
    using namespace cv;
        const int l = it / I_LAYER; int r = it - l * I_LAYER;
        unsigned char* wl = A.ws + WS_W + (size_t)l * WL_SIZE;
        if (r < I_IN) { const int kb = r / NB_IN, nb = r - kb * NB_IN, n0 = nb * 32; int sc, nv;
            if (n0 < 1600) { sc = n0; nv = 32; } else if (n0 < 1632) { sc = 7232; nv = 8; } else if (n0 < PC_QSWA) { sc = 0; nv = 0; } else if (n0 < PC_GATE) { sc = n0 - 192; nv = 32; } else { sc = n0 - 184; nv = 32; }
            tr_item(A.w_in + (size_t)l * DM * NIN_SRC, NIN_SRC, DM, (bf16*)(wl + WL_WIN), kb * 64, n0, sc, nv, 0, scr, lane, A.g_mix_pre + (size_t)l * DM, WEIGHT_DROP_BITS); return; } r -= I_IN;
        if (r < I_UQ) { const int kb = r / NB_UQ, nb = r - kb * NB_UQ, n0 = nb * 32; int sc, mode;
            if (n0 < 1024) { sc = 192 * (n0 >> 7) + (n0 & 127); mode = 0; } else { const int q = n0 - 1024; sc = 192 * (q >> 6) + 128 + 16 * ((q >> 5) & 1); mode = 1; }
            tr_item(A.w_uq + (size_t)l * 1024 * 1536, 1536, 1024, (bf16*)(wl + WL_WUQ), kb * 64, n0, sc, 32, mode, scr, lane, nullptr, 0u); return; } r -= I_UQ;
        if (r < I_UKV) { const int kb = r / NB_UKV, nb = r - kb * NB_UKV, n0 = nb * 32; const int q = n0 & 1023;
            const int sc = 256 * (q >> 7) + (q & 127) + (n0 >= 1024 ? 128 : 0);
            tr_item(A.w_ukv + (size_t)l * 512 * 2048, 2048, 512, (bf16*)(wl + WL_WUKV), kb * 64, n0, sc, 32, 0, scr, lane, nullptr, 0u); return; } r -= I_UKV;
        if (r < I_B0 + I_B1 + I_B2) { const int kb = r / NB_D, nb = r - kb * NB_D;
            tr_item(A.w_branch + (size_t)l * DM * DM, DM, DM, (bf16*)(wl + WL_WB), kb * 64, nb * 32, nb * 32, 32, 0, scr, lane); return; } r -= I_B0 + I_B1 + I_B2;
        if (r < I_OUT) { const int kb = r / NB_D, nb = r - kb * NB_D;
            tr_item(A.w_out + (size_t)l * DM * DM, DM, DM, (bf16*)(wl + WL_WOUT), kb * 64, nb * 32, nb * 32, 32, 0, scr, lane); return; } r -= I_OUT;
        if (r < I_GU) { const int kb = r / NB_GU, nb = r - kb * NB_GU, n0 = nb * 32;
            const int sc = ((n0 >> 7) & 1) * FF + 128 * (n0 >> 8) + (n0 & 127);
            tr_item(A.w_gate_up + (size_t)l * DM * 2 * FF, 2 * FF, DM, (bf16*)(wl + WL_WGU), kb * 64, n0, sc, 32, 0, scr, lane, A.g_ffn_pre + (size_t)l * DM, WEIGHT_DROP_BITS); return; } r -= I_GU;
        { const int kb = r / NB_D, nb = r - kb * NB_D;
            tr_item(A.w_down + (size_t)l * FF * DM, DM, FF, (bf16*)(wl + WL_WD), kb * 64, nb * 32, nb * 32, 32, 0, scr, lane, nullptr, WEIGHT_DROP_BITS); }
}
__device__ __forceinline__ void convert_span(Frame& F, const PA& A, const int lo, const int hi, const int gw, const int NGW) {
    LAS float* scr = (LAS float*)(F.lds + RING_OFF + F.wave * 16384);
    for (int it = lo + gw; it < hi; it += NGW) convert_one(A, it, scr, F.lane);
}
__device__ __forceinline__ void convert_items(Frame& F, const PA& A, const int mode) {
    using namespace cv;
    const int gw = A.vcu * NWAVES + F.wave, NGW = A.G * NWAVES;
    if (mode == 0) { convert_span(F, A, 0, I_IN, gw, NGW); return; }
    if (mode == 1) { convert_span(F, A, I_IN, DEPTH * I_LAYER, gw, NGW); return; }
    LAS float* scr = (LAS float*)(F.lds + RING_OFF + F.wave * 16384);
    constexpr int n1 = T0_LO - I_IN, n2 = T1_LO - T0_HI, n3 = T2_LO - T1_HI, n4 = T3_LO - T2_HI, n5 = DEPTH * I_LAYER - T3_HI;
    for (int v = gw; v < n1 + n2 + n3 + n4 + n5; v += NGW) {
        const int it = v < n1 ? I_IN + v : v < n1 + n2 ? T0_HI + (v - n1) : v < n1 + n2 + n3 ? T1_HI + (v - n1 - n2) : v < n1 + n2 + n3 + n4 ? T2_HI + (v - n1 - n2 - n3) : T3_HI + (v - n1 - n2 - n3 - n4);
        convert_one(A, it, scr, F.lane); }
}
__device__ __forceinline__ void convert_tail(Frame& F, const PA& A, const int lo, const int hi, const int first_idle) {
    if (A.G != 256 || A.bx < first_idle) return;
    convert_span(F, A, lo, hi, (A.bx - first_idle) * NWAVES + F.wave, (256 - first_idle) * NWAVES);
}
__device__ __forceinline__ void rope_tables(Frame& F, const PA& A) {
    float* cs = (float*)(A.ws + WS_ROPE); float* sn = cs + (size_t)M * 32;
    for (int e = (A.vcu * NWAVES * 64) + F.tid; e < M * 32; e += A.G * NWAVES * 64) { const int m = e >> 5, i = e & 31;
        const float inv = __builtin_amdgcn_exp2f(-(float)i * 0.41524101186092f); const float ang = (float)A.pos[m] * inv; float s, c; sincos_f(ang, s, c); cs[e] = c; sn[e] = s; }
}
__device__ __forceinline__ void x_in_rows(Frame& F, const PA& A, const float* x, bf16* xb, float* rs) {
    const int gw = A.vcu * NWAVES + F.wave, NGW = A.G * NWAVES;
    for (int m = gw; m < M; m += NGW) {
        const GAS f32x4* xr = (const GAS f32x4*)(x + (size_t)m * DM) + F.lane;
        f32x4 v[16]; float s = 0.f;
#pragma unroll
        for (int j = 0; j < 16; ++j) { v[j] = xr[64 * j]; s += (v[j].x * v[j].x + v[j].y * v[j].y) + (v[j].z * v[j].z + v[j].w * v[j].w); }
        const float rstd = 1.0f / sqrtf(wave_sum(s) * (1.f / DM) + RMS_EPS);
        GAS unsigned long long* o8 = (GAS unsigned long long*)(xb + (size_t)m * DM) + F.lane;
#pragma unroll
        for (int j = 0; j < 16; ++j) o8[64 * j] = (unsigned long long)pk2(v[j].x, v[j].y) | ((unsigned long long)pk2(v[j].z, v[j].w) << 32);
        if (F.lane == 0) rs[m] = rstd;
    }
}
__device__ __forceinline__ void resid_rows(Frame& F, const PA& A, bf16* xb, const bf16* mo, const float* ga, float* rs, float* out) {
    const int gw = A.vcu * NWAVES + F.wave, NGW = A.G * NWAVES;
    for (int m = gw; m < M; m += NGW) {
        const GAS v2u* mr = (const GAS v2u*)(mo + (size_t)m * DM) + F.lane; GAS v2u* xr = (GAS v2u*)(xb + (size_t)m * DM) + F.lane;
        const GAS f32x4* gar = (const GAS f32x4*)ga + F.lane;
        f32x4 v[16]; v2u xw[16]; float s = 0.f;
#pragma unroll
        for (int j = 0; j < 16; ++j) { const v2u w = mr[64 * j]; xw[j] = xr[64 * j]; v[j] = (f32x4){bfl(w.x), bfh(w.x), bfl(w.y), bfh(w.y)}; s += (v[j].x * v[j].x + v[j].y * v[j].y) + (v[j].z * v[j].z + v[j].w * v[j].w); }
        const float rstd = 1.0f / sqrtf(wave_sum(s) * (1.f / DM) + RMS_EPS);
        float s2 = 0.f;
#pragma unroll
        for (int j = 0; j < 16; ++j) { const f32x4 gg = gar[64 * j]; f32x4 o;
            o.x = bfl(xw[j].x) + v[j].x * rstd * gg.x; o.y = bfh(xw[j].x) + v[j].y * rstd * gg.y; o.z = bfl(xw[j].y) + v[j].z * rstd * gg.z; o.w = bfh(xw[j].y) + v[j].w * rstd * gg.w;
            v[j] = o; s2 += (o.x * o.x + o.y * o.y) + (o.z * o.z + o.w * o.w); }
        if (out) { GAS f32x4* oo = (GAS f32x4*)(out + (size_t)m * DM) + F.lane;
#pragma unroll
            for (int j = 0; j < 16; ++j) oo[64 * j] = v[j]; }
        else {
#pragma unroll
            for (int j = 0; j < 16; ++j) { v2u w; w.x = pk2(v[j].x, v[j].y); w.y = pk2(v[j].z, v[j].w); xr[64 * j] = w; }
            const float rstd2 = 1.0f / sqrtf(wave_sum(s2) * (1.f / DM) + RMS_EPS);
            if (F.lane == 0) rs[m] = rstd2; }
    }
}
__device__ __forceinline__ void mla_prep_rows(Frame& F, const PA& A, int l, const int gw, const int NGW) {
    const bf16* P = (const bf16*)(A.ws + WS_PB); const float* misc = (const float*)(A.ws + WS_MISC);
    bf16* CQN = (bf16*)(A.ws + WS_CQN); bf16* CKVN = (bf16*)(A.ws + WS_CKVN); bf16* KR = (bf16*)(A.ws + WS_KR); float* LF = (float*)(A.ws + WS_LF);
    const float* cs = (const float*)(A.ws + WS_ROPE); const float* sn = cs + (size_t)M * 32;
    const float* gq = A.g_q_lora + (size_t)l * 1024; const float* gkv = A.g_kv_lora + (size_t)l * 512; const float* bf = A.b_forget + (size_t)l * 8;
    for (int m = gw; m < M; m += NGW) {
        const bf16* pr = P + (size_t)m * NINP;
        {
            const v4u a = *(const GAS v4u*)(pr + PC_CQ + 8 * F.lane), b = *(const GAS v4u*)(pr + PC_CQ + 512 + 8 * F.lane);
            float v[16] = {bfl(a.x), bfh(a.x), bfl(a.y), bfh(a.y), bfl(a.z), bfh(a.z), bfl(a.w), bfh(a.w), bfl(b.x), bfh(b.x), bfl(b.y), bfh(b.y), bfl(b.z), bfh(b.z), bfl(b.w), bfh(b.w)};
            float s = 0.f;
#pragma unroll
            for (int j = 0; j < 16; ++j) s += v[j] * v[j];
            const float rstd = 1.0f / sqrtf(wave_sum(s) * (1.f / 1024.f) + RMS_EPS);
            const f32x4 g0 = *(const GAS f32x4*)(gq + 8 * F.lane), g1 = *(const GAS f32x4*)(gq + 8 * F.lane + 4), g2 = *(const GAS f32x4*)(gq + 512 + 8 * F.lane), g3 = *(const GAS f32x4*)(gq + 512 + 8 * F.lane + 4);
            v4u o0, o1;
            o0.x = pk2(v[0] * rstd * g0.x, v[1] * rstd * g0.y); o0.y = pk2(v[2] * rstd * g0.z, v[3] * rstd * g0.w); o0.z = pk2(v[4] * rstd * g1.x, v[5] * rstd * g1.y); o0.w = pk2(v[6] * rstd * g1.z, v[7] * rstd * g1.w);
            o1.x = pk2(v[8] * rstd * g2.x, v[9] * rstd * g2.y); o1.y = pk2(v[10] * rstd * g2.z, v[11] * rstd * g2.w); o1.z = pk2(v[12] * rstd * g3.x, v[13] * rstd * g3.y); o1.w = pk2(v[14] * rstd * g3.z, v[15] * rstd * g3.w);
            *(GAS v4u*)(CQN + (size_t)m * 1024 + 8 * F.lane) = o0; *(GAS v4u*)(CQN + (size_t)m * 1024 + 512 + 8 * F.lane) = o1;
        }
        {
            const v4u a = *(const GAS v4u*)(pr + PC_CKV + 8 * F.lane);
            float v[8] = {bfl(a.x), bfh(a.x), bfl(a.y), bfh(a.y), bfl(a.z), bfh(a.z), bfl(a.w), bfh(a.w)};
            float s = 0.f;
#pragma unroll
            for (int j = 0; j < 8; ++j) s += v[j] * v[j];
            const float rstd = 1.0f / sqrtf(wave_sum(s) * (1.f / 512.f) + RMS_EPS);
            const f32x4 g0 = *(const GAS f32x4*)(gkv + 8 * F.lane), g1 = *(const GAS f32x4*)(gkv + 8 * F.lane + 4);
            v4u o0;
            o0.x = pk2(v[0] * rstd * g0.x, v[1] * rstd * g0.y); o0.y = pk2(v[2] * rstd * g0.z, v[3] * rstd * g0.w); o0.z = pk2(v[4] * rstd * g1.x, v[5] * rstd * g1.y); o0.w = pk2(v[6] * rstd * g1.z, v[7] * rstd * g1.w);
            *(GAS v4u*)(CKVN + (size_t)m * 512 + 8 * F.lane) = o0;
        }
        const float* mr = misc + (size_t)m * 256;
        if (F.lane < 32) { const int i = F.lane; const float x1 = mr[i], x2 = mr[32 + i], c = cs[(size_t)m * 32 + i], s = sn[(size_t)m * 32 + i];
            *(GAS unsigned*)(KR + (size_t)m * 64 + 2 * i) = pk2(x1 * c - x2 * s, x2 * c + x1 * s); }
        else if (F.lane < 40) { const int h = F.lane - 32; const float z = mr[64 + h] + bf[h];
            LF[(size_t)m * 8 + h] = fminf(z, 0.f) - log1pf(expf(-fabsf(z))); }
    }
}
__device__ __forceinline__ void fox_scan(Frame& F, const PA& A, const int sw) {
    const int gw = sw * NWAVES + F.wave;
    const int b = gw >> 3, h = gw & 7;
    const float* LF = (const float*)(A.ws + WS_LF) + ((size_t)b * SEQ + 32 * F.lane) * 8 + h; float* FC = (float*)(A.ws + WS_FC) + ((size_t)b * SEQ + 32 * F.lane) * 8 + h;
    float v[32]; float run = 0.f;
#pragma unroll
    for (int j = 0; j < 32; ++j) { run += LF[j * 8]; v[j] = run; }
    float incl = run;
#pragma unroll
    for (int o = 1; o < 64; o <<= 1) { const float t = __shfl_up(incl, o); if (F.lane >= o) incl += t; }
    const float excl = incl - run;
#pragma unroll
    for (int j = 0; j < 32; ++j) FC[j * 8] = v[j] + excl;
}

template <int TYPE>
__device__ __forceinline__ void naive_attn_unit(const PA& A, int l, int m, int head, LAS float* qs, LAS float* sc, int lane) {
    constexpr int DK = TYPE == 0 ? 192 : 128;
    const int b = m / SEQ, t = m - b * SEQ;
    const bf16* P = (const bf16*)(A.ws + WS_PB);
    const float scale = TYPE == 0 ? 0.07216878364870323f : 0.08838834764831845f;
    if (TYPE == 0) { const bf16* qn = (const bf16*)(A.ws + WS_QN) + (size_t)m * 1024 + 128 * head; const bf16* qr = (const bf16*)(A.ws + WS_QR) + (size_t)m * 512 + 64 * head;
        qs[lane] = bfl((unsigned)qn[lane]) * scale; qs[64 + lane] = bfl((unsigned)qn[64 + lane]) * scale; qs[128 + lane] = bfl((unsigned)qr[lane]) * scale; }
    else { const bf16* q = P + (size_t)m * NINP + (TYPE == 1 ? PC_QSWA : PC_QFOX) + 128 * head; qs[lane] = bfl((unsigned)q[lane]) * scale; qs[64 + lane] = bfl((unsigned)q[64 + lane]) * scale; }
    LDS_WAIT(); asm volatile("" ::: "memory");
    const int s_lo = TYPE == 1 ? (t >= 127 ? t - 127 : 0) : 0;
    const int nk = t - s_lo + 1;
    const float slope = TYPE == 1 ? exp2f(-8.0f * (float)(head + 1) / 16.0f) : 0.f;
    const float sink = TYPE == 1 ? A.swa_sinks[l * 16 + head] : 0.f;
    const float* FC = (const float*)(A.ws + WS_FC);
    float mx = -3.0e38f;
    for (int i = lane; i < nk; i += 64) {
        const int s = s_lo + i; const size_t row = (size_t)b * SEQ + s;
        float dot = 0.f;
        if (TYPE == 0) {
            const bf16* kn = (const bf16*)(A.ws + WS_KN) + row * 1024 + 128 * head; const bf16* kr = (const bf16*)(A.ws + WS_KR) + row * 64;
            for (int d = 0; d < 128; d += 8) { const v4u w = *(const GAS v4u*)(kn + d); const LAS float* q = qs + d;
                dot += q[0] * bfl(w.x) + q[1] * bfh(w.x) + q[2] * bfl(w.y) + q[3] * bfh(w.y) + q[4] * bfl(w.z) + q[5] * bfh(w.z) + q[6] * bfl(w.w) + q[7] * bfh(w.w); }
            for (int d = 0; d < 64; d += 8) { const v4u w = *(const GAS v4u*)(kr + d); const LAS float* q = qs + 128 + d;
                dot += q[0] * bfl(w.x) + q[1] * bfh(w.x) + q[2] * bfl(w.y) + q[3] * bfh(w.y) + q[4] * bfl(w.z) + q[5] * bfh(w.z) + q[6] * bfl(w.w) + q[7] * bfh(w.w); }
        } else {
            const bf16* k = P + row * NINP + (TYPE == 1 ? PC_KSWA + 128 * (head >> 3) : PC_KFOX + 128 * head);
            for (int d = 0; d < 128; d += 8) { const v4u w = *(const GAS v4u*)(k + d); const LAS float* q = qs + d;
                dot += q[0] * bfl(w.x) + q[1] * bfh(w.x) + q[2] * bfl(w.y) + q[3] * bfh(w.y) + q[4] * bfl(w.z) + q[5] * bfh(w.z) + q[6] * bfl(w.w) + q[7] * bfh(w.w); }
            if (TYPE == 1) dot -= slope * (float)(A.pos[m] - A.pos[row]);
            if (TYPE == 2) dot += FC[(size_t)m * 8 + head] - FC[row * 8 + head];
        }
        sc[i] = dot; mx = fmaxf(mx, dot);
    }
    mx = wave_max(mx); if (TYPE == 1) mx = fmaxf(mx, sink);
    float sum = 0.f;
    for (int i = lane; i < nk; i += 64) { const float e = __expf(sc[i] - mx); sc[i] = e; sum += e; }
    sum = wave_sum(sum); if (TYPE == 1) sum += __expf(sink - mx);
    LDS_WAIT(); asm volatile("" ::: "memory");
    const bf16* vbase; int ldv;
    if (TYPE == 0) { vbase = (const bf16*)(A.ws + WS_VM) + 128 * head; ldv = 1024; } else if (TYPE == 1) { vbase = P + PC_VSWA + 128 * (head >> 3); ldv = NINP; } else { vbase = P + PC_VFOX + 128 * head; ldv = NINP; }
    vbase += ((size_t)b * SEQ + s_lo) * ldv + 2 * lane;
    float o0 = 0.f, o1 = 0.f;
    int i = 0;
    for (; i + 4 <= nk; i += 4) {
        const unsigned w0 = *(const GAS unsigned*)(vbase + (size_t)(i + 0) * ldv), w1 = *(const GAS unsigned*)(vbase + (size_t)(i + 1) * ldv), w2 = *(const GAS unsigned*)(vbase + (size_t)(i + 2) * ldv), w3 = *(const GAS unsigned*)(vbase + (size_t)(i + 3) * ldv);
        const float p0 = sc[i], p1 = sc[i + 1], p2 = sc[i + 2], p3 = sc[i + 3];
        o0 += p0 * bfl(w0) + p1 * bfl(w1) + p2 * bfl(w2) + p3 * bfl(w3); o1 += p0 * bfh(w0) + p1 * bfh(w1) + p2 * bfh(w2) + p3 * bfh(w3);
    }
    for (; i < nk; ++i) { const unsigned w0 = *(const GAS unsigned*)(vbase + (size_t)i * ldv); const float p0 = sc[i]; o0 += p0 * bfl(w0); o1 += p0 * bfh(w0); }
    const float inv = 1.0f / sum;
    bf16* op = (bf16*)(A.ws + WS_OM) + (size_t)m * DM + (TYPE == 0 ? 0 : TYPE == 1 ? 1024 : 3072) + 128 * head;
    *(GAS unsigned*)(op + 2 * lane) = pk2(o0 * inv, o1 * inv);
    LDS_WAIT(); asm volatile("" ::: "memory");
}
__device__ __forceinline__ void naive_attn_phase(Frame& F, const PA& A, int l) {
    LAS float* qs = (LAS float*)(F.lds + RING_OFF + F.wave * 9216); LAS float* sc = qs + 256;
    const int gw = A.vcu * NWAVES + F.wave, NGW = A.G * NWAVES;
    for (int u = gw; u < M * 32; u += NGW) {
        const int head = (u + (u >> 11)) & 31, m = u >> 5;
        if (head < 8) { if (!(ATT_MFMA_TYPES & 1)) naive_attn_unit<0>(A, l, m, head, qs, sc, F.lane); }
        else if (head < 24) { if (!(ATT_MFMA_TYPES & 2)) naive_attn_unit<1>(A, l, m, head - 8, qs, sc, F.lane); }
        else { if (!(ATT_MFMA_TYPES & 4)) naive_attn_unit<2>(A, l, m, head - 24, qs, sc, F.lane); }
    }
}


namespace att {
typedef short bf16x8 __attribute__((ext_vector_type(8)));
typedef short s16x4 __attribute__((ext_vector_type(4)));
typedef float f32x16 __attribute__((ext_vector_type(16)));
typedef unsigned u32x4 __attribute__((ext_vector_type(4)));
constexpr int KVBLK = 64, QBLK = 32, SHM_V = 16384, SHM_K = 16384, SHM_KR = 8192;
constexpr int L_V = 0, L_K = 3 * SHM_V, L_KR = L_K + 2 * SHM_K, L_KB = L_KR + 2 * SHM_KR, L_WS = L_KB + 2 * 256, L_END = L_WS + 8 * 256;
static_assert(L_END <= RING_BYTES, "attention LDS fits the ring region");
#define ATT_KSWZ(row, colB) ((row) * 256 + ((colB) ^ (((row) & 7) << 4)))
#define ATT_KRSWZ(row, colB) ((row) * 128 + ((colB) ^ (((row) & 7) << 4)))
#define ATT_SBAR() __builtin_amdgcn_sched_barrier(0)
__device__ __forceinline__ int v_st(int k, int c) { const int kk = (k & ~0xC) | ((k & 4) << 1) | ((k & 8) >> 1); return ((kk >> 3) * 4 + (c >> 5)) * 512 + ((kk & 7) * 32 + (c & 31)) * 2; }
__device__ __forceinline__ int v_rd_base(int lane) { return ((lane & 3) << 3) | (((lane >> 2) & 3) << 6) | (((lane >> 4) & 1) << 5) | (((lane >> 5) & 1) << 8); }
__device__ __forceinline__ int crow(int r, int hi) { return (r & 3) + 8 * (r >> 2) + 4 * hi; }
__device__ __forceinline__ unsigned cvtpk(float lo, float hi) { unsigned r; asm volatile("v_cvt_pk_bf16_f32 %0, %1, %2" : "=v"(r) : "v"(lo), "v"(hi)); return r; }
__device__ __forceinline__ void mask_tile(f32x16& p0, f32x16& p1, int dq, unsigned W) {
    const float NEG = -__builtin_inff();
#pragma unroll
    for (int r = 0; r < 16; ++r) { const int c = (r & 3) + 8 * (r >> 2);
        if ((unsigned)(dq - c) >= W) p0[r] = NEG;
        if ((unsigned)(dq - c - 32) >= W) p1[r] = NEG; }
}
template <int SC>
__device__ __forceinline__ float softmax_tile(f32x16& p0, f32x16& p1, float& m_reg, float& l_reg, bf16x8& pa0, bf16x8& pa1, bf16x8& pa2, bf16x8& pa3) {
    constexpr float SCALE = SC == 0 ? 0.07216878364870323f : 0.08838834764831845f, C2 = 1.4426950408889634f * SCALE, THR = 8.f;
    float pmax = p0[0];
#pragma unroll
    for (int r = 1; r < 16; ++r) pmax = fmaxf(pmax, p0[r]);
#pragma unroll
    for (int r = 0; r < 16; ++r) pmax = fmaxf(pmax, p1[r]);
    { auto rr = __builtin_amdgcn_permlane32_swap(__float_as_uint(pmax), __float_as_uint(pmax), false, false);
      pmax = fmaxf(__uint_as_float(rr[0]), __uint_as_float(rr[1])); }
    float mn, alpha;
    if (__builtin_expect(__all((pmax - m_reg) * SCALE <= THR), 1)) { mn = m_reg; alpha = 1.f; }
    else { mn = fmaxf(m_reg, pmax); alpha = __builtin_amdgcn_exp2f((m_reg - mn) * C2); m_reg = mn; }
    const float mnL = -mn * C2;
#pragma unroll
    for (int r = 0; r < 16; ++r) { p0[r] = __builtin_amdgcn_exp2f(fmaf(p0[r], C2, mnL)); p1[r] = __builtin_amdgcn_exp2f(fmaf(p1[r], C2, mnL)); }
    float ps = 0.f;
#pragma unroll
    for (int r = 0; r < 16; ++r) ps += p0[r] + p1[r];
    { auto rr = __builtin_amdgcn_permlane32_swap(__float_as_uint(ps), __float_as_uint(ps), false, false);
      ps = __uint_as_float(rr[0]) + __uint_as_float(rr[1]); }
    l_reg = l_reg * alpha + ps;
#define ATT_PK4(P, B_, OUT) do { unsigned a0 = cvtpk(P[B_+0], P[B_+1]), a1 = cvtpk(P[B_+2], P[B_+3]);                          \
        unsigned b0 = cvtpk(P[B_+4], P[B_+5]), b1 = cvtpk(P[B_+6], P[B_+7]);                                             \
        auto r0 = __builtin_amdgcn_permlane32_swap(a0, b0, false, false); auto r1 = __builtin_amdgcn_permlane32_swap(a1, b1, false, false); \
        u32x4 w = {r0[0], r1[0], r0[1], r1[1]}; OUT = __builtin_bit_cast(bf16x8, w); } while (0)
    ATT_PK4(p0, 0, pa0); ATT_PK4(p0, 8, pa1); ATT_PK4(p1, 0, pa2); ATT_PK4(p1, 8, pa3);
#undef ATT_PK4
    return alpha;
}
template <bool ROPE, bool BIAS>
__device__ __forceinline__ void qkt(f32x16& p0, f32x16& p1, LAS const char* lds, int buf, int r32, int hi, const bf16x8* qr, const bf16x8* qrr, float kbmul) {
    if (BIAS) { LAS const float* kb = (LAS const float*)(lds + L_KB + buf * 256) + 4 * hi;
#pragma unroll
        for (int g = 0; g < 4; ++g) { const f32x4 a = *(LAS const f32x4*)(kb + 8 * g) * kbmul, b = *(LAS const f32x4*)(kb + 32 + 8 * g) * kbmul;
            p0[4 * g] = a[0]; p0[4 * g + 1] = a[1]; p0[4 * g + 2] = a[2]; p0[4 * g + 3] = a[3]; p1[4 * g] = b[0]; p1[4 * g + 1] = b[1]; p1[4 * g + 2] = b[2]; p1[4 * g + 3] = b[3]; } }
    else { p0 = f32x16{}; p1 = f32x16{}; }
    LAS const char* kbase = lds + L_K + buf * SHM_K;
#pragma unroll
    for (int d0 = 0; d0 < 8; ++d0) { LAS const char* a = kbase + ATT_KSWZ(r32, ((d0 & 3) * 16 + hi * 8) * 2) + (d0 >> 2) * 128;
        const bf16x8 b0 = *(LAS const bf16x8*)a, b1 = *(LAS const bf16x8*)(a + 32 * 256);
        p0 = __builtin_amdgcn_mfma_f32_32x32x16_bf16(b0, qr[d0], p0, 0, 0, 0);
        p1 = __builtin_amdgcn_mfma_f32_32x32x16_bf16(b1, qr[d0], p1, 0, 0, 0); }
    if (ROPE) { LAS const char* rbase = lds + L_KR + buf * SHM_KR;
#pragma unroll
        for (int d0 = 0; d0 < 4; ++d0) { LAS const char* a = rbase + ATT_KRSWZ(r32, (d0 * 16 + hi * 8) * 2);
            const bf16x8 b0 = *(LAS const bf16x8*)a, b1 = *(LAS const bf16x8*)(a + 32 * 128);
            p0 = __builtin_amdgcn_mfma_f32_32x32x16_bf16(b0, qrr[d0], p0, 0, 0, 0);
            p1 = __builtin_amdgcn_mfma_f32_32x32x16_bf16(b1, qrr[d0], p1, 0, 0, 0); } }
}
__device__ __forceinline__ void pv_tile(f32x16* o, int vb, bf16x8 pa0, bf16x8 pa1, bf16x8 pa2, bf16x8 pa3) {
#define ATT_TRRD(dst, off) asm volatile("ds_read_b64_tr_b16 %0, %1 offset:%2" : "=&v"(dst) : "v"(vb), "i"(off) : "memory")
#define ATT_PV_D0(d0) do { s16x4 l0, l1, l2, l3, h0, h1, h2, h3; constexpr int b_ = (d0) * 512;   \
        ATT_TRRD(l0, b_); ATT_TRRD(h0, b_ + 2048); ATT_TRRD(l1, b_ + 4096); ATT_TRRD(h1, b_ + 6144); ATT_TRRD(l2, b_ + 8192); ATT_TRRD(h2, b_ + 10240); ATT_TRRD(l3, b_ + 12288); ATT_TRRD(h3, b_ + 14336); \
        asm volatile("s_waitcnt lgkmcnt(0)" ::: "memory"); ATT_SBAR();   \
        o[d0] = __builtin_amdgcn_mfma_f32_32x32x16_bf16((bf16x8){l0[0], l0[1], l0[2], l0[3], h0[0], h0[1], h0[2], h0[3]}, pa0, o[d0], 0, 0, 0);   \
        o[d0] = __builtin_amdgcn_mfma_f32_32x32x16_bf16((bf16x8){l1[0], l1[1], l1[2], l1[3], h1[0], h1[1], h1[2], h1[3]}, pa1, o[d0], 0, 0, 0);   \
        o[d0] = __builtin_amdgcn_mfma_f32_32x32x16_bf16((bf16x8){l2[0], l2[1], l2[2], l2[3], h2[0], h2[1], h2[2], h2[3]}, pa2, o[d0], 0, 0, 0);   \
        o[d0] = __builtin_amdgcn_mfma_f32_32x32x16_bf16((bf16x8){l3[0], l3[1], l3[2], l3[3], h3[0], h3[1], h3[2], h3[3]}, pa3, o[d0], 0, 0, 0); } while (0)
    ATT_PV_D0(0); ATT_PV_D0(1); ATT_PV_D0(2); ATT_PV_D0(3);
#undef ATT_PV_D0
#undef ATT_TRRD
}
template <int TYPE>
__device__ __forceinline__ void attn_unit(LAS char* lds, int tid, const bf16* Qw, int ldq, const bf16* QRw, const bf16* Kh, int ldk, const bf16* KRb, const bf16* Vh, int ldv, bf16* Ow, int ldo,
                                          int qlo, int j_lo, int j_hi, int W, const void* kbp, float kbscale, float kbref_f, int kbref_i, float sink_raw) {
    constexpr bool ROPE = TYPE == 0, BIAS = TYPE != 0; constexpr int SC = TYPE == 0 ? 0 : 1;
    constexpr float SCALE = SC == 0 ? 0.07216878364870323f : 0.08838834764831845f, C2 = 1.4426950408889634f * SCALE;
    const int wid = __builtin_amdgcn_readfirstlane(tid >> 6), lane = tid & 63, r32 = lane & 31, hi = lane >> 5;
    const int NT = j_hi - j_lo;
    bf16x8 qr[8], qrr[4];
#pragma unroll
    for (int d0 = 0; d0 < 8; ++d0) qr[d0] = *(const GAS bf16x8*)(Qw + (size_t)r32 * ldq + d0 * 16 + hi * 8);
    if (ROPE) {
#pragma unroll
        for (int d0 = 0; d0 < 4; ++d0) qrr[d0] = *(const GAS bf16x8*)(QRw + (size_t)r32 * 512 + d0 * 16 + hi * 8); }
#define ATT_STCOORD int tq_ = tid; asm volatile("" : "+v"(tq_)); const int sr = tq_ >> 4, sc = (tq_ & 15) * 8, rr_ = tq_ >> 3, rc_ = (tq_ & 7) * 8
    bf16x8 st_k0, st_k1, st_v0, st_v1, st_kr; float st_kb = 0.f;
#define ATT_LOADT(j) do { ATT_STCOORD; const int k0_ = (j) * KVBLK;                                                                                                \
        st_k0 = *(const GAS bf16x8*)(Kh + (size_t)(k0_ + sr) * ldk + sc); st_k1 = *(const GAS bf16x8*)(Kh + (size_t)(k0_ + 32 + sr) * ldk + sc);          \
        st_v0 = *(const GAS bf16x8*)(Vh + (size_t)(k0_ + sr) * ldv + sc); st_v1 = *(const GAS bf16x8*)(Vh + (size_t)(k0_ + 32 + sr) * ldv + sc);          \
        if (ROPE) st_kr = *(const GAS bf16x8*)(KRb + (size_t)(k0_ + rr_) * 64 + rc_);                                                                     \
        if (BIAS) { if (tid < 64) { if (TYPE == 2) st_kb = kbref_f - ((const GAS float*)kbp)[(size_t)(k0_ + tid) * 8];                                    \
                                    else st_kb = (float)(((const GAS int*)kbp)[k0_ + tid] - kbref_i); } } } while (0)
#define ATT_WRITET(bf, vs_) do { ATT_STCOORD; const int kws = ATT_KSWZ(sr, sc * 2), vst0 = v_st(sr, sc), vst1 = v_st(32 + sr, sc), krws = ATT_KRSWZ(rr_, rc_ * 2); (void)krws; *(LAS bf16x8*)(lds + L_K + (bf) * SHM_K + kws) = st_k0; *(LAS bf16x8*)(lds + L_K + (bf) * SHM_K + kws + 32 * 256) = st_k1;     \
        *(LAS bf16x8*)(lds + L_V + (vs_) * SHM_V + vst0) = st_v0; *(LAS bf16x8*)(lds + L_V + (vs_) * SHM_V + vst1) = st_v1;                                  \
        if (ROPE) *(LAS bf16x8*)(lds + L_KR + (bf) * SHM_KR + krws) = st_kr;                                                                              \
        if (BIAS) { if (tid < 64) *(LAS float*)(lds + L_KB + (bf) * 256 + tid * 4) = st_kb; } } while (0)
    float m_reg = -1e30f, l_reg = 0.f; f32x16 o[4] = {};
    const int vb0 = (int)(unsigned)(size_t)(lds + L_V) + v_rd_base(lane);
    const int qm = qlo + r32 - 4 * hi;
    const bool late = wid >= 4;
    bf16x8 pa0, pa1, pa2, pa3;
#define ATT_ACT(t_) ((j_lo + (t_)) * KVBLK <= qlo + QBLK - 1 && (j_lo + (t_)) * KVBLK + KVBLK - 1 >= qlo - W + 1)
#define ATT_SCORES(t_) do { const int kb_ = (j_lo + (t_)) * KVBLK; f32x16 p0, p1;                                                                      \
            qkt<ROPE, BIAS>(p0, p1, lds, (t_) & 1, r32, hi, qr, qrr, kbscale);                                                                          \
            if (kb_ + KVBLK - 1 > qlo || kb_ <= qlo + QBLK - 1 - W) mask_tile(p0, p1, qm - kb_, (unsigned)W);                                          \
            const float alpha = softmax_tile<SC>(p0, p1, m_reg, l_reg, pa0, pa1, pa2, pa3);                                                             \
            if (__any(alpha < 1.f)) { _Pragma("unroll") for (int d_ = 0; d_ < 4; ++d_) _Pragma("unroll") for (int r = 0; r < 16; ++r) o[d_][r] *= alpha; } } while (0)
#define ATT_BSTEP(t_, vsn_) do { if ((t_) + 1 < NT) { asm volatile("s_waitcnt vmcnt(0)" ::: "memory"); ATT_WRITET(((t_) + 1) & 1, vsn_); }             \
            __syncthreads(); if ((t_) + 2 < NT) { ATT_LOADT(j_lo + (t_) + 2); } } while (0)
    ATT_LOADT(j_lo); asm volatile("s_waitcnt vmcnt(0)" ::: "memory"); ATT_WRITET(0, 0);
    __syncthreads();
    if (NT > 1) { ATT_LOADT(j_lo + 1); }
    if (ATT_ACT(0)) ATT_SCORES(0);
    int vs = 0, vsn = 1, vsnn = 2;
    for (int t = 0; t < NT; ++t) {
        if (late) ATT_BSTEP(t, vsn);
        ATT_SBAR();
        if (ATT_ACT(t)) pv_tile(o, vb0 + vs * SHM_V, pa0, pa1, pa2, pa3);
        ATT_SBAR();
        if (!late) ATT_BSTEP(t, vsn);
        ATT_SBAR();
        if (t + 1 < NT) { if (ATT_ACT(t + 1)) ATT_SCORES(t + 1); }
        { const int x = vs; vs = vsn; vsn = vsnn; vsnn = x; }
    }
    __syncthreads();
#undef ATT_SCORES
#undef ATT_BSTEP
#undef ATT_ACT
    if (TYPE == 1) l_reg += __builtin_amdgcn_exp2f((sink_raw - m_reg) * C2);
    const float rl = __builtin_amdgcn_rcpf(l_reg);
    bf16* orow = Ow + (size_t)r32 * ldo + 8 * hi;
#pragma unroll
    for (int d0 = 0; d0 < 4; ++d0)
#pragma unroll
        for (int gp = 0; gp < 2; ++gp) { const int ra = 8 * gp, rb = 8 * gp + 4;
            const unsigned a0 = cvtpk(o[d0][ra] * rl, o[d0][ra + 1] * rl), a1 = cvtpk(o[d0][ra + 2] * rl, o[d0][ra + 3] * rl), b0 = cvtpk(o[d0][rb] * rl, o[d0][rb + 1] * rl), b1 = cvtpk(o[d0][rb + 2] * rl, o[d0][rb + 3] * rl);
            auto r0 = __builtin_amdgcn_permlane32_swap(a0, b0, false, false); auto r1 = __builtin_amdgcn_permlane32_swap(a1, b1, false, false);
            const u32x4 w = {r0[0], r1[0], r0[1], r1[1]};
            *(GAS u32x4*)(orow + d0 * 32 + 16 * gp) = w; }
#undef ATT_LOADT
#undef ATT_STCOORD
#undef ATT_WRITET
}
}

template <int ST>
__device__ __forceinline__ void attn_stage(Frame& F, const PA& A, int l) {
    LAS char* lds = (LAS char*)(F.lds + RING_OFF);
    const bf16* P = (const bf16*)(A.ws + WS_PB);
    const int wid = F.wave;
    if constexpr (ST == 0 && (ATT_MFMA_TYPES & 1) != 0)
    for (int item = A.vcu; item < NBATCH * 8 * 4; item += A.G) {
        const int b = item >> 5, h = (item >> 2) & 7, pr = item & 3;
#pragma unroll 1
        for (int pass = 0; pass < 2; ++pass) { const int qb = pass ? 7 - pr : pr; const size_t row0 = (size_t)b * SEQ + qb * 256 + wid * 32;
            att::attn_unit<0>(lds, F.tid, (const bf16*)(A.ws + WS_QN) + row0 * 1024 + 128 * h, 1024, (const bf16*)(A.ws + WS_QR) + row0 * 512 + 64 * h,
                              (const bf16*)(A.ws + WS_KN) + (size_t)b * SEQ * 1024 + 128 * h, 1024, (const bf16*)(A.ws + WS_KR) + (size_t)b * SEQ * 64,
                              (const bf16*)(A.ws + WS_VM) + (size_t)b * SEQ * 1024 + 128 * h, 1024, (bf16*)(A.ws + WS_OM) + row0 * DM + 128 * h, DM,
                              qb * 256 + wid * 32, 0, 4 * (qb + 1), SEQ, nullptr, 0.f, 0.f, 0, 0.f); }
    }
    if constexpr (ST == 1 && (ATT_MFMA_TYPES & 4) != 0)
    for (int item = A.vcu; item < NBATCH * 8 * 4; item += A.G) {
        const int b = item >> 5, h = (item >> 2) & 7, pr = item & 3;
        const float* FCb = (const float*)(A.ws + WS_FC) + (size_t)b * SEQ * 8 + h;
#pragma unroll 1
        for (int pass = 0; pass < 2; ++pass) { const int qb = pass ? 7 - pr : pr; const size_t row0 = (size_t)b * SEQ + qb * 256 + wid * 32;
            const float fref = FCb[(size_t)(qb * 256) * 8];
            att::attn_unit<2>(lds, F.tid, P + row0 * NINP + PC_QFOX + 128 * h, NINP, nullptr,
                              P + (size_t)b * SEQ * NINP + PC_KFOX + 128 * h, NINP, nullptr,
                              P + (size_t)b * SEQ * NINP + PC_VFOX + 128 * h, NINP, (bf16*)(A.ws + WS_OM) + row0 * DM + 3072 + 128 * h, DM,
                              qb * 256 + wid * 32, 0, 4 * (qb + 1), SEQ, FCb, 11.313708498984761f, fref, 0, 0.f); }
    }
    if constexpr (ST == 2 && (ATT_MFMA_TYPES & 2) != 0)
    for (int u = A.vcu * 4; u < NBATCH * 2 * 64; u += A.G * 4) {
#pragma unroll 1
        for (int i = 0; i < 4; ++i) { const int uu = u + i, b = uu >> 7, kvh = (uu >> 6) & 1, blk = uu & 63, t0 = blk * 32, hq = kvh * 8 + wid;
            const size_t row0 = (size_t)b * SEQ + t0; const int* posb = A.pos + (size_t)b * SEQ;
            const float slope = exp2f(-0.5f * (float)(hq + 1)); const int pref = posb[t0];
            const int klo = t0 >= 127 ? t0 - 127 : 0;
            const float sink_raw = (A.swa_sinks[l * 16 + hq] + slope * (float)(posb[t0 + (F.lane & 31)] - pref)) * 11.313708498984761f;
            att::attn_unit<1>(lds, F.tid, P + row0 * NINP + PC_QSWA + 128 * hq, NINP, nullptr,
                              P + (size_t)b * SEQ * NINP + PC_KSWA + 128 * kvh, NINP, nullptr,
                              P + (size_t)b * SEQ * NINP + PC_VSWA + 128 * kvh, NINP, (bf16*)(A.ws + WS_OM) + row0 * DM + 1024 + 128 * hq, DM,
                              t0, klo >> 6, ((t0 + 31) >> 6) + 1, 128, posb, slope * 11.313708498984761f, 0.f, pref, sink_raw); }
    }
}
__device__ __forceinline__ void load_rs_table(Frame& F, const PA& A) {
    static_assert(M / 256 == 64, "row-panel ownership of StaticOrder");
    LAS float* rsl = (LAS float*)(F.lds + RS_OFF); const float* rsg = (const float*)(A.ws + WS_RS) + 2048 * (A.bx & 7);
    for (int i = F.tid; i < 2048; i += NWAVES * 64) rsl[i] = rsg[i];
    __syncthreads();
}
constexpr int PH_PER_LAYER = 10, N_PHASES = 1 + DEPTH * PH_PER_LAYER;
#ifndef PHMASK
#define PHMASK 0x7ff
#endif
__device__ __forceinline__ Frame make_frame(LAS unsigned char* lds) {
    Frame F; F.lds = lds; int t = threadIdx.x; asm volatile("" : "+v"(t)); F.tid = t; F.lane = t & 63; F.wave = __builtin_amdgcn_readfirstlane(t >> 6); return F;
}
#define IN(k) (((PHMASK >> ((k) == 0 ? 10 : ((k) - 1) % PH_PER_LAYER)) & 1) && lo <= (k) && (k) < hi)
#define SEAM(k) do { if (IN(k) && IN((k) + 1)) { if (!MK_PER_PHASE) xcd_barrier(bar); } } while (0)
#define WSP(T, off) ((T)(A.ws + (off)))
#define PHASE_BEGIN const PA A = load_args(argw); Frame F = make_frame(ldsb)
template <int l>
__device__ __forceinline__ void layer_phases(LAS unsigned char* ldsb, const LAS unsigned* argw, const XcdBarrier& bar, const int lo, const int hi) {
        constexpr int pb = 1 + l * PH_PER_LAYER;
        if (IN(pb + 0)) {
            PHASE_BEGIN; unsigned char* wl = A.ws + WS_W + (size_t)l * WL_SIZE; load_rs_table(F, A);
            pg8::Gemm g{WSP(const bf16*, WS_HB), (const bf16*)(wl + WL_WIN), M, NIN, DM}; pg8::StaticOrder S; S.init(M, NIN, A.G, A.bx);
            pg8::EpiInproj E{WSP(bf16*, WS_PB), WSP(float*, WS_MISC), NINP, GATE_TILE0, WSP(bf16*, WS_GT), (const LAS float*)(F.lds + RS_OFF), (int)((size_t)3 * M * DM * 2)};
            if constexpr (l == 0 && CONV_IN_GEMM) {
                const int rc = 1 + (A.vcu % 18);
                { pg8::RangeOrder R{S, 0, rc}; pg8::gemm_phase<pg8::EpiInproj, pg8::RangeOrder, true, true>(F.lds + RING_OFF, g, R, E); }
                __syncthreads();
                { const PA A2 = load_args(argw); Frame F2 = make_frame(ldsb); convert_items(F2, A2, 1); }
                __syncthreads();
                { pg8::RangeOrder R{S, rc, 1 << 30}; pg8::gemm_phase<pg8::EpiInproj, pg8::RangeOrder, true, true>(F.lds + RING_OFF, g, R, E); }
            } else {
                pg8::RangeOrder R{S, 0, S.nwg / A.G}; pg8::gemm_phase<pg8::EpiInproj, pg8::RangeOrder, true, true>(F.lds + RING_OFF, g, R, E); }
        }
#if PROBE_REPEAT & 4
        if (IN(pb + 0)) {
            __syncthreads(); PHASE_BEGIN; unsigned char* wl = A.ws + WS_W + (size_t)l * WL_SIZE; load_rs_table(F, A);
            pg8::Gemm g{WSP(const bf16*, WS_HB), (const bf16*)(wl + WL_WIN), M, NIN, DM}; pg8::StaticOrder S; S.init(M, NIN, A.G, A.bx);
            pg8::EpiInproj E{WSP(bf16*, WS_PB), WSP(float*, WS_MISC), NINP, GATE_TILE0, WSP(bf16*, WS_GT), (const LAS float*)(F.lds + RS_OFF), (int)((size_t)3 * M * DM * 2)};
            pg8::gemm_phase<pg8::EpiInproj, pg8::StaticOrder, true, true>(F.lds + RING_OFF, g, S, E);
        }
#endif
        SEAM(pb + 0);
        if (IN(pb + 1)) { PHASE_BEGIN; mla_prep_rows(F, A, l, A.vcu * NWAVES + F.wave, A.G * NWAVES); }
        SEAM(pb + 1);
        if (IN(pb + 2)) {
            int left; { PHASE_BEGIN; pg8::StaticOrder S; S.init(M, NIN, A.G, A.bx); left = CONV_IN_GEMM ? 0 : S.nwg % A.G; }
            static_assert(((M / 256) * (NIN / 256) / 256 * 256 / 8) / 8 >= GATE_TILE0, "the deferred units (grid of 256) must be gate tiles: nothing before L.4 reads them");
            bool mine; { PHASE_BEGIN; mine = A.bx < left; }
            if (mine) {
                PHASE_BEGIN; unsigned char* wl = A.ws + WS_W + (size_t)l * WL_SIZE; load_rs_table(F, A);
                pg8::Gemm g{WSP(const bf16*, WS_HB), (const bf16*)(wl + WL_WIN), M, NIN, DM}; pg8::StaticOrder S; S.init(M, NIN, A.G, A.bx);
                pg8::EpiInproj E{WSP(bf16*, WS_PB), WSP(float*, WS_MISC), NINP, GATE_TILE0, WSP(bf16*, WS_GT), (const LAS float*)(F.lds + RS_OFF), (int)((size_t)3 * M * DM * 2)};
                pg8::RangeOrder R{S, S.nwg / A.G, 1 << 30}; pg8::gemm_phase<pg8::EpiInproj, pg8::RangeOrder, true, true>(F.lds + RING_OFF, g, R, E);
            } else {
                { PHASE_BEGIN; const int nn = A.G - left, c = A.bx - left; for (int sw = c - (nn > NBATCH ? nn - NBATCH : 0); sw < NBATCH; sw += nn) if (sw >= 0) fox_scan(F, A, sw); }
                { PHASE_BEGIN; unsigned char* wl = A.ws + WS_W + (size_t)l * WL_SIZE;
                  pg8::Gemm g{WSP(const bf16*, WS_CQN), (const bf16*)(wl + WL_WUQ), M, 1536, 1024}; pg8::StaticOrder S; S.init(M, 1536, A.G - left, A.bx - left);
                  pg8::EpiQup E{WSP(bf16*, WS_QN), WSP(bf16*, WS_QR), WSP(const float*, WS_ROPE), WSP(const float*, WS_ROPE) + (size_t)M * 32};
                  pg8::gemm_phase<pg8::EpiQup, pg8::StaticOrder, true, true>(F.lds + RING_OFF, g, S, E); }
                __syncthreads();
                { PHASE_BEGIN; unsigned char* wl = A.ws + WS_W + (size_t)l * WL_SIZE;
                  pg8::Gemm g{WSP(const bf16*, WS_CKVN), (const bf16*)(wl + WL_WUKV), M, 2048, 512}; pg8::StaticOrder S; S.init(M, 2048, A.G - left, A.bx - left);
                  pg8::EpiSplitBf16 E{WSP(bf16*, WS_KN), WSP(bf16*, WS_VM), 4, 1024};
                  pg8::gemm_phase<pg8::EpiSplitBf16, pg8::StaticOrder, true, true>(F.lds + RING_OFF, g, S, E); }
            }
        }
        SEAM(pb + 2);
        if (IN(pb + 3)) {
            if (ATT_MFMA_TYPES != 0) {
                constexpr int cvl = l == 0 ? cv::O_B : cv::I_LAYER + cv::O_B, cvh = l == 0 ? cv::I_LAYER + cv::O_B : DEPTH * cv::I_LAYER;
#define CONV_SLOT(k) if (CONV_UNDER_ATTN && !CONV_IN_GEMM) { PHASE_BEGIN; if (((A.bx >> 3) & 3) == (k)) { __syncthreads(); convert_span(F, A, cvl, cvh, A.vcu * NWAVES + F.wave, A.G * NWAVES); __syncthreads(); } }
                CONV_SLOT(0) { PHASE_BEGIN; attn_stage<0>(F, A, l); }
                CONV_SLOT(1) { PHASE_BEGIN; attn_stage<1>(F, A, l); }
                CONV_SLOT(2) { PHASE_BEGIN; attn_stage<2>(F, A, l); }
                CONV_SLOT(3)
#undef CONV_SLOT
            }
#if PROBE_REPEAT & 1
            { __syncthreads(); { PHASE_BEGIN; attn_stage<0>(F, A, l); } { PHASE_BEGIN; attn_stage<1>(F, A, l); } { PHASE_BEGIN; attn_stage<2>(F, A, l); } }
#endif
            if (ATT_MFMA_TYPES != 7) { __syncthreads(); PHASE_BEGIN; naive_attn_phase(F, A, l); }
        }
        SEAM(pb + 3);
        if (IN(pb + 4)) {
            PHASE_BEGIN; const bf16* WB = (const bf16*)(A.ws + WS_W + (size_t)l * WL_SIZE + WL_WB);
            pg8::Gemm g{WSP(const bf16*, WS_OM), WB, M, DM, DM}; pg8::StaticOrder S; S.init(M, DM, A.G, A.bx);
            pg8::EpiBranchFused E{WSP(const bf16*, WS_GT), WSP(bf16*, WS_MRG), DM};
            pg8::gemm_phase<pg8::EpiBranchFused, pg8::StaticOrder, true, true>(F.lds + RING_OFF, g, S, E);
        }
#if PROBE_REPEAT & 128
        __syncthreads();
        if (IN(pb + 4)) {
            PHASE_BEGIN; const bf16* WB = (const bf16*)(A.ws + WS_W + (size_t)l * WL_SIZE + WL_WB);
            pg8::Gemm g{WSP(const bf16*, WS_OM), WB, M, DM, DM}; pg8::StaticOrder S; S.init(M, DM, A.G, A.bx);
            pg8::EpiBranchFused E{WSP(const bf16*, WS_GT), WSP(bf16*, WS_MRG), DM};
            pg8::gemm_phase<pg8::EpiBranchFused, pg8::StaticOrder, true, true>(F.lds + RING_OFF, g, S, E);
        }
#endif
        SEAM(pb + 4);
        if (IN(pb + 5)) {
            PHASE_BEGIN; unsigned char* wl = A.ws + WS_W + (size_t)l * WL_SIZE;
            pg8::Gemm g{WSP(const bf16*, WS_MRG), (const bf16*)(wl + WL_WOUT), M, DM, DM}; pg8::StaticOrder S; S.init(M, DM, A.G, A.bx);
            pg8::EpiSplitBf16 E{WSP(bf16*, WS_TM), WSP(bf16*, WS_TM), 1 << 30, DM};
            pg8::gemm_phase<pg8::EpiSplitBf16, pg8::StaticOrder, true, true>(F.lds + RING_OFF, g, S, E);
        }
#if PROBE_REPEAT & 256
        __syncthreads();
        if (IN(pb + 5)) {
            PHASE_BEGIN; unsigned char* wl = A.ws + WS_W + (size_t)l * WL_SIZE;
            pg8::Gemm g{WSP(const bf16*, WS_MRG), (const bf16*)(wl + WL_WOUT), M, DM, DM}; pg8::StaticOrder S; S.init(M, DM, A.G, A.bx);
            pg8::EpiSplitBf16 E{WSP(bf16*, WS_TM), WSP(bf16*, WS_TM), 1 << 30, DM};
            pg8::gemm_phase<pg8::EpiSplitBf16, pg8::StaticOrder, true, true>(F.lds + RING_OFF, g, S, E);
        }
#endif
        SEAM(pb + 5);
        if (IN(pb + 6)) { PHASE_BEGIN; resid_rows(F, A, WSP(bf16*, WS_HB), WSP(const bf16*, WS_TM), A.g_mix_post + (size_t)l * DM, WSP(float*, WS_RS), nullptr); }
        SEAM(pb + 6);
        if (IN(pb + 7)) {
            PHASE_BEGIN; unsigned char* wl = A.ws + WS_W + (size_t)l * WL_SIZE; load_rs_table(F, A);
            pg8::Gemm g{WSP(const bf16*, WS_HB), (const bf16*)(wl + WL_WGU), M, 2 * FF, DM}; pg8::StaticOrder S; S.init(M, 2 * FF, A.G, A.bx);
            pg8::EpiSwiglu E{WSP(bf16*, WS_PB), FF, (const LAS float*)(F.lds + RS_OFF)};
            pg8::gemm_phase<pg8::EpiSwiglu, pg8::StaticOrder, true, true>(F.lds + RING_OFF, g, S, E);
        }
#if PROBE_REPEAT & 32
        if (IN(pb + 7)) {
            __syncthreads(); PHASE_BEGIN; unsigned char* wl = A.ws + WS_W + (size_t)l * WL_SIZE; load_rs_table(F, A);
            pg8::Gemm g{WSP(const bf16*, WS_HB), (const bf16*)(wl + WL_WGU), M, 2 * FF, DM}; pg8::StaticOrder S; S.init(M, 2 * FF, A.G, A.bx);
            pg8::EpiSwiglu E{WSP(bf16*, WS_PB), FF, (const LAS float*)(F.lds + RS_OFF)};
            pg8::gemm_phase<pg8::EpiSwiglu, pg8::StaticOrder, true, true>(F.lds + RING_OFF, g, S, E);
        }
#endif
        SEAM(pb + 7);
        if (IN(pb + 8)) {
            PHASE_BEGIN; unsigned char* wl = A.ws + WS_W + (size_t)l * WL_SIZE;
            pg8::Gemm g{WSP(const bf16*, WS_PB), (const bf16*)(wl + WL_WD), M, DM, FF}; pg8::StaticOrder S; S.init(M, DM, A.G, A.bx);
            pg8::EpiSplitBf16 E{WSP(bf16*, WS_TM), WSP(bf16*, WS_TM), 1 << 30, DM};
            pg8::gemm_phase<pg8::EpiSplitBf16, pg8::StaticOrder, true, true>(F.lds + RING_OFF, g, S, E);
        }
#if PROBE_REPEAT & 64
        if (IN(pb + 8)) {
            __syncthreads(); PHASE_BEGIN; unsigned char* wl = A.ws + WS_W + (size_t)l * WL_SIZE;
            pg8::Gemm g{WSP(const bf16*, WS_PB), (const bf16*)(wl + WL_WD), M, DM, FF}; pg8::StaticOrder S; S.init(M, DM, A.G, A.bx);
            pg8::EpiSplitBf16 E{WSP(bf16*, WS_TM), WSP(bf16*, WS_TM), 1 << 30, DM};
            pg8::gemm_phase<pg8::EpiSplitBf16, pg8::StaticOrder, true, true>(F.lds + RING_OFF, g, S, E);
        }
#endif
        SEAM(pb + 8);
        if (IN(pb + 9)) { PHASE_BEGIN;
            resid_rows(F, A, WSP(bf16*, WS_HB), WSP(const bf16*, WS_TM), A.g_ffn_post + (size_t)l * DM, WSP(float*, WS_RS), l + 1 < DEPTH ? (float*)nullptr : A.out); }
        SEAM(pb + 9);
}
__global__ void __launch_bounds__(NWAVES * 64, 2) fwd_kernel(Ptrs A0) {
    extern __shared__ __attribute__((aligned(16))) unsigned char lds[];
    LAS unsigned char* ldsb = (LAS unsigned char*)lds;
    LAS unsigned* argw = (LAS unsigned*)(ldsb + LDSCTL_OFF);
    volatile LAS unsigned* MISC = (volatile LAS unsigned*)(ldsb + MISC_OFF);
    for (int u = threadIdx.x; u < (LDS_BYTES - LDSCTL_OFF) / 4; u += NWAVES * 64) ((LAS unsigned*)(ldsb + LDSCTL_OFF))[u] = 0u;
    __syncthreads();
    if (threadIdx.x == 0) park_args(A0, argw);
    const int lo = A0.ph_lo, hi = A0.ph_hi;
    unsigned* barw = (unsigned*)(A0.ws + WS_CTL) + CW_BAR;
    __syncthreads();
    XcdBarrier bar; bar.bar = barw; bar.x = 0; bar.st = nullptr;
    if (!MK_PER_PHASE) bar = xcd_barrier_post(barw, MISC + 8);

    if (IN(0)) { PHASE_BEGIN; convert_items(F, A, 0); if (!CONV_IN_GEMM) convert_span(F, A, cv::I_IN, CONV_UNDER_ATTN ? cv::O_B : DEPTH * cv::I_LAYER, A.vcu * NWAVES + F.wave, A.G * NWAVES); rope_tables(F, A); x_in_rows(F, A, A.x, WSP(bf16*, WS_HB), WSP(float*, WS_RS)); }
#if PROBE_REPEAT & 8
    if (IN(0)) { for (int rep = 0; rep < 4; ++rep) { __syncthreads(); PHASE_BEGIN; x_in_rows(F, A, A.x, WSP(bf16*, WS_HB), WSP(float*, WS_RS)); } }
#endif
#if PROBE_REPEAT & 16
    if (IN(0)) { for (int rep = 0; rep < 20; ++rep) xcd_barrier(bar); }
#endif
#if PROBE_REPEAT & 2
    if (IN(0)) { __syncthreads(); PHASE_BEGIN; convert_items(F, A, 0); convert_items(F, A, 1); }
#endif
    SEAM(0);
    layer_phases<0>(ldsb, argw, bar, lo, hi);
    layer_phases<1>(ldsb, argw, bar, lo, hi);
    static_assert(DEPTH == 2, "two layers written out");
}
#undef IN
#undef SEAM
#undef WSP
#undef PHASE_BEGIN

extern "C" void kernel_launch(void* const* d_in, const int* in_sizes, int n_in, void* d_out, int out_size, void* d_ws, size_t ws_size, hipStream_t stream) {
    static int grid = 0;
    if (grid == 0) {
        if (n_in != 17 || in_sizes[0] != M * DM || out_size != M * DM || ws_size < WS_END) { fprintf(stderr, "kernel_launch: unexpected shapes (n_in %d, in0 %d, out %d, ws %zu < %zu); nothing launched\n", n_in, n_in > 0 ? in_sizes[0] : -1, out_size, ws_size, (size_t)WS_END); grid = -1; return; }
        int dev = 0, cus = 0, per_cu = 0;
        if (hipGetDevice(&dev) != hipSuccess || hipDeviceGetAttribute(&cus, hipDeviceAttributeMultiprocessorCount, dev) != hipSuccess) { fprintf(stderr, "kernel_launch: device query failed\n"); grid = -1; return; }
        if (hipFuncSetAttribute((const void*)fwd_kernel, hipFuncAttributeMaxDynamicSharedMemorySize, LDS_BYTES) != hipSuccess) { fprintf(stderr, "kernel_launch: hipFuncSetAttribute failed\n"); grid = -1; return; }
        if (hipOccupancyMaxActiveBlocksPerMultiprocessor(&per_cu, (const void*)fwd_kernel, NWAVES * 64, LDS_BYTES) != hipSuccess || per_cu < 1) { fprintf(stderr, "kernel_launch: occupancy query reports %d workgroups per CU\n", per_cu); }
        (void)hipGetLastError();
        if (cus % 8 != 0) { fprintf(stderr, "kernel_launch: %d CUs: the row-panel ownership the epilogues rely on needs a grid that is a multiple of 8; nothing launched\n", cus); grid = -1; return; }
        grid = cus;
    }
    if (grid < 0) return;
    if (hipMemsetAsync((char*)d_ws + WS_CTL, 0, CTL_ZERO_BYTES, stream) != hipSuccess) { fprintf(stderr, "kernel_launch: memset failed\n"); return; }
    Ptrs a{};
    a.x = (const float*)d_in[0]; a.pos = (const int*)d_in[1]; a.g_mix_pre = (const float*)d_in[2]; a.g_mix_post = (const float*)d_in[3]; a.g_ffn_pre = (const float*)d_in[4]; a.g_ffn_post = (const float*)d_in[5];
    a.w_in = (const float*)d_in[6]; a.g_q_lora = (const float*)d_in[7]; a.w_uq = (const float*)d_in[8]; a.g_kv_lora = (const float*)d_in[9]; a.w_ukv = (const float*)d_in[10]; a.b_forget = (const float*)d_in[11];
    a.swa_sinks = (const float*)d_in[12]; a.w_branch = (const float*)d_in[13]; a.w_out = (const float*)d_in[14]; a.w_gate_up = (const float*)d_in[15]; a.w_down = (const float*)d_in[16];
    a.out = (float*)d_out; a.ws = (unsigned char*)d_ws;
#if MK_PER_PHASE
    for (int k = 0; k < N_PHASES; ++k) { a.ph_lo = k; a.ph_hi = k + 1; hipLaunchKernelGGL(fwd_kernel, dim3(grid), dim3(NWAVES * 64), LDS_BYTES, stream, a); }
#else
    a.ph_lo = 0; a.ph_hi = N_PHASES; hipLaunchKernelGGL(fwd_kernel, dim3(grid), dim3(NWAVES * 64), LDS_BYTES, stream, a);
#endif
    const hipError_t le = hipPeekAtLastError();
    if (le != hipSuccess) fprintf(stderr, "kernel_launch: launch failed: %s\n", hipGetErrorName(le));
}
```

```cpp
#include <hip/hip_runtime.h>
#include <cstdio>
#include <cstdint>
namespace pg8 {
#define PG8_LAS __attribute__((address_space(3)))
typedef unsigned short bf16_t;
typedef short bf16x8 __attribute__((ext_vector_type(8)));
typedef float f32x4 __attribute__((ext_vector_type(4)));
typedef unsigned u32x4 __attribute__((ext_vector_type(4)));
constexpr int BM = 256, BK = 64, HALF = 128, HTB = HALF * BK * 2  , STAGE_BYTES = 8 * HTB, NXCD = 8, WGM = 8;

__host__ __device__ __forceinline__ int lds_byte(int r, int c) { const int st = (r >> 4) * 2 + (c >> 5), rr = r & 15, cc = c & 31, ob = rr * 64 + cc * 2; return st * 1024 + (ob ^ (((ob >> 9) & 1) << 5)); }
__host__ __device__ __forceinline__ void stage_rc(int b, int& R, int& C) { const int st = b / 1024, sb = b % 1024, swz = sb ^ (((sb >> 9) & 1) << 5); R = (st >> 1) * 16 + swz / 64; C = (st & 1) * 32 + (swz % 64) / 2; }
__host__ __device__ __forceinline__ int perm32(int rho) { const int n = rho >> 4, i = rho & 15; return 8 * (i >> 2) + 4 * n + (i & 3); }

struct Unit { int pm, pn; };
struct Gemm { const bf16_t* A; const bf16_t* Bt; int M, N, K; };

struct StaticOrder {
    int nM, nN, nwg, G, c;
    __host__ __device__ void init(int M, int N, int G_, int c_) { nM = M / BM; nN = N / BM; nwg = nM * nN; G = G_; c = c_; }
    __host__ __device__ bool next(int i, Unit& u) const {
        const long L = (long)i * G + c; if (L >= nwg) return false;
        int wgid = (int)L; { const int q = nwg / NXCD, r = nwg % NXCD, xcd = wgid % NXCD, off = wgid / NXCD; wgid = (xcd < r ? xcd * (q + 1) : r * (q + 1) + (xcd - r) * q) + off; }
        const int nig = WGM * nN, gid = wgid / nig, fm = gid * WGM, gsz = (nM - fm) < WGM ? (nM - fm) : WGM;
        u.pm = fm + ((wgid % nig) % gsz); u.pn = (wgid % nig) / gsz; return true;
    }
    __device__ __forceinline__ void a_ready(const Unit&) const {}
    __device__ __forceinline__ void done(const Unit&) const {}
};
struct RangeOrder {
    StaticOrder S; int i0, i1;
    __host__ __device__ bool next(int i, Unit& u) const { return (i0 + i < i1) && S.next(i0 + i, u); }
    __device__ __forceinline__ void a_ready(const Unit&) const {}
    __device__ __forceinline__ void done(const Unit&) const {}
};
__device__ __forceinline__ unsigned cvt_pk_bf16(float lo, float hi) { unsigned r; asm volatile("v_cvt_pk_bf16_f32 %0, %1, %2" : "=v"(r) : "v"(lo), "v"(hi)); return r; }
typedef float f32x2 __attribute__((ext_vector_type(2)));
__device__ __forceinline__ float sigmoid_f(float v) { return __builtin_amdgcn_rcpf(1.0f + __builtin_amdgcn_exp2f(-1.4426950408889634f * v)); }
__device__ __forceinline__ u32x4 pack8_bf16(const f32x4 v0, const f32x4 v1) { u32x4 w; w.x = cvt_pk_bf16(v0[0], v0[1]); w.y = cvt_pk_bf16(v0[2], v0[3]); w.z = cvt_pk_bf16(v1[0], v1[1]); w.w = cvt_pk_bf16(v1[2], v1[3]); return w; }
__device__ __forceinline__ float bf_lo(unsigned w) { return __uint_as_float(w << 16); }
__device__ __forceinline__ float bf_hi(unsigned w) { return __uint_as_float(w & 0xffff0000u); }

__device__ __forceinline__ size_t gate_tile_elem(int gt, int pm, int wr, int wc, int fr, int fq) {
    const int i = gt >> 4, pn = gt & 15;
    return ((size_t)((i * 64 + pm) * 16 + pn) * 8 + (wr * 4 + wc)) * 8192 + (size_t)(fq * 16 + fr) * 8;
}
typedef unsigned v4u32_t __attribute__((__vector_size__(16)));
__device__ __forceinline__ void st_wt16(u32x4 v, __amdgpu_buffer_rsrc_t rsrc, int byte_off) { __builtin_amdgcn_raw_buffer_store_b128(__builtin_bit_cast(v4u32_t, v), rsrc, byte_off, 0, 16); }
struct EpiInproj {
    static constexpr bool PERM = true, AFTER_DRAIN = false, HAS_MID = false;
    bf16_t* P; float* misc; int ldp; int gate_t0; bf16_t* GT; PG8_LAS const float* rsl; int gt_bytes;
    __device__ __forceinline__ void operator()(const f32x4 (&acc)[2][2][4][2], const Unit& u, int wr, int wc, int fr, int fq) const {
        const int row0 = u.pm * BM + wr * 64 + fr, cl = wc * 32 + 8 * fq;
#define PG8_LOAD_RS float rs[2][4]; _Pragma("unroll") for (int ai = 0; ai < 2; ++ai) _Pragma("unroll") for (int m = 0; m < 4; ++m) rs[ai][m] = rsl[(u.pm & 7) * BM + wr * 64 + fr + ai * HALF + m * 16];
        if (u.pn == 6) {
            PG8_LOAD_RS
#pragma unroll
            for (int ai = 0; ai < 2; ++ai)
#pragma unroll
                for (int m = 0; m < 4; ++m) { float* rowp = misc + (size_t)(row0 + ai * HALF + m * 16) * 256 + cl;
#pragma unroll
                    for (int bj = 0; bj < 2; ++bj) { *(f32x4*)(rowp + bj * HALF) = acc[ai][bj][m][0] * rs[ai][m]; *(f32x4*)(rowp + bj * HALF + 4) = acc[ai][bj][m][1] * rs[ai][m]; } }
        } else if (u.pn < gate_t0) {
            PG8_LOAD_RS
#pragma unroll
            for (int ai = 0; ai < 2; ++ai)
#pragma unroll
                for (int m = 0; m < 4; ++m) { bf16_t* rowp = P + (size_t)(row0 + ai * HALF + m * 16) * ldp + u.pn * BM + cl;
#pragma unroll
                    for (int bj = 0; bj < 2; ++bj) *(u32x4*)(rowp + bj * HALF) = pack8_bf16(acc[ai][bj][m][0] * rs[ai][m], acc[ai][bj][m][1] * rs[ai][m]); }
        } else {
            PG8_LOAD_RS
            const size_t tpo = gate_tile_elem(u.pn - gate_t0, u.pm, wr, wc, fr, fq);
            const __amdgpu_buffer_rsrc_t gt_rsrc = __builtin_amdgcn_make_buffer_rsrc((void*)GT, 0, gt_bytes, 0x00020000);
#pragma unroll
            for (int ai = 0; ai < 2; ++ai)
#pragma unroll
                for (int m = 0; m < 4; ++m)
#pragma unroll
                    for (int bj = 0; bj < 2; ++bj) { f32x4 v0 = acc[ai][bj][m][0] * rs[ai][m], v1 = acc[ai][bj][m][1] * rs[ai][m];
#pragma unroll
                        for (int e = 0; e < 4; ++e) { v0[e] = fmaxf(sigmoid_f(v0[e]), 1e-20f); v1[e] = fmaxf(sigmoid_f(v1[e]), 1e-20f); }
                        st_wt16(pack8_bf16(v0, v1), gt_rsrc, (int)(tpo + (size_t)(((ai * 4 + m) * 2 + bj) * 512)) * 2); }
        }
    }
};
#undef PG8_LOAD_RS
struct EpiSplitBf16 {
    static constexpr bool PERM = true, AFTER_DRAIN = false, HAS_MID = false;
    bf16_t* O0; bf16_t* O1; int split; int ldc;
    __device__ __forceinline__ void operator()(const f32x4 (&acc)[2][2][4][2], const Unit& u, int wr, int wc, int fr, int fq) const {
        const int row0 = u.pm * BM + wr * 64 + fr; bf16_t* base = u.pn < split ? O0 : O1; const int col0 = (u.pn < split ? u.pn : u.pn - split) * BM + wc * 32 + 8 * fq;
#pragma unroll
        for (int ai = 0; ai < 2; ++ai)
#pragma unroll
            for (int m = 0; m < 4; ++m) { bf16_t* rowp = base + (size_t)(row0 + ai * HALF + m * 16) * ldc + col0;
#pragma unroll
                for (int bj = 0; bj < 2; ++bj) *(u32x4*)(rowp + bj * HALF) = pack8_bf16(acc[ai][bj][m][0], acc[ai][bj][m][1]); }
    }
};
struct EpiQup {
    static constexpr bool PERM = true, AFTER_DRAIN = false, HAS_MID = false;
    bf16_t* QN; bf16_t* QR; const float* cs; const float* sn;
    __device__ __forceinline__ void operator()(const f32x4 (&acc)[2][2][4][2], const Unit& u, int wr, int wc, int fr, int fq) const {
        const int row0 = u.pm * BM + wr * 64 + fr;
        if (u.pn < 4) {
            const int col0 = u.pn * BM + wc * 32 + 8 * fq;
#pragma unroll
            for (int ai = 0; ai < 2; ++ai)
#pragma unroll
                for (int m = 0; m < 4; ++m) { bf16_t* rowp = QN + (size_t)(row0 + ai * HALF + m * 16) * 1024 + col0;
#pragma unroll
                    for (int bj = 0; bj < 2; ++bj) *(u32x4*)(rowp + bj * HALF) = pack8_bf16(acc[ai][bj][m][0], acc[ai][bj][m][1]); }
        } else {
            const int col0 = (u.pn - 4) * BM + wc * 32 + 8 * fq;
#pragma unroll
            for (int ai = 0; ai < 2; ++ai)
#pragma unroll
                for (int m = 0; m < 4; ++m) { const int row = row0 + ai * HALF + m * 16;
#pragma unroll
                    for (int bj = 0; bj < 2; ++bj) { const int c = col0 + bj * HALF, i0 = (c & 63) >> 1;
                        const f32x4 cv = *(const f32x4*)(cs + (size_t)row * 32 + i0), sv = *(const f32x4*)(sn + (size_t)row * 32 + i0);
                        const f32x4 a = acc[ai][bj][m][0], b = acc[ai][bj][m][1]; f32x4 o0, o1;
                        o0[0] = a[0] * cv[0] - a[1] * sv[0]; o0[1] = a[1] * cv[0] + a[0] * sv[0]; o0[2] = a[2] * cv[1] - a[3] * sv[1]; o0[3] = a[3] * cv[1] + a[2] * sv[1];
                        o1[0] = b[0] * cv[2] - b[1] * sv[2]; o1[1] = b[1] * cv[2] + b[0] * sv[2]; o1[2] = b[2] * cv[3] - b[3] * sv[3]; o1[3] = b[3] * cv[3] + b[2] * sv[3];
                        *(u32x4*)(QR + (size_t)row * 512 + c) = pack8_bf16(o0, o1); } }
        }
    }
};
template <int MODE> struct EpiBranch {
    static constexpr bool PERM = true, AFTER_DRAIN = false, HAS_MID = false;
    const bf16_t* G; int ldg; float* T; bf16_t* MRG; int ldc;
    __device__ __forceinline__ void operator()(const f32x4 (&acc)[2][2][4][2], const Unit& u, int wr, int wc, int fr, int fq) const {
        const int row0 = u.pm * BM + wr * 64 + fr, col0 = u.pn * BM + wc * 32 + 8 * fq;
#pragma unroll
        for (int ai = 0; ai < 2; ++ai)
#pragma unroll
            for (int m = 0; m < 4; ++m) { const size_t row = (size_t)(row0 + ai * HALF + m * 16);
#pragma unroll
                for (int bj = 0; bj < 2; ++bj) { const int c = col0 + bj * HALF;
                    const u32x4 gw = *(const u32x4*)(G + row * ldg + c);
                    f32x4 v0 = acc[ai][bj][m][0], v1 = acc[ai][bj][m][1];
                    v0[0] *= bf_lo(gw.x); v0[1] *= bf_hi(gw.x); v0[2] *= bf_lo(gw.y); v0[3] *= bf_hi(gw.y);
                    v1[0] *= bf_lo(gw.z); v1[1] *= bf_hi(gw.z); v1[2] *= bf_lo(gw.w); v1[3] *= bf_hi(gw.w);
                    float* tp = T + row * ldc + c;
                    if (MODE >= 1) { v0 += *(const f32x4*)tp; v1 += *(const f32x4*)(tp + 4); }
                    if (MODE <= 1) { *(f32x4*)tp = v0; *(f32x4*)(tp + 4) = v1; }
                    else *(u32x4*)(MRG + row * ldc + c) = pack8_bf16(v0, v1); } }
    }
};
__device__ __forceinline__ void gate_load8(u32x4 (&g)[8], const bf16_t* tpm) {
    asm volatile(
        "global_load_dwordx4 %0, %8, off offset:-4096\n\t"  "global_load_dwordx4 %1, %8, off offset:-3072\n\t"
        "global_load_dwordx4 %2, %8, off offset:-2048\n\t"  "global_load_dwordx4 %3, %8, off offset:-1024\n\t"
        "global_load_dwordx4 %4, %8, off\n\t"               "global_load_dwordx4 %5, %8, off offset:1024\n\t"
        "global_load_dwordx4 %6, %8, off offset:2048\n\t"   "global_load_dwordx4 %7, %8, off offset:3072\n\t"
        "s_waitcnt vmcnt(0)"
        : "=&v"(g[0]), "=&v"(g[1]), "=&v"(g[2]), "=&v"(g[3]), "=&v"(g[4]), "=&v"(g[5]), "=&v"(g[6]), "=&v"(g[7])
        : "v"(tpm) : "memory");
}
__device__ __forceinline__ void gate_load16(u32x4 (&g)[16], const bf16_t* tp) {
    const bf16_t* tpa = tp + 4 * 512; const bf16_t* tpb = tp + 12 * 512;
    asm volatile(
        "global_load_dwordx4 %0, %16, off offset:-4096\n\t"  "global_load_dwordx4 %1, %16, off offset:-3072\n\t"
        "global_load_dwordx4 %2, %16, off offset:-2048\n\t"  "global_load_dwordx4 %3, %16, off offset:-1024\n\t"
        "global_load_dwordx4 %4, %16, off\n\t"               "global_load_dwordx4 %5, %16, off offset:1024\n\t"
        "global_load_dwordx4 %6, %16, off offset:2048\n\t"   "global_load_dwordx4 %7, %16, off offset:3072\n\t"
        "global_load_dwordx4 %8, %17, off offset:-4096\n\t"  "global_load_dwordx4 %9, %17, off offset:-3072\n\t"
        "global_load_dwordx4 %10, %17, off offset:-2048\n\t" "global_load_dwordx4 %11, %17, off offset:-1024\n\t"
        "global_load_dwordx4 %12, %17, off\n\t"              "global_load_dwordx4 %13, %17, off offset:1024\n\t"
        "global_load_dwordx4 %14, %17, off offset:2048\n\t"  "global_load_dwordx4 %15, %17, off offset:3072\n\t"
        "s_waitcnt vmcnt(0)"
        : "=&v"(g[0]), "=&v"(g[1]), "=&v"(g[2]), "=&v"(g[3]), "=&v"(g[4]), "=&v"(g[5]), "=&v"(g[6]), "=&v"(g[7]),
          "=&v"(g[8]), "=&v"(g[9]), "=&v"(g[10]), "=&v"(g[11]), "=&v"(g[12]), "=&v"(g[13]), "=&v"(g[14]), "=&v"(g[15])
        : "v"(tpa), "v"(tpb) : "memory");
}
struct EpiBranchFused {
    static constexpr bool PERM = true, AFTER_DRAIN = false, HAS_MID = true;
    static constexpr int T1 = 16, T2 = 48;
    const bf16_t* GT; bf16_t* MRG; int ldc;
    __device__ __forceinline__ void mid(f32x4 (&acc)[2][2][4][2], const Unit& u, int seg, int, int, int, int) const {
        int t_ = threadIdx.x; asm volatile("" : "+v"(t_));
        const int wid_ = __builtin_amdgcn_readfirstlane(t_ >> 6), wr = wid_ >> 2, wc = wid_ & 3, fr = t_ & 15, fq = (t_ & 63) >> 4;
#pragma unroll
        for (int pass = 0; pass < 2; ++pass) {
            u32x4 gw[16]; gate_load16(gw, GT + gate_tile_elem((seg + pass) * 16 + u.pn, u.pm, wr, wc, fr, fq));
#pragma unroll
            for (int ai = 0; ai < 2; ++ai)
#pragma unroll
                for (int m = 0; m < 4; ++m)
#pragma unroll
                    for (int bj = 0; bj < 2; ++bj) { const u32x4 w = gw[(ai * 4 + m) * 2 + bj];
                        f32x4 s0 = {bf_lo(w.x), bf_hi(w.x), bf_lo(w.y), bf_hi(w.y)}, s1 = {bf_lo(w.z), bf_hi(w.z), bf_lo(w.w), bf_hi(w.w)};
                        if (pass == 1) {
#pragma unroll
                            for (int e = 0; e < 4; ++e) { s0[e] = __builtin_amdgcn_rcpf(fmaxf(s0[e], 1e-30f)); s1[e] = __builtin_amdgcn_rcpf(fmaxf(s1[e], 1e-30f)); } }
                        acc[ai][bj][m][0] *= s0; acc[ai][bj][m][1] *= s1;
                        asm volatile("" : "+v"(acc[ai][bj][m][0]), "+v"(acc[ai][bj][m][1])); }
        }
    }
    __device__ __forceinline__ void operator()(const f32x4 (&acc)[2][2][4][2], const Unit& u, int, int, int, int) const {
        int t_ = threadIdx.x; asm volatile("" : "+v"(t_));
        const int wid_ = __builtin_amdgcn_readfirstlane(t_ >> 6), wr = wid_ >> 2, wc = wid_ & 3, fr = t_ & 15, fq = (t_ & 63) >> 4;
        const int row0 = u.pm * BM + wr * 64 + fr, col0 = u.pn * BM + wc * 32 + 8 * fq;
        u32x4 gw[16]; gate_load16(gw, GT + gate_tile_elem(2 * 16 + u.pn, u.pm, wr, wc, fr, fq));
#pragma unroll
        for (int ai = 0; ai < 2; ++ai) {
#pragma unroll
            for (int m = 0; m < 4; ++m) { const size_t row = (size_t)(row0 + ai * HALF + m * 16);
#pragma unroll
                for (int bj = 0; bj < 2; ++bj) { const int c = col0 + bj * HALF; const u32x4 g = gw[(ai * 4 + m) * 2 + bj];
                    f32x4 v0 = acc[ai][bj][m][0], v1 = acc[ai][bj][m][1];
                    v0[0] *= bf_lo(g.x); v0[1] *= bf_hi(g.x); v0[2] *= bf_lo(g.y); v0[3] *= bf_hi(g.y);
                    v1[0] *= bf_lo(g.z); v1[1] *= bf_hi(g.z); v1[2] *= bf_lo(g.w); v1[3] *= bf_hi(g.w);
                    *(u32x4*)(MRG + row * ldc + c) = pack8_bf16(v0, v1); } }
            __builtin_amdgcn_sched_barrier(0); }
    }
};
struct EpiSwiglu {
    static constexpr bool PERM = true, AFTER_DRAIN = false, HAS_MID = false;
    bf16_t* H; int ldh; PG8_LAS const float* rsl;
    __device__ __forceinline__ void operator()(const f32x4 (&acc)[2][2][4][2], const Unit& u, int wr, int wc, int fr, int fq) const {
        const int row0 = u.pm * BM + wr * 64 + fr, col0 = u.pn * HALF + wc * 32 + 8 * fq;
#pragma unroll
        for (int ai = 0; ai < 2; ++ai)
#pragma unroll
            for (int m = 0; m < 4; ++m) { f32x4 o0, o1; const float rs = rsl[(u.pm & 7) * BM + wr * 64 + fr + ai * HALF + m * 16]; const f32x4 g0 = acc[ai][0][m][0] * rs, g1 = acc[ai][0][m][1] * rs, u0 = acc[ai][1][m][0] * rs, u1 = acc[ai][1][m][1] * rs;
#pragma unroll
                for (int e = 0; e < 4; ++e) { o0[e] = g0[e] * sigmoid_f(g0[e]) * u0[e]; o1[e] = g1[e] * sigmoid_f(g1[e]) * u1[e]; }
                *(u32x4*)(H + (size_t)(row0 + ai * HALF + m * 16) * ldh + col0) = pack8_bf16(o0, o1); }
    }
};
struct EpiF32 {
    static constexpr bool PERM = false, AFTER_DRAIN = false, HAS_MID = false;
    float* C; int ldc;
    __device__ __forceinline__ void operator()(const f32x4 (&acc)[2][2][4][2], const Unit& u, int wr, int wc, int fr, int fq) const {
        const int row0 = u.pm * BM + wr * 64 + fr, col0 = u.pn * BM + wc * 32 + 4 * fq;
#pragma unroll
        for (int ai = 0; ai < 2; ++ai)
#pragma unroll
            for (int m = 0; m < 4; ++m) { float* rowp = C + (size_t)(row0 + ai * HALF + m * 16) * ldc + col0;
#pragma unroll
                for (int bj = 0; bj < 2; ++bj)
#pragma unroll
                    for (int n = 0; n < 2; ++n) *(f32x4*)(rowp + bj * HALF + n * 16) = acc[ai][bj][m][n]; }
    }
};

#define PG8_KTILE_PAIR \
            const bool last = (t == nt - 2); \
            const char* a1 = cA + (size_t)(t + 1) * kstepA; \
            const char* a2 = last ? nA : cA + (size_t)(t + 2) * kstepA; const char* b2 = last ? nB : cB + (size_t)(t + 2) * kstepB; \
            const char* a3 = a2 + kstepA; const char* b3 = b2 + kstepB; \
            if (last && has_next) S.a_ready(nxt); \
            if constexpr (SP2) { \
            PG8_LDB(B0, 0, 0); PG8_LDB(B1, 0, 1); PG8_SCHED; PG8_LDA(At, 0, 0); PG8_STAGE(PG8_SA(1, 1), a1 + hstepA, voffA); \
            PG8_WAIT_V(8); PG8_WAIT_L(0); PG8_BAR; PG8_MMA(0, 0, At, B0); PG8_MMA(0, 1, At, B1); PG8_BAR; PG8_SCHED; \
            PG8_LDA(At, 0, 1); PG8_STAGE(PG8_SB(0, 0), b2, voffB); PG8_STAGE(PG8_SB(0, 1), b2 + hstepB, voffB); PG8_STAGE(PG8_SA(0, 0), a2, voffA); \
            PG8_WAIT_V(8); PG8_WAIT_L(0); PG8_BAR; PG8_MMA(1, 0, At, B0); PG8_MMA(1, 1, At, B1); PG8_BAR; PG8_SCHED; \
            PG8_LDB(B0, 1, 0); PG8_LDB(B1, 1, 1); PG8_SCHED; PG8_LDA(At, 1, 0); PG8_STAGE(PG8_SA(0, 1), a2 + hstepA, voffA); \
            PG8_WAIT_V(8); PG8_WAIT_L(0); PG8_BAR; PG8_MMA(0, 0, At, B0); PG8_MMA(0, 1, At, B1); PG8_BAR; PG8_SCHED; \
            PG8_LDA(At, 1, 1); PG8_STAGE(PG8_SB(1, 0), b3, voffB); PG8_STAGE(PG8_SB(1, 1), b3 + hstepB, voffB); PG8_STAGE(PG8_SA(1, 0), a3, voffA); \
            PG8_WAIT_V(8); PG8_WAIT_L(0); PG8_BAR; PG8_MMA(1, 0, At, B0); PG8_MMA(1, 1, At, B1); PG8_BAR; PG8_SCHED; \
            } else { \
            PG8_LDB(B0, 0, 0); PG8_SCHED; PG8_LDA(At, 0, 0); PG8_STAGE(PG8_SA(1, 1), a1 + hstepA, voffA); \
            PG8_WAIT_L(8); PG8_BAR; PG8_WAIT_L(0); PG8_MMA(0, 0, At, B0); PG8_BAR; PG8_SCHED; \
            PG8_LDB(B1, 0, 1); PG8_STAGE(PG8_SB(0, 0), b2, voffB); \
            PG8_BAR; PG8_WAIT_L(0); PG8_MMA(0, 1, At, B1); PG8_BAR; \
            PG8_LDA(At, 0, 1); PG8_STAGE(PG8_SA(0, 0), a2, voffA); \
            PG8_BAR; PG8_WAIT_L(0); PG8_MMA(1, 0, At, B0); PG8_BAR; PG8_SCHED; \
            PG8_STAGE(PG8_SB(0, 1), b2 + hstepB, voffB); \
            PG8_WAIT_V(6); PG8_BAR; PG8_MMA(1, 1, At, B1); PG8_BAR; \
            PG8_LDB(B0, 1, 0); PG8_SCHED; PG8_LDA(At, 1, 0); PG8_STAGE(PG8_SA(0, 1), a2 + hstepA, voffA); \
            PG8_WAIT_L(8); PG8_BAR; PG8_WAIT_L(0); PG8_MMA(0, 0, At, B0); PG8_BAR; PG8_SCHED; \
            PG8_LDB(B1, 1, 1); PG8_STAGE(PG8_SB(1, 0), b3, voffB); \
            PG8_BAR; PG8_WAIT_L(0); PG8_MMA(0, 1, At, B1); PG8_BAR; \
            PG8_LDA(At, 1, 1); PG8_STAGE(PG8_SA(1, 0), a3, voffA); \
            PG8_BAR; PG8_WAIT_L(0); PG8_MMA(1, 0, At, B0); PG8_BAR; PG8_SCHED; \
            PG8_STAGE(PG8_SB(1, 1), b3 + hstepB, voffB); \
            PG8_WAIT_V(6); PG8_BAR; PG8_MMA(1, 1, At, B1); PG8_BAR; \
            }
template <class Epi, class Sched, bool ALIGN_EPI = false, bool SP2 = false>
__device__ __forceinline__ void gemm_phase(PG8_LAS unsigned char* lds, const Gemm g, const Sched& S, const Epi& E) {
    int tid_ = threadIdx.x; asm volatile("" : "+v"(tid_));
    const int tid = tid_, wid = __builtin_amdgcn_readfirstlane(tid >> 6), lane = tid & 63, wr = wid >> 2, wc = wid & 3, fr = lane & 15, fq = lane >> 4;
    const int K = g.K, nt = K / BK;
    unsigned voffA[2], voffB[2];
#define PG8_LANE_VOFF(tid__) do { _Pragma("unroll") for (int i = 0; i < 2; ++i) { int R, C; stage_rc((tid__) * 16 + i * 8192, R, C); const int Rb = Epi::PERM ? ((R & ~31) + perm32(R & 31)) : R; \
        voffA[i] = (unsigned)(R * K + C) * 2u; (void)Rb; voffB[i] = (unsigned)((tid__) * 16 + i * 8192); } } while (0)
    PG8_LANE_VOFF(tid);
    const size_t kstepA = (size_t)(BK * 2), kstepB = 2 * HTB;
    const size_t hstepA = (size_t)HALF * K * 2, hstepB = HTB;
    const size_t tstepA = 2 * hstepA, tstepB = (size_t)nt * 2 * HTB;
    const unsigned ldsw = (unsigned)wid * 1024u;
    int aoff = lds_byte(wr * 64 + fr, fq * 8), boff = lds_byte(wc * 32 + fr, fq * 8);
#define PG8_LANE_REBUILD() do { int t__ = threadIdx.x; asm volatile("" : "+v"(t__)); PG8_LANE_VOFF(t__); const int l__ = t__ & 63, w__ = __builtin_amdgcn_readfirstlane(t__ >> 6); \
        aoff = lds_byte((w__ >> 2) * 64 + (l__ & 15), (l__ >> 4) * 8); boff = lds_byte((w__ & 3) * 32 + (l__ & 15), (l__ >> 4) * 8); } while (0)
#define PG8_SA(b, h) (((b) * 2 + (h)) * HTB)
#define PG8_SB(b, h) ((4 + (b) * 2 + (h)) * HTB)
#define PG8_STAGE(bufoff, gbase, voff) do { _Pragma("unroll") for (int _i = 0; _i < 2; ++_i) \
        __builtin_amdgcn_global_load_lds((const unsigned*)((const char*)(gbase) + (voff)[_i]), (PG8_LAS unsigned*)(lds + (bufoff) + ldsw + _i * 8192), 16, 0, 0); } while (0)
#define PG8_LDA(dst, b, h) do { _Pragma("unroll") for (int m = 0; m < 4; ++m) _Pragma("unroll") for (int k = 0; k < 2; ++k) dst[m][k] = *(const PG8_LAS bf16x8*)(lds + PG8_SA(b, h) + aoff + m * 2048 + k * 1024); } while (0)
#define PG8_LDB(dst, b, h) do { _Pragma("unroll") for (int n = 0; n < 2; ++n) _Pragma("unroll") for (int k = 0; k < 2; ++k) dst[n][k] = *(const PG8_LAS bf16x8*)(lds + PG8_SB(b, h) + boff + n * 2048 + k * 1024); } while (0)
#define PG8_MMA(ai, bj, At, Bt) do { __builtin_amdgcn_s_setprio(1); _Pragma("unroll") for (int k = 0; k < 2; ++k) _Pragma("unroll") for (int m = 0; m < 4; ++m) _Pragma("unroll") for (int n = 0; n < 2; ++n) \
        acc[ai][bj][m][n] = __builtin_amdgcn_mfma_f32_16x16x32_bf16(Bt[n][k], At[m][k], acc[ai][bj][m][n], 0, 0, 0); __builtin_amdgcn_s_setprio(0); } while (0)
#define PG8_WAIT_V(n) asm volatile("s_waitcnt vmcnt(" #n ")" ::: "memory")
#define PG8_WAIT_L(n) asm volatile("s_waitcnt lgkmcnt(" #n ")" ::: "memory")
#define PG8_BAR __builtin_amdgcn_s_barrier()
#define PG8_SCHED __builtin_amdgcn_sched_barrier(0)
    Unit cur, nxt; int ui = 0;
    if (!S.next(0, cur)) return;
    f32x4 acc[2][2][4][2];
#pragma unroll
    for (int a = 0; a < 2; ++a)
#pragma unroll
        for (int b = 0; b < 2; ++b)
#pragma unroll
            for (int m = 0; m < 4; ++m)
#pragma unroll
                for (int n = 0; n < 2; ++n) acc[a][b][m][n] = (f32x4){0.f, 0.f, 0.f, 0.f};
    bf16x8 At[4][2], B0[2][2], B1[2][2];
    const char* cA = (const char*)g.A + (size_t)cur.pm * tstepA; const char* cB = (const char*)g.Bt + (size_t)cur.pn * tstepB;
    S.a_ready(cur);
    if constexpr (SP2) {
        PG8_STAGE(PG8_SB(0, 0), cB, voffB); PG8_STAGE(PG8_SB(0, 1), cB + hstepB, voffB); PG8_STAGE(PG8_SA(0, 0), cA, voffA); PG8_STAGE(PG8_SA(0, 1), cA + hstepA, voffA);
        if (wr == 1) PG8_BAR;
        PG8_WAIT_V(2); PG8_BAR;
        PG8_STAGE(PG8_SB(1, 0), cB + kstepB, voffB); PG8_STAGE(PG8_SA(1, 0), cA + kstepA, voffA); PG8_STAGE(PG8_SB(1, 1), cB + hstepB + kstepB, voffB);
        PG8_WAIT_V(6); PG8_BAR;
    } else {
        PG8_STAGE(PG8_SB(0, 0), cB, voffB); PG8_STAGE(PG8_SA(0, 0), cA, voffA); PG8_STAGE(PG8_SB(0, 1), cB + hstepB, voffB); PG8_STAGE(PG8_SA(0, 1), cA + hstepA, voffA);
        if (wr == 1) PG8_BAR;
        PG8_WAIT_V(4); PG8_BAR;
        PG8_STAGE(PG8_SB(1, 0), cB + kstepB, voffB); PG8_STAGE(PG8_SA(1, 0), cA + kstepA, voffA); PG8_STAGE(PG8_SB(1, 1), cB + hstepB + kstepB, voffB);
        PG8_WAIT_V(6); PG8_BAR;
    }
    for (;;) {
        const bool has_next = S.next(ui + 1, nxt);
        const char* nA = has_next ? (const char*)g.A + (size_t)nxt.pm * tstepA : cA; const char* nB = has_next ? (const char*)g.Bt + (size_t)nxt.pn * tstepB : cB;
        int t = 0;
        if constexpr (Epi::HAS_MID) {
            for (; t < Epi::T1; t += 2) { PG8_KTILE_PAIR }
            E.mid(acc, cur, 0, wr, wc, fr, fq); PG8_LANE_REBUILD();
            for (; t < Epi::T2; t += 2) { PG8_KTILE_PAIR }
            E.mid(acc, cur, 1, wr, wc, fr, fq); PG8_LANE_REBUILD();
        }
        for (; t < nt; t += 2) { PG8_KTILE_PAIR }
        if constexpr (ALIGN_EPI) { if (wr == 0) PG8_BAR; }
        if constexpr (!Epi::AFTER_DRAIN) { E(acc, cur, wr, wc, fr, fq); S.done(cur); }
        if (!has_next) break;
#pragma unroll
        for (int a = 0; a < 2; ++a)
#pragma unroll
            for (int b = 0; b < 2; ++b)
#pragma unroll
                for (int m = 0; m < 4; ++m)
#pragma unroll
                    for (int n = 0; n < 2; ++n) acc[a][b][m][n] = (f32x4){0.f, 0.f, 0.f, 0.f};
        cur = nxt; cA = nA; cB = nB; ++ui;
        if constexpr (ALIGN_EPI) { if (wr == 1) PG8_BAR; }
    }
    PG8_WAIT_V(0);
    if constexpr (!ALIGN_EPI) { if (wr == 0) PG8_BAR; }
    PG8_BAR;
    if constexpr (Epi::AFTER_DRAIN) { E.fused(acc, cur, wr, wc, fr, fq, lds, wid, lane); S.done(cur); }
#undef PG8_SA
#undef PG8_SB
#undef PG8_STAGE
#undef PG8_LDA
#undef PG8_LDB
#undef PG8_MMA
#undef PG8_WAIT_V
#undef PG8_WAIT_L
#undef PG8_BAR
#undef PG8_SCHED
#undef PG8_LANE_VOFF
#undef PG8_LANE_REBUILD
#undef PG8_KTILE_PAIR
}
}

constexpr int NWAVES = 8;
#ifndef ATT_MFMA_TYPES
#define ATT_MFMA_TYPES 7
#endif
#ifndef PROBE_REPEAT
#define PROBE_REPEAT 0
#endif
#ifndef CONV_IN_GEMM
#define CONV_IN_GEMM 0
#endif
#ifndef MK_PER_PHASE
#define MK_PER_PHASE 0
#endif

constexpr int DM = 4096, NBATCH = 8, SEQ = 2048, M = NBATCH * SEQ, DEPTH = 2;
constexpr int NIN_SRC = 19528, NIN = 19712;
constexpr int FF = 11008;
constexpr float RMS_EPS = 1e-6f;
constexpr int PC_CQ = 0, PC_CKV = 1024, PC_MISC = 1536  , PC_QSWA = 1792, PC_KSWA = 3840, PC_VSWA = 4096, PC_QFOX = 4352, PC_KFOX = 5376, PC_VFOX = 6400, PC_GATE = 7424;
constexpr int GATE_TILE0 = PC_GATE / 256;
static_assert(PC_GATE + 3 * DM == NIN && NIN % 256 == 0 && PC_MISC / 256 == 6, "in-projection map");
constexpr int NINP = PC_GATE;

constexpr size_t MiB = 1u << 20;
constexpr size_t WS_CTL = 0, CTL_ZERO_BYTES = 1 * MiB;
constexpr size_t SZ_WIN = (size_t)NIN * DM * 2, SZ_WUQ = (size_t)1536 * 1024 * 2, SZ_WUKV = (size_t)2048 * 512 * 2, SZ_WB = (size_t)DM * DM * 2, SZ_WOUT = (size_t)DM * DM * 2,
                 SZ_WGU = (size_t)2 * FF * DM * 2, SZ_WD = (size_t)DM * FF * 2;
constexpr size_t WL_WIN = 0, WL_WUQ = WL_WIN + SZ_WIN, WL_WUKV = WL_WUQ + SZ_WUQ, WL_WB = WL_WUKV + SZ_WUKV, WL_WOUT = WL_WB + SZ_WB, WL_WGU = WL_WOUT + SZ_WOUT, WL_WD = WL_WGU + SZ_WGU,
                 WL_SIZE = WL_WD + SZ_WD;
constexpr size_t WS_W = 1 * MiB;
constexpr size_t WS_ROPE = WS_W + DEPTH * WL_SIZE;
constexpr size_t WS_HB = WS_ROPE + 4 * MiB;
constexpr size_t WS_PB = WS_HB + (size_t)M * DM * 2;
constexpr size_t WS_GT = WS_PB + (size_t)M * NINP * 2;
constexpr size_t WS_MISC = WS_PB + (size_t)M * NIN * 2;
constexpr size_t WS_CQN = WS_MISC + (size_t)M * 256 * 4;
constexpr size_t WS_CKVN = WS_CQN + (size_t)M * 1024 * 2;
constexpr size_t WS_KR = WS_CKVN + (size_t)M * 512 * 2;
constexpr size_t WS_LF = WS_KR + (size_t)M * 64 * 2;
constexpr size_t WS_FC = WS_LF + (size_t)M * 8 * 4;
constexpr size_t WS_QN = WS_FC + (size_t)M * 8 * 4;
constexpr size_t WS_QR = WS_QN + (size_t)M * 1024 * 2;
constexpr size_t WS_KN = WS_QR + (size_t)M * 512 * 2;
constexpr size_t WS_VM = WS_KN + (size_t)M * 1024 * 2;
constexpr size_t WS_OM = WS_VM + (size_t)M * 1024 * 2;
constexpr size_t WS_OS = WS_OM + (size_t)M * 1024 * 2;
constexpr size_t WS_OF = WS_OS + (size_t)M * 2048 * 2;
constexpr size_t WS_TM = WS_OF + (size_t)M * 1024 * 2;
constexpr size_t WS_MRG = WS_TM + (size_t)M * DM * 4;
constexpr size_t WS_RS = WS_MRG + (size_t)M * DM * 2;
constexpr size_t WS_END = WS_RS + (size_t)M * 4;
static_assert(WS_END <= (size_t)2752 * MiB, "d_ws map exceeds the guaranteed workspace");
static_assert((size_t)M * FF * 2 <= (size_t)M * NIN * 2 && WS_GT + (size_t)3 * M * DM * 2 <= WS_MISC, "HID overlays P + GT");
constexpr int CW_TMO = 0, CW_CODE = 1;
constexpr int CW_BAR = 4096;

constexpr int RING_OFF = 0, RING_BYTES = 131072;
constexpr int LDSCTL_OFF = RING_BYTES, MISC_OFF = LDSCTL_OFF + 320;
constexpr int RS_OFF = 133120;
constexpr int LDS_BYTES = 147456;
static_assert(MISC_OFF + 128 <= RS_OFF && RS_OFF + 8192 <= LDS_BYTES, "LDS map");

#define GAS __attribute__((address_space(1)))
#define LAS __attribute__((address_space(3)))
typedef unsigned short bf16;
typedef unsigned v4u __attribute__((ext_vector_type(4)));
typedef unsigned v2u __attribute__((ext_vector_type(2)));
typedef float f32x4 __attribute__((ext_vector_type(4)));
typedef short bf16x8 __attribute__((ext_vector_type(8)));
typedef GAS unsigned gu32;
typedef GAS unsigned long long gu64;
#define RLX_AGENT __ATOMIC_RELAXED, __HIP_MEMORY_SCOPE_AGENT
#define LDS_WAIT() asm volatile("s_waitcnt lgkmcnt(0)" ::: "memory")
#define VM_WAIT() asm volatile("s_waitcnt vmcnt(0)" ::: "memory")
__device__ __forceinline__ unsigned long long rt() { return __builtin_amdgcn_s_memrealtime(); }
__device__ __forceinline__ unsigned f2bf(float f) { unsigned u = __builtin_bit_cast(unsigned, f); return (u + 0x7fffu + ((u >> 16) & 1u)) >> 16; }
__device__ __forceinline__ unsigned pk2(float lo, float hi) { return f2bf(lo) | (f2bf(hi) << 16); }

#define XB_TMO      128
#define XB_XCNT(j)  (256  + 64 * (j))
#define XB_XSUB(j)  (1280 + 64 * (j))
#define XB_XGEN(j)  (2304 + 64 * (j))
#define XB_TOP      3328
#define XB_TOPGEN   3392
#define XCD_BAR_WORDS 3456
#define XB_SPIN_CAP (1u << 23)

__device__ __forceinline__ unsigned xb_ld(unsigned* p)              { return __hip_atomic_load(p, __ATOMIC_RELAXED, __HIP_MEMORY_SCOPE_AGENT); }
__device__ __forceinline__ unsigned xb_add(unsigned* p, unsigned v) { return __hip_atomic_fetch_add(p, v, __ATOMIC_RELAXED, __HIP_MEMORY_SCOPE_AGENT); }
__device__ __forceinline__ unsigned xb_xcc_id() { return (unsigned)__builtin_amdgcn_s_getreg((3 << 11) | 20) & 0xFu; }
#define XB_SPIN(cond, bar) do { unsigned _sp = 0; while (cond) { __builtin_amdgcn_s_sleep(1); \
    if ((++_sp & 255u) == 0u) { if (xb_ld(&(bar)[XB_TMO])) break; if (_sp > XB_SPIN_CAP) { atomicAdd(&(bar)[XB_TMO], 1u); break; } } } } while (0)

struct XcdBarrier {
    unsigned* bar; unsigned x;
    volatile LAS unsigned* st;
};

__device__ __forceinline__ XcdBarrier xcd_barrier_post(unsigned* bar, volatile LAS unsigned* st) {
    XcdBarrier b; b.bar = bar; b.x = xb_xcc_id(); b.st = st;
    if (threadIdx.x == 0) (void)xb_add(&bar[XB_XCNT(b.x)], 1u);
    return b;
}
__device__ __forceinline__ void xcd_barrier_complete(unsigned* bar, unsigned x, unsigned& nloc, unsigned& nx) {
    const unsigned G = gridDim.x * gridDim.y * gridDim.z;
    unsigned sum, cnt, mine, sp = 0u;
    for (;;) {
        sum = 0u; cnt = 0u; mine = 0u;
#pragma unroll
        for (unsigned j = 0; j < 16; ++j) { const unsigned c = xb_ld(&bar[XB_XCNT(j)]); sum += c; cnt += (c > 0u) ? 1u : 0u; mine = (j == x) ? c : mine; }
        if (sum == G) break;
        __builtin_amdgcn_s_sleep(1);
        if ((++sp & 255u) == 0u) { if (xb_ld(&bar[XB_TMO])) break; if (sp > XB_SPIN_CAP) { atomicAdd(&bar[XB_TMO], 1u); break; } }
    }
    nloc = mine > 0u ? mine : 1u; nx = cnt > 0u ? cnt : 1u;
}

__device__ __forceinline__ void xcd_barrier(const XcdBarrier& b) {
    asm volatile("s_waitcnt vmcnt(0)" ::: "memory");
    __syncthreads();
    if (threadIdx.x == 0) {
        unsigned* bar = b.bar;
        __builtin_amdgcn_s_waitcnt(0);
        unsigned nloc = b.st[0], nx = b.st[1];
        if (nloc == 0u) { xcd_barrier_complete(bar, b.x, nloc, nx); b.st[0] = nloc; b.st[1] = nx; }
        const unsigned old = xb_add(&bar[XB_XSUB(b.x)], 1u);
        const unsigned gen = old / nloc;
        if (old + 1u == (gen + 1u) * nloc) {
            __builtin_amdgcn_fence(__ATOMIC_RELEASE, "agent");
            asm volatile("s_waitcnt vmcnt(0)" ::: "memory");
            const unsigned og = xb_add(&bar[XB_TOP], 1u);
            const unsigned tg = og / nx;
            if (og + 1u == (tg + 1u) * nx) xb_add(&bar[XB_TOPGEN], 1u);
            else XB_SPIN(xb_ld(&bar[XB_TOPGEN]) == tg, bar);
            __builtin_amdgcn_fence(__ATOMIC_ACQUIRE, "agent");
            xb_add(&bar[XB_XGEN(b.x)], 1u);
            asm volatile("s_waitcnt vmcnt(0)" ::: "memory");
        } else {
            XB_SPIN(xb_ld(&bar[XB_XGEN(b.x)]) == gen, bar);
            __builtin_amdgcn_fence(__ATOMIC_ACQUIRE, "agent");
            asm volatile("s_waitcnt vmcnt(0)" ::: "memory");
        }
    }
    __syncthreads();
}

struct Frame {
    LAS unsigned char* lds;
    int tid, lane, wave;
};
__device__ __forceinline__ float wave_sum(float v) {
#pragma unroll
    for (int o = 1; o < 64; o <<= 1) v += __shfl_xor(v, o);
    return v;
}
__device__ __forceinline__ float wave_max(float v) {
#pragma unroll
    for (int o = 1; o < 64; o <<= 1) v = fmaxf(v, __shfl_xor(v, o));
    return v;
}
__device__ __forceinline__ float bfl(unsigned w) { return __uint_as_float(w << 16); }
__device__ __forceinline__ float bfh(unsigned w) { return __uint_as_float(w & 0xffff0000u); }

__device__ __forceinline__ void sincos_f(float x, float& s, float& c) {
    const float k = rintf(x * 0.636619772367581f);
    float r = fmaf(k, -1.5703125f, x); r = fmaf(k, -4.837512969970703125e-4f, r); r = fmaf(k, -7.549789948768648e-8f, r);
    const int q = (int)k & 3; const float z = r * r;
    const float sp = fmaf(r * z, fmaf(z, fmaf(z, -1.9515295891e-4f, 8.3321608736e-3f), -1.6666654611e-1f), r);
    const float cp = fmaf(z * z, fmaf(z, fmaf(z, 2.443315711809948e-5f, -1.388731625493765e-3f), 4.166664568298827e-2f), fmaf(z, -0.5f, 1.0f));
    float ss = (q & 1) ? cp : sp, cc = (q & 1) ? sp : cp;
    if (q & 2) ss = -ss; if ((q + 1) & 2) cc = -cc;
    s = ss; c = cc;
}

#ifndef WEIGHT_DROP_BITS
#define WEIGHT_DROP_BITS 2
#endif
__device__ __forceinline__ unsigned f2bfw(float f, unsigned drop) { const unsigned SH = 16u + drop; unsigned u = __builtin_bit_cast(unsigned, f); return ((u + ((1u << (SH - 1u)) - 1u) + ((u >> SH) & 1u)) >> SH) << drop; }
__device__ __forceinline__ unsigned pk2w(float lo, float hi, unsigned drop) { return f2bfw(lo, drop) | (f2bfw(hi, drop) << 16); }
__device__ __forceinline__ void tr_item(const float* W, int ldw, int K, bf16* WT, int k0, int dst_row0, int src_col0, int nvalid, int mode, LAS float* scr, int lane, const float* gk = nullptr, unsigned drop = WEIGHT_DROP_BITS) {
    if (mode == 0) {
        const int r8 = lane >> 3, c4 = (lane & 7) * 4; const bool ok = c4 < nvalid;
        const float* src = W + (size_t)(k0 + r8) * ldw + src_col0 + c4;
        f32x4 v[8];
#pragma unroll
        for (int i = 0; i < 8; ++i) v[i] = ok ? *(const GAS f32x4*)(src + (size_t)(8 * i) * ldw) : (f32x4){0.f, 0.f, 0.f, 0.f};
        if (gk) {
#pragma unroll
            for (int i = 0; i < 8; ++i) v[i] = v[i] * gk[k0 + 8 * i + r8]; }
#pragma unroll
        for (int i = 0; i < 8; ++i) { LAS float* dd = scr + (8 * i + r8) * 33 + c4; dd[0] = v[i].x; dd[1] = v[i].y; dd[2] = v[i].z; dd[3] = v[i].w; }
    } else {
        const int c = lane & 31; const int scol = src_col0 + 32 * (c & 1) + (c >> 1);
        const float* src = W + (size_t)(k0 + (lane >> 5)) * ldw + scol;
#pragma unroll 8
        for (int i = 0; i < 32; ++i) { const int kk = 2 * i + (lane >> 5); scr[kk * 33 + c] = src[(size_t)(2 * i) * ldw]; }
    }
    LDS_WAIT(); asm volatile("" ::: "memory");
    const int cc = lane & 7;
#pragma unroll
    for (int j = 0; j < 4; ++j) { const int n = (lane >> 3) + 8 * j; const LAS float* s = scr + (8 * cc) * 33 + n;
        v4u o; o.x = pk2w(s[0 * 33], s[1 * 33], drop); o.y = pk2w(s[2 * 33], s[3 * 33], drop); o.z = pk2w(s[4 * 33], s[5 * 33], drop); o.w = pk2w(s[6 * 33], s[7 * 33], drop);
        const int w = dst_row0 + n, wl = w & 127, x = wl & 31, R = (wl & ~31) + ((((x >> 2) & 1) << 4) | ((x >> 3) << 2) | (x & 3));
        *(GAS v4u*)((GAS unsigned char*)WT + ((size_t)((w >> 8) * (K >> 6) + (k0 >> 6)) * 2 + ((w >> 7) & 1)) * 16384 + pg8::lds_byte(R, 8 * cc)) = o; }
    LDS_WAIT(); asm volatile("" ::: "memory");
}
#define PTR_FIELDS(X) X(const float*, x) X(const int*, pos) X(const float*, g_mix_pre) X(const float*, g_mix_post) X(const float*, g_ffn_pre) X(const float*, g_ffn_post) X(const float*, w_in) \
    X(const float*, g_q_lora) X(const float*, w_uq) X(const float*, g_kv_lora) X(const float*, w_ukv) X(const float*, b_forget) X(const float*, swa_sinks) X(const float*, w_branch) X(const float*, w_out) \
    X(const float*, w_gate_up) X(const float*, w_down) X(float*, out) X(unsigned char*, ws)
constexpr int N_PTRS = 19;
struct Ptrs {
#define X(T, n) T n;
    PTR_FIELDS(X)
#undef X
    int ph_lo, ph_hi;
};
static_assert(sizeof(Ptrs) == N_PTRS * 8 + 8, "Ptrs has no padding");
struct PA : Ptrs { int G, bx, vcu; };
__device__ __forceinline__ unsigned long long ld_u64u(const LAS unsigned* w) { const unsigned lo = (unsigned)__builtin_amdgcn_readfirstlane((int)w[0]), hi = (unsigned)__builtin_amdgcn_readfirstlane((int)w[1]); return ((unsigned long long)hi << 32) | lo; }
__device__ __forceinline__ void park_args(const Ptrs& A0, LAS unsigned* argw) {
    LAS unsigned long long* a64 = (LAS unsigned long long*)argw; int i = 0;
#define X(T, n) a64[i++] = (unsigned long long)A0.n;
    PTR_FIELDS(X)
#undef X
    const int G = gridDim.x, bx = blockIdx.x;
    argw[2 * N_PTRS + 0] = (unsigned)G; argw[2 * N_PTRS + 1] = (unsigned)bx; argw[2 * N_PTRS + 2] = (unsigned)((G % 8 == 0) ? (bx % 8) * (G / 8) + bx / 8 : bx);
}
__device__ __forceinline__ PA load_args(const LAS unsigned* argw) {
    asm volatile("" ::: "memory");
    PA A; int i = 0;
#define X(T, n) A.n = (T)(GAS unsigned char*)ld_u64u(argw + 2 * (i++));
    PTR_FIELDS(X)
#undef X
    A.G = __builtin_amdgcn_readfirstlane((int)argw[2 * N_PTRS + 0]); A.bx = __builtin_amdgcn_readfirstlane((int)argw[2 * N_PTRS + 1]); A.vcu = __builtin_amdgcn_readfirstlane((int)argw[2 * N_PTRS + 2]);
    A.ph_lo = 0; A.ph_hi = 0;
    return A;
}
namespace cv {
constexpr int NB_IN = NIN / 32, NB_UQ = 1536 / 32, NB_UKV = 2048 / 32, NB_D = DM / 32, NB_GU = 2 * FF / 32;
constexpr int I_IN = (DM / 64) * NB_IN, I_UQ = (1024 / 64) * NB_UQ, I_UKV = (512 / 64) * NB_UKV, I_B0 = (1024 / 64) * NB_D, I_B1 = (2048 / 64) * NB_D, I_B2 = I_B0,
              I_OUT = (DM / 64) * NB_D, I_GU = (DM / 64) * NB_GU, I_D = (FF / 64) * NB_D;
constexpr int O_B = I_IN + I_UQ + I_UKV, O_GU = O_B + I_B0 + I_B1 + I_B2 + I_OUT, O_D = O_GU + I_GU;
constexpr int I_LAYER = O_D + I_D;
#ifndef CONV_UNDER_ATTN
#define CONV_UNDER_ATTN 1
#endif
#ifndef TAIL_T0
#define TAIL_T0 30208
#endif
#ifndef TAIL_T1
#define TAIL_T1 16384
#endif
#ifndef TAIL_T2
#define TAIL_T2 28000
#endif
#ifndef TAIL_T3
#define TAIL_T3 16384
#endif
constexpr int T0_LO = I_LAYER - TAIL_T0, T0_HI = I_LAYER;
constexpr int T1_LO = I_LAYER + O_B, T1_HI = T1_LO + TAIL_T1;
constexpr int T2_LO = I_LAYER + O_GU, T2_HI = T2_LO + TAIL_T2;
constexpr int T3_LO = I_LAYER + O_D, T3_HI = T3_LO + TAIL_T3;
static_assert(T0_LO >= O_GU && T1_HI <= I_LAYER + O_GU && T2_HI <= I_LAYER + O_D && T3_HI <= 2 * I_LAYER && DEPTH == 2, "tail slots");
}
__device__ __forceinline__ void convert_one(const PA& A, const int it, LAS float* scr, const int lane) {
    using namespace cv;
        const int l = it / I_LAYER; int r = it - l * I_LAYER;
        unsigned char* wl = A.ws + WS_W + (size_t)l * WL_SIZE;
        if (r < I_IN) { const int kb = r / NB_IN, nb = r - kb * NB_IN, n0 = nb * 32; int sc, nv;
            if (n0 < 1600) { sc = n0; nv = 32; } else if (n0 < 1632) { sc = 7232; nv = 8; } else if (n0 < PC_QSWA) { sc = 0; nv = 0; } else if (n0 < PC_GATE) { sc = n0 - 192; nv = 32; } else { sc = n0 - 184; nv = 32; }
            tr_item(A.w_in + (size_t)l * DM * NIN_SRC, NIN_SRC, DM, (bf16*)(wl + WL_WIN), kb * 64, n0, sc, nv, 0, scr, lane, A.g_mix_pre + (size_t)l * DM, WEIGHT_DROP_BITS); return; } r -= I_IN;
        if (r < I_UQ) { const int kb = r / NB_UQ, nb = r - kb * NB_UQ, n0 = nb * 32; int sc, mode;
            if (n0 < 1024) { sc = 192 * (n0 >> 7) + (n0 & 127); mode = 0; } else { const int q = n0 - 1024; sc = 192 * (q >> 6) + 128 + 16 * ((q >> 5) & 1); mode = 1; }
            tr_item(A.w_uq + (size_t)l * 1024 * 1536, 1536, 1024, (bf16*)(wl + WL_WUQ), kb * 64, n0, sc, 32, mode, scr, lane, nullptr, 0u); return; } r -= I_UQ;
        if (r < I_UKV) { const int kb = r / NB_UKV, nb = r - kb * NB_UKV, n0 = nb * 32; const int q = n0 & 1023;
            const int sc = 256 * (q >> 7) + (q & 127) + (n0 >= 1024 ? 128 : 0);
            tr_item(A.w_ukv + (size_t)l * 512 * 2048, 2048, 512, (bf16*)(wl + WL_WUKV), kb * 64, n0, sc, 32, 0, scr, lane, nullptr, 0u); return; } r -= I_UKV;
        if (r < I_B0 + I_B1 + I_B2) { const int kb = r / NB_D, nb = r - kb * NB_D;
            tr_item(A.w_branch + (size_t)l * DM * DM, DM, DM, (bf16*)(wl + WL_WB), kb * 64, nb * 32, nb * 32, 32, 0, scr, lane); return; } r -= I_B0 + I_B1 + I_B2;
        if (r < I_OUT) { const int kb = r / NB_D, nb = r - kb * NB_D;
            tr_item(A.w_out + (size_t)l * DM * DM, DM, DM, (bf16*)(wl + WL_WOUT), kb * 64, nb * 32, nb * 32, 32, 0, scr, lane); return; } r -= I_OUT;
        if (r < I_GU) { const int kb = r / NB_GU, nb = r - kb * NB_GU, n0 = nb * 32;
            const int sc = ((n0 >> 7) & 1) * FF + 128 * (n0 >> 8) + (n0 & 127);
            tr_item(A.w_gate_up + (size_t)l * DM * 2 * FF, 2 * FF, DM, (bf16*)(wl + WL_WGU), kb * 64, n0, sc, 32, 0, scr, lane, A.g_ffn_pre + (size_t)l * DM, WEIGHT_DROP_BITS); return; } r -= I_GU;
        { const int kb = r / NB_D, nb = r - kb * NB_D;
            tr_item(A.w_down + (size_t)l * FF * DM, DM, FF, (bf16*)(wl + WL_WD), kb * 64, nb * 32, nb * 32, 32, 0, scr, lane, nullptr, WEIGHT_DROP_BITS); }
}
__device__ __forceinline__ void convert_span(Frame& F, const PA& A, const int lo, const int hi, const int gw, const int NGW) {
    LAS float* scr = (LAS float*)(F.lds + RING_OFF + F.wave * 16384);
    for (int it = lo + gw; it < hi; it += NGW) convert_one(A, it, scr, F.lane);
}
__device__ __forceinline__ void convert_items(Frame& F, const PA& A, const int mode) {
    using namespace cv;
    const int gw = A.vcu * NWAVES + F.wave, NGW = A.G * NWAVES;
    if (mode == 0) { convert_span(F, A, 0, I_IN, gw, NGW); return; }
    if (mode == 1) { convert_span(F, A, I_IN, DEPTH * I_LAYER, gw, NGW); return; }
    LAS float* scr = (LAS float*)(F.lds + RING_OFF + F.wave * 16384);
    constexpr int n1 = T0_LO - I_IN, n2 = T1_LO - T0_HI, n3 = T2_LO - T1_HI, n4 = T3_LO - T2_HI, n5 = DEPTH * I_LAYER - T3_HI;
    for (int v = gw; v < n1 + n2 + n3 + n4 + n5; v += NGW) {
        const int it = v < n1 ? I_IN + v : v < n1 + n2 ? T0_HI + (v - n1) : v < n1 + n2 + n3 ? T1_HI + (v - n1 - n2) : v < n1 + n2 + n3 + n4 ? T2_HI + (v - n1 - n2 - n3) : T3_HI + (v - n1 - n2 - n3 - n4);
        convert_one(A, it, scr, F.lane); }
}
__device__ __forceinline__ void convert_tail(Frame& F, const PA& A, const int lo, const int hi, const int first_idle) {
    if (A.G != 256 || A.bx < first_idle) return;
    convert_span(F, A, lo, hi, (A.bx - first_idle) * NWAVES + F.wave, (256 - first_idle) * NWAVES);
}
__device__ __forceinline__ void rope_tables(Frame& F, const PA& A) {
    float* cs = (float*)(A.ws + WS_ROPE); float* sn = cs + (size_t)M * 32;
    for (int e = (A.vcu * NWAVES * 64) + F.tid; e < M * 32; e += A.G * NWAVES * 64) { const int m = e >> 5, i = e & 31;
        const float inv = __builtin_amdgcn_exp2f(-(float)i * 0.41524101186092f); const float ang = (float)A.pos[m] * inv; float s, c; sincos_f(ang, s, c); cs[e] = c; sn[e] = s; }
}
__device__ __forceinline__ void x_in_rows(Frame& F, const PA& A, const float* x, bf16* xb, float* rs) {
    const int gw = A.vcu * NWAVES + F.wave, NGW = A.G * NWAVES;
    for (int m = gw; m < M; m += NGW) {
        const GAS f32x4* xr = (const GAS f32x4*)(x + (size_t)m * DM) + F.lane;
        f32x4 v[16]; float s = 0.f;
#pragma unroll
        for (int j = 0; j < 16; ++j) { v[j] = xr[64 * j]; s += (v[j].x * v[j].x + v[j].y * v[j].y) + (v[j].z * v[j].z + v[j].w * v[j].w); }
        const float rstd = 1.0f / sqrtf(wave_sum(s) * (1.f / DM) + RMS_EPS);
        GAS unsigned long long* o8 = (GAS unsigned long long*)(xb + (size_t)m * DM) + F.lane;
#pragma unroll
        for (int j = 0; j < 16; ++j) o8[64 * j] = (unsigned long long)pk2(v[j].x, v[j].y) | ((unsigned long long)pk2(v[j].z, v[j].w) << 32);
        if (F.lane == 0) rs[m] = rstd;
    }
}
__device__ __forceinline__ void resid_rows(Frame& F, const PA& A, bf16* xb, const bf16* mo, const float* ga, float* rs, float* out) {
    const int gw = A.vcu * NWAVES + F.wave, NGW = A.G * NWAVES;
    for (int m = gw; m < M; m += NGW) {
        const GAS v2u* mr = (const GAS v2u*)(mo + (size_t)m * DM) + F.lane; GAS v2u* xr = (GAS v2u*)(xb + (size_t)m * DM) + F.lane;
        const GAS f32x4* gar = (const GAS f32x4*)ga + F.lane;
        f32x4 v[16]; v2u xw[16]; float s = 0.f;
#pragma unroll
        for (int j = 0; j < 16; ++j) { const v2u w = mr[64 * j]; xw[j] = xr[64 * j]; v[j] = (f32x4){bfl(w.x), bfh(w.x), bfl(w.y), bfh(w.y)}; s += (v[j].x * v[j].x + v[j].y * v[j].y) + (v[j].z * v[j].z + v[j].w * v[j].w); }
        const float rstd = 1.0f / sqrtf(wave_sum(s) * (1.f / DM) + RMS_EPS);
        float s2 = 0.f;
#pragma unroll
        for (int j = 0; j < 16; ++j) { const f32x4 gg = gar[64 * j]; f32x4 o;
            o.x = bfl(xw[j].x) + v[j].x * rstd * gg.x; o.y = bfh(xw[j].x) + v[j].y * rstd * gg.y; o.z = bfl(xw[j].y) + v[j].z * rstd * gg.z; o.w = bfh(xw[j].y) + v[j].w * rstd * gg.w;
            v[j] = o; s2 += (o.x * o.x + o.y * o.y) + (o.z * o.z + o.w * o.w); }
        if (out) { GAS f32x4* oo = (GAS f32x4*)(out + (size_t)m * DM) + F.lane;
#pragma unroll
            for (int j = 0; j < 16; ++j) oo[64 * j] = v[j]; }
        else {
#pragma unroll
            for (int j = 0; j < 16; ++j) { v2u w; w.x = pk2(v[j].x, v[j].y); w.y = pk2(v[j].z, v[j].w); xr[64 * j] = w; }
            const float rstd2 = 1.0f / sqrtf(wave_sum(s2) * (1.f / DM) + RMS_EPS);
            if (F.lane == 0) rs[m] = rstd2; }
    }
}
__device__ __forceinline__ void mla_prep_rows(Frame& F, const PA& A, int l, const int gw, const int NGW) {
    const bf16* P = (const bf16*)(A.ws + WS_PB); const float* misc = (const float*)(A.ws + WS_MISC);
    bf16* CQN = (bf16*)(A.ws + WS_CQN); bf16* CKVN = (bf16*)(A.ws + WS_CKVN); bf16* KR = (bf16*)(A.ws + WS_KR); float* LF = (float*)(A.ws + WS_LF);
    const float* cs = (const float*)(A.ws + WS_ROPE); const float* sn = cs + (size_t)M * 32;
    const float* gq = A.g_q_lora + (size_t)l * 1024; const float* gkv = A.g_kv_lora + (size_t)l * 512; const float* bf = A.b_forget + (size_t)l * 8;
    for (int m = gw; m < M; m += NGW) {
        const bf16* pr = P + (size_t)m * NINP;
        {
            const v4u a = *(const GAS v4u*)(pr + PC_CQ + 8 * F.lane), b = *(const GAS v4u*)(pr + PC_CQ + 512 + 8 * F.lane);
            float v[16] = {bfl(a.x), bfh(a.x), bfl(a.y), bfh(a.y), bfl(a.z), bfh(a.z), bfl(a.w), bfh(a.w), bfl(b.x), bfh(b.x), bfl(b.y), bfh(b.y), bfl(b.z), bfh(b.z), bfl(b.w), bfh(b.w)};
            float s = 0.f;
#pragma unroll
            for (int j = 0; j < 16; ++j) s += v[j] * v[j];
            const float rstd = 1.0f / sqrtf(wave_sum(s) * (1.f / 1024.f) + RMS_EPS);
            const f32x4 g0 = *(const GAS f32x4*)(gq + 8 * F.lane), g1 = *(const GAS f32x4*)(gq + 8 * F.lane + 4), g2 = *(const GAS f32x4*)(gq + 512 + 8 * F.lane), g3 = *(const GAS f32x4*)(gq + 512 + 8 * F.lane + 4);
            v4u o0, o1;
            o0.x = pk2(v[0] * rstd * g0.x, v[1] * rstd * g0.y); o0.y = pk2(v[2] * rstd * g0.z, v[3] * rstd * g0.w); o0.z = pk2(v[4] * rstd * g1.x, v[5] * rstd * g1.y); o0.w = pk2(v[6] * rstd * g1.z, v[7] * rstd * g1.w);
            o1.x = pk2(v[8] * rstd * g2.x, v[9] * rstd * g2.y); o1.y = pk2(v[10] * rstd * g2.z, v[11] * rstd * g2.w); o1.z = pk2(v[12] * rstd * g3.x, v[13] * rstd * g3.y); o1.w = pk2(v[14] * rstd * g3.z, v[15] * rstd * g3.w);
            *(GAS v4u*)(CQN + (size_t)m * 1024 + 8 * F.lane) = o0; *(GAS v4u*)(CQN + (size_t)m * 1024 + 512 + 8 * F.lane) = o1;
        }
        {
            const v4u a = *(const GAS v4u*)(pr + PC_CKV + 8 * F.lane);
            float v[8] = {bfl(a.x), bfh(a.x), bfl(a.y), bfh(a.y), bfl(a.z), bfh(a.z), bfl(a.w), bfh(a.w)};
            float s = 0.f;
#pragma unroll
            for (int j = 0; j < 8; ++j) s += v[j] * v[j];
            const float rstd = 1.0f / sqrtf(wave_sum(s) * (1.f / 512.f) + RMS_EPS);
            const f32x4 g0 = *(const GAS f32x4*)(gkv + 8 * F.lane), g1 = *(const GAS f32x4*)(gkv + 8 * F.lane + 4);
            v4u o0;
            o0.x = pk2(v[0] * rstd * g0.x, v[1] * rstd * g0.y); o0.y = pk2(v[2] * rstd * g0.z, v[3] * rstd * g0.w); o0.z = pk2(v[4] * rstd * g1.x, v[5] * rstd * g1.y); o0.w = pk2(v[6] * rstd * g1.z, v[7] * rstd * g1.w);
            *(GAS v4u*)(CKVN + (size_t)m * 512 + 8 * F.lane) = o0;
        }
        const float* mr = misc + (size_t)m * 256;
        if (F.lane < 32) { const int i = F.lane; const float x1 = mr[i], x2 = mr[32 + i], c = cs[(size_t)m * 32 + i], s = sn[(size_t)m * 32 + i];
            *(GAS unsigned*)(KR + (size_t)m * 64 + 2 * i) = pk2(x1 * c - x2 * s, x2 * c + x1 * s); }
        else if (F.lane < 40) { const int h = F.lane - 32; const float z = mr[64 + h] + bf[h];
            LF[(size_t)m * 8 + h] = fminf(z, 0.f) - log1pf(expf(-fabsf(z))); }
    }
}
__device__ __forceinline__ void fox_scan(Frame& F, const PA& A, const int sw) {
    const int gw = sw * NWAVES + F.wave;
    const int b = gw >> 3, h = gw & 7;
    const float* LF = (const float*)(A.ws + WS_LF) + ((size_t)b * SEQ + 32 * F.lane) * 8 + h; float* FC = (float*)(A.ws + WS_FC) + ((size_t)b * SEQ + 32 * F.lane) * 8 + h;
    float v[32]; float run = 0.f;
#pragma unroll
    for (int j = 0; j < 32; ++j) { run += LF[j * 8]; v[j] = run; }
    float incl = run;
#pragma unroll
    for (int o = 1; o < 64; o <<= 1) { const float t = __shfl_up(incl, o); if (F.lane >= o) incl += t; }
    const float excl = incl - run;
#pragma unroll
    for (int j = 0; j < 32; ++j) FC[j * 8] = v[j] + excl;
}

template <int TYPE>
__device__ __forceinline__ void naive_attn_unit(const PA& A, int l, int m, int head, LAS float* qs, LAS float* sc, int lane) {
    constexpr int DK = TYPE == 0 ? 192 : 128;
    const int b = m / SEQ, t = m - b * SEQ;
    const bf16* P = (const bf16*)(A.ws + WS_PB);
    const float scale = TYPE == 0 ? 0.07216878364870323f : 0.08838834764831845f;
    if (TYPE == 0) { const bf16* qn = (const bf16*)(A.ws + WS_QN) + (size_t)m * 1024 + 128 * head; const bf16* qr = (const bf16*)(A.ws + WS_QR) + (size_t)m * 512 + 64 * head;
        qs[lane] = bfl((unsigned)qn[lane]) * scale; qs[64 + lane] = bfl((unsigned)qn[64 + lane]) * scale; qs[128 + lane] = bfl((unsigned)qr[lane]) * scale; }
    else { const bf16* q = P + (size_t)m * NINP + (TYPE == 1 ? PC_QSWA : PC_QFOX) + 128 * head; qs[lane] = bfl((unsigned)q[lane]) * scale; qs[64 + lane] = bfl((unsigned)q[64 + lane]) * scale; }
    LDS_WAIT(); asm volatile("" ::: "memory");
    const int s_lo = TYPE == 1 ? (t >= 127 ? t - 127 : 0) : 0;
    const int nk = t - s_lo + 1;
    const float slope = TYPE == 1 ? exp2f(-8.0f * (float)(head + 1) / 16.0f) : 0.f;
    const float sink = TYPE == 1 ? A.swa_sinks[l * 16 + head] : 0.f;
    const float* FC = (const float*)(A.ws + WS_FC);
    float mx = -3.0e38f;
    for (int i = lane; i < nk; i += 64) {
        const int s = s_lo + i; const size_t row = (size_t)b * SEQ + s;
        float dot = 0.f;
        if (TYPE == 0) {
            const bf16* kn = (const bf16*)(A.ws + WS_KN) + row * 1024 + 128 * head; const bf16* kr = (const bf16*)(A.ws + WS_KR) + row * 64;
            for (int d = 0; d < 128; d += 8) { const v4u w = *(const GAS v4u*)(kn + d); const LAS float* q = qs + d;
                dot += q[0] * bfl(w.x) + q[1] * bfh(w.x) + q[2] * bfl(w.y) + q[3] * bfh(w.y) + q[4] * bfl(w.z) + q[5] * bfh(w.z) + q[6] * bfl(w.w) + q[7] * bfh(w.w); }
            for (int d = 0; d < 64; d += 8) { const v4u w = *(const GAS v4u*)(kr + d); const LAS float* q = qs + 128 + d;
                dot += q[0] * bfl(w.x) + q[1] * bfh(w.x) + q[2] * bfl(w.y) + q[3] * bfh(w.y) + q[4] * bfl(w.z) + q[5] * bfh(w.z) + q[6] * bfl(w.w) + q[7] * bfh(w.w); }
        } else {
            const bf16* k = P + row * NINP + (TYPE == 1 ? PC_KSWA + 128 * (head >> 3) : PC_KFOX + 128 * head);
            for (int d = 0; d < 128; d += 8) { const v4u w = *(const GAS v4u*)(k + d); const LAS float* q = qs + d;
                dot += q[0] * bfl(w.x) + q[1] * bfh(w.x) + q[2] * bfl(w.y) + q[3] * bfh(w.y) + q[4] * bfl(w.z) + q[5] * bfh(w.z) + q[6] * bfl(w.w) + q[7] * bfh(w.w); }
            if (TYPE == 1) dot -= slope * (float)(A.pos[m] - A.pos[row]);
            if (TYPE == 2) dot += FC[(size_t)m * 8 + head] - FC[row * 8 + head];
        }
        sc[i] = dot; mx = fmaxf(mx, dot);
    }
    mx = wave_max(mx); if (TYPE == 1) mx = fmaxf(mx, sink);
    float sum = 0.f;
    for (int i = lane; i < nk; i += 64) { const float e = __expf(sc[i] - mx); sc[i] = e; sum += e; }
    sum = wave_sum(sum); if (TYPE == 1) sum += __expf(sink - mx);
    LDS_WAIT(); asm volatile("" ::: "memory");
    const bf16* vbase; int ldv;
    if (TYPE == 0) { vbase = (const bf16*)(A.ws + WS_VM) + 128 * head; ldv = 1024; } else if (TYPE == 1) { vbase = P + PC_VSWA + 128 * (head >> 3); ldv = NINP; } else { vbase = P + PC_VFOX + 128 * head; ldv = NINP; }
    vbase += ((size_t)b * SEQ + s_lo) * ldv + 2 * lane;
    float o0 = 0.f, o1 = 0.f;
    int i = 0;
    for (; i + 4 <= nk; i += 4) {
        const unsigned w0 = *(const GAS unsigned*)(vbase + (size_t)(i + 0) * ldv), w1 = *(const GAS unsigned*)(vbase + (size_t)(i + 1) * ldv), w2 = *(const GAS unsigned*)(vbase + (size_t)(i + 2) * ldv), w3 = *(const GAS unsigned*)(vbase + (size_t)(i + 3) * ldv);
        const float p0 = sc[i], p1 = sc[i + 1], p2 = sc[i + 2], p3 = sc[i + 3];
        o0 += p0 * bfl(w0) + p1 * bfl(w1) + p2 * bfl(w2) + p3 * bfl(w3); o1 += p0 * bfh(w0) + p1 * bfh(w1) + p2 * bfh(w2) + p3 * bfh(w3);
    }
    for (; i < nk; ++i) { const unsigned w0 = *(const GAS unsigned*)(vbase + (size_t)i * ldv); const float p0 = sc[i]; o0 += p0 * bfl(w0); o1 += p0 * bfh(w0); }
    const float inv = 1.0f / sum;
    bf16* op = (bf16*)(A.ws + WS_OM) + (size_t)m * DM + (TYPE == 0 ? 0 : TYPE == 1 ? 1024 : 3072) + 128 * head;
    *(GAS unsigned*)(op + 2 * lane) = pk2(o0 * inv, o1 * inv);
    LDS_WAIT(); asm volatile("" ::: "memory");
}
__device__ __forceinline__ void naive_attn_phase(Frame& F, const PA& A, int l) {
    LAS float* qs = (LAS float*)(F.lds + RING_OFF + F.wave * 9216); LAS float* sc = qs + 256;
    const int gw = A.vcu * NWAVES + F.wave, NGW = A.G * NWAVES;
    for (int u = gw; u < M * 32; u += NGW) {
        const int head = (u + (u >> 11)) & 31, m = u >> 5;
        if (head < 8) { if (!(ATT_MFMA_TYPES & 1)) naive_attn_unit<0>(A, l, m, head, qs, sc, F.lane); }
        else if (head < 24) { if (!(ATT_MFMA_TYPES & 2)) naive_attn_unit<1>(A, l, m, head - 8, qs, sc, F.lane); }
        else { if (!(ATT_MFMA_TYPES & 4)) naive_attn_unit<2>(A, l, m, head - 24, qs, sc, F.lane); }
    }
}


namespace att {
typedef short bf16x8 __attribute__((ext_vector_type(8)));
typedef short s16x4 __attribute__((ext_vector_type(4)));
typedef float f32x16 __attribute__((ext_vector_type(16)));
typedef unsigned u32x4 __attribute__((ext_vector_type(4)));
constexpr int KVBLK = 64, QBLK = 32, SHM_V = 16384, SHM_K = 16384, SHM_KR = 8192;
constexpr int L_V = 0, L_K = 2 * SHM_V, L_KR = L_K + 2 * SHM_K, L_KB = L_KR + 2 * SHM_KR, L_WS = L_KB + 2 * 256, L_END = L_WS + 8 * 256;
static_assert(L_END <= RING_BYTES, "attention LDS fits the ring region");
#define ATT_KSWZ(row, colB) ((row) * 256 + ((colB) ^ (((row) & 15) << 4)))
#define ATT_KRSWZ(row, colB) ((row) * 128 + ((colB) ^ ((((row) >> 1) & 7) << 4)))
#define ATT_SBAR() __builtin_amdgcn_sched_barrier(0)
__device__ __forceinline__ int v_st(int k, int c) { const int kk = (k & ~0xC) | ((k & 4) << 1) | ((k & 8) >> 1); return ((kk >> 3) * 4 + (c >> 5)) * 512 + ((kk & 7) * 32 + (c & 31)) * 2; }
__device__ __forceinline__ int v_rd_base(int lane) { return ((lane & 3) << 3) | (((lane >> 2) & 3) << 6) | (((lane >> 4) & 1) << 5) | (((lane >> 5) & 1) << 8); }
__device__ __forceinline__ int crow(int r, int hi) { return (r & 3) + 8 * (r >> 2) + 4 * hi; }
__device__ __forceinline__ unsigned cvtpk(float lo, float hi) { unsigned r; asm volatile("v_cvt_pk_bf16_f32 %0, %1, %2" : "=v"(r) : "v"(lo), "v"(hi)); return r; }
__device__ __forceinline__ void mask_tile(f32x16& p0, f32x16& p1, int dq, unsigned W) {
    const float NEG = -__builtin_inff();
#pragma unroll
    for (int r = 0; r < 16; ++r) { const int c = (r & 3) + 8 * (r >> 2);
        if ((unsigned)(dq - c) >= W) p0[r] = NEG;
        if ((unsigned)(dq - c - 32) >= W) p1[r] = NEG; }
}
template <int SC>
__device__ __forceinline__ float softmax_tile(f32x16& p0, f32x16& p1, float& m_reg, float& l_reg, bf16x8& pa0, bf16x8& pa1, bf16x8& pa2, bf16x8& pa3) {
    constexpr float SCALE = SC == 0 ? 0.07216878364870323f : 0.08838834764831845f, C2 = 1.4426950408889634f * SCALE, THR = 8.f;
    float pmax = p0[0];
#pragma unroll
    for (int r = 1; r < 16; ++r) pmax = fmaxf(pmax, p0[r]);
#pragma unroll
    for (int r = 0; r < 16; ++r) pmax = fmaxf(pmax, p1[r]);
    { auto rr = __builtin_amdgcn_permlane32_swap(__float_as_uint(pmax), __float_as_uint(pmax), false, false);
      pmax = fmaxf(__uint_as_float(rr[0]), __uint_as_float(rr[1])); }
    float mn, alpha;
    if (__builtin_expect(__all((pmax - m_reg) * SCALE <= THR), 1)) { mn = m_reg; alpha = 1.f; }
    else { mn = fmaxf(m_reg, pmax); alpha = __builtin_amdgcn_exp2f((m_reg - mn) * C2); m_reg = mn; }
    const float mnL = -mn * C2;
#pragma unroll
    for (int r = 0; r < 16; ++r) { p0[r] = __builtin_amdgcn_exp2f(fmaf(p0[r], C2, mnL)); p1[r] = __builtin_amdgcn_exp2f(fmaf(p1[r], C2, mnL)); }
    float ps = 0.f;
#pragma unroll
    for (int r = 0; r < 16; ++r) ps += p0[r] + p1[r];
    { auto rr = __builtin_amdgcn_permlane32_swap(__float_as_uint(ps), __float_as_uint(ps), false, false);
      ps = __uint_as_float(rr[0]) + __uint_as_float(rr[1]); }
    l_reg = l_reg * alpha + ps;
#define ATT_PK4(P, B_, OUT) do { unsigned a0 = cvtpk(P[B_+0], P[B_+1]), a1 = cvtpk(P[B_+2], P[B_+3]);                          \
        unsigned b0 = cvtpk(P[B_+4], P[B_+5]), b1 = cvtpk(P[B_+6], P[B_+7]);                                             \
        auto r0 = __builtin_amdgcn_permlane32_swap(a0, b0, false, false); auto r1 = __builtin_amdgcn_permlane32_swap(a1, b1, false, false); \
        u32x4 w = {r0[0], r1[0], r0[1], r1[1]}; OUT = __builtin_bit_cast(bf16x8, w); } while (0)
    ATT_PK4(p0, 0, pa0); ATT_PK4(p0, 8, pa1); ATT_PK4(p1, 0, pa2); ATT_PK4(p1, 8, pa3);
#undef ATT_PK4
    return alpha;
}
template <bool ROPE, bool BIAS>
__device__ __forceinline__ void qkt(f32x16& p0, f32x16& p1, LAS const char* lds, int buf, int r32, int hi, const bf16x8* qr, const bf16x8* qrr, float kbmul) {
    if (BIAS) { LAS const float* kb = (LAS const float*)(lds + L_KB + buf * 256) + 4 * hi;
#pragma unroll
        for (int g = 0; g < 4; ++g) { const f32x4 a = *(LAS const f32x4*)(kb + 8 * g) * kbmul, b = *(LAS const f32x4*)(kb + 32 + 8 * g) * kbmul;
            p0[4 * g] = a[0]; p0[4 * g + 1] = a[1]; p0[4 * g + 2] = a[2]; p0[4 * g + 3] = a[3]; p1[4 * g] = b[0]; p1[4 * g + 1] = b[1]; p1[4 * g + 2] = b[2]; p1[4 * g + 3] = b[3]; } }
    else { p0 = f32x16{}; p1 = f32x16{}; }
    LAS const char* kbase = lds + L_K + buf * SHM_K;
#pragma unroll
    for (int d0 = 0; d0 < 8; ++d0) { LAS const char* a = kbase + ATT_KSWZ(r32, (d0 * 16 + hi * 8) * 2);
        const bf16x8 b0 = *(LAS const bf16x8*)a, b1 = *(LAS const bf16x8*)(a + 32 * 256);
        p0 = __builtin_amdgcn_mfma_f32_32x32x16_bf16(b0, qr[d0], p0, 0, 0, 0);
        p1 = __builtin_amdgcn_mfma_f32_32x32x16_bf16(b1, qr[d0], p1, 0, 0, 0); }
    if (ROPE) { LAS const char* rbase = lds + L_KR + buf * SHM_KR;
#pragma unroll
        for (int d0 = 0; d0 < 4; ++d0) { LAS const char* a = rbase + ATT_KRSWZ(r32, (d0 * 16 + hi * 8) * 2);
            const bf16x8 b0 = *(LAS const bf16x8*)a, b1 = *(LAS const bf16x8*)(a + 32 * 128);
            p0 = __builtin_amdgcn_mfma_f32_32x32x16_bf16(b0, qrr[d0], p0, 0, 0, 0);
            p1 = __builtin_amdgcn_mfma_f32_32x32x16_bf16(b1, qrr[d0], p1, 0, 0, 0); } }
}
__device__ __forceinline__ void pv_tile(f32x16* o, int vb, bf16x8 pa0, bf16x8 pa1, bf16x8 pa2, bf16x8 pa3) {
#define ATT_TRRD(dst, off) asm volatile("ds_read_b64_tr_b16 %0, %1 offset:%2" : "=&v"(dst) : "v"(vb), "i"(off) : "memory")
#define ATT_PV_D0(d0) do { s16x4 l0, l1, l2, l3, h0, h1, h2, h3; constexpr int b_ = (d0) * 512;   \
        ATT_TRRD(l0, b_); ATT_TRRD(h0, b_ + 2048); ATT_TRRD(l1, b_ + 4096); ATT_TRRD(h1, b_ + 6144); ATT_TRRD(l2, b_ + 8192); ATT_TRRD(h2, b_ + 10240); ATT_TRRD(l3, b_ + 12288); ATT_TRRD(h3, b_ + 14336); \
        asm volatile("s_waitcnt lgkmcnt(0)" ::: "memory"); ATT_SBAR();   \
        o[d0] = __builtin_amdgcn_mfma_f32_32x32x16_bf16((bf16x8){l0[0], l0[1], l0[2], l0[3], h0[0], h0[1], h0[2], h0[3]}, pa0, o[d0], 0, 0, 0);   \
        o[d0] = __builtin_amdgcn_mfma_f32_32x32x16_bf16((bf16x8){l1[0], l1[1], l1[2], l1[3], h1[0], h1[1], h1[2], h1[3]}, pa1, o[d0], 0, 0, 0);   \
        o[d0] = __builtin_amdgcn_mfma_f32_32x32x16_bf16((bf16x8){l2[0], l2[1], l2[2], l2[3], h2[0], h2[1], h2[2], h2[3]}, pa2, o[d0], 0, 0, 0);   \
        o[d0] = __builtin_amdgcn_mfma_f32_32x32x16_bf16((bf16x8){l3[0], l3[1], l3[2], l3[3], h3[0], h3[1], h3[2], h3[3]}, pa3, o[d0], 0, 0, 0); } while (0)
    ATT_PV_D0(0); ATT_PV_D0(1); ATT_PV_D0(2); ATT_PV_D0(3);
#undef ATT_PV_D0
#undef ATT_TRRD
}
template <int TYPE>
__device__ __forceinline__ void attn_unit(LAS char* lds, int tid, const bf16* Qw, int ldq, const bf16* QRw, const bf16* Kh, int ldk, const bf16* KRb, const bf16* Vh, int ldv, bf16* Ow, int ldo,
                                          int qlo, int j_lo, int j_hi, int W, const void* kbp, float kbscale, float kbref_f, int kbref_i, float sink_raw) {
    constexpr bool ROPE = TYPE == 0, BIAS = TYPE != 0; constexpr int SC = TYPE == 0 ? 0 : 1;
    constexpr float SCALE = SC == 0 ? 0.07216878364870323f : 0.08838834764831845f, C2 = 1.4426950408889634f * SCALE;
    const int wid = __builtin_amdgcn_readfirstlane(tid >> 6), lane = tid & 63, r32 = lane & 31, hi = lane >> 5;
    const int NT = j_hi - j_lo;
    bf16x8 qr[8], qrr[4];
#pragma unroll
    for (int d0 = 0; d0 < 8; ++d0) qr[d0] = *(const GAS bf16x8*)(Qw + (size_t)r32 * ldq + d0 * 16 + hi * 8);
    if (ROPE) {
#pragma unroll
        for (int d0 = 0; d0 < 4; ++d0) qrr[d0] = *(const GAS bf16x8*)(QRw + (size_t)r32 * 512 + d0 * 16 + hi * 8); }
    const int sr = tid >> 4, sc = (tid & 15) * 8, kws = ATT_KSWZ(sr, sc * 2), vst0 = v_st(sr, sc), vst1 = v_st(32 + sr, sc);
    const int rr_ = tid >> 3, rc_ = (tid & 7) * 8, krws = ATT_KRSWZ(rr_, rc_ * 2);
    bf16x8 st_k0, st_k1, st_v0, st_v1, st_kr; float st_kb = 0.f;
#define ATT_LOADT(j) do { const int k0_ = (j) * KVBLK;                                                                                                  \
        st_k0 = *(const GAS bf16x8*)(Kh + (size_t)(k0_ + sr) * ldk + sc); st_k1 = *(const GAS bf16x8*)(Kh + (size_t)(k0_ + 32 + sr) * ldk + sc);          \
        st_v0 = *(const GAS bf16x8*)(Vh + (size_t)(k0_ + sr) * ldv + sc); st_v1 = *(const GAS bf16x8*)(Vh + (size_t)(k0_ + 32 + sr) * ldv + sc);          \
        if (ROPE) st_kr = *(const GAS bf16x8*)(KRb + (size_t)(k0_ + rr_) * 64 + rc_);                                                                     \
        if (BIAS) { if (tid < 64) { if (TYPE == 2) st_kb = kbref_f - ((const GAS float*)kbp)[(size_t)(k0_ + tid) * 8];                                    \
                                    else st_kb = (float)(((const GAS int*)kbp)[k0_ + tid] - kbref_i); } } } while (0)
#define ATT_WRITET(bf) do { *(LAS bf16x8*)(lds + L_K + (bf) * SHM_K + kws) = st_k0; *(LAS bf16x8*)(lds + L_K + (bf) * SHM_K + kws + 32 * 256) = st_k1;     \
        *(LAS bf16x8*)(lds + L_V + (bf) * SHM_V + vst0) = st_v0; *(LAS bf16x8*)(lds + L_V + (bf) * SHM_V + vst1) = st_v1;                                  \
        if (ROPE) *(LAS bf16x8*)(lds + L_KR + (bf) * SHM_KR + krws) = st_kr;                                                                              \
        if (BIAS) { if (tid < 64) *(LAS float*)(lds + L_KB + (bf) * 256 + tid * 4) = st_kb; } } while (0)
    float m_reg = -1e30f, l_reg = 0.f; f32x16 o[4] = {};
    const int vb0 = (int)(unsigned)(size_t)(lds + L_V) + v_rd_base(lane);
    const int qm = qlo + r32 - 4 * hi;
    ATT_LOADT(j_lo); asm volatile("s_waitcnt vmcnt(0)" ::: "memory"); ATT_WRITET(0);
    __syncthreads();
    for (int t = 0; t < NT; ++t) {
        const int bsel = t & 1, kb_ = (j_lo + t) * KVBLK;
        if (t + 1 < NT) { ATT_LOADT(j_lo + t + 1); }
        ATT_SBAR();
        const bool act = kb_ <= qlo + QBLK - 1 && kb_ + KVBLK - 1 >= qlo - W + 1;
        if (act) {
            f32x16 p0, p1; bf16x8 pa0, pa1, pa2, pa3;
            qkt<ROPE, BIAS>(p0, p1, lds, bsel, r32, hi, qr, qrr, kbscale);
            if (kb_ + KVBLK - 1 > qlo || kb_ <= qlo + QBLK - 1 - W) mask_tile(p0, p1, qm - kb_, (unsigned)W);
            const float alpha = softmax_tile<SC>(p0, p1, m_reg, l_reg, pa0, pa1, pa2, pa3);
            if (__any(alpha < 1.f)) {
#pragma unroll
                for (int d_ = 0; d_ < 4; ++d_)
#pragma unroll
                    for (int r = 0; r < 16; ++r) o[d_][r] *= alpha; }
            pv_tile(o, vb0 + bsel * SHM_V, pa0, pa1, pa2, pa3);
        }
        ATT_SBAR();
        if (t + 1 < NT) { asm volatile("s_waitcnt vmcnt(0)" ::: "memory"); ATT_WRITET(bsel ^ 1); }
        __syncthreads();
    }
    if (TYPE == 1) l_reg += __builtin_amdgcn_exp2f((sink_raw - m_reg) * C2);
    const float rl = __builtin_amdgcn_rcpf(l_reg);
    bf16* orow = Ow + (size_t)r32 * ldo + 8 * hi;
#pragma unroll
    for (int d0 = 0; d0 < 4; ++d0)
#pragma unroll
        for (int gp = 0; gp < 2; ++gp) { const int ra = 8 * gp, rb = 8 * gp + 4;
            const unsigned a0 = cvtpk(o[d0][ra] * rl, o[d0][ra + 1] * rl), a1 = cvtpk(o[d0][ra + 2] * rl, o[d0][ra + 3] * rl), b0 = cvtpk(o[d0][rb] * rl, o[d0][rb + 1] * rl), b1 = cvtpk(o[d0][rb + 2] * rl, o[d0][rb + 3] * rl);
            auto r0 = __builtin_amdgcn_permlane32_swap(a0, b0, false, false); auto r1 = __builtin_amdgcn_permlane32_swap(a1, b1, false, false);
            const u32x4 w = {r0[0], r1[0], r0[1], r1[1]};
            *(GAS u32x4*)(orow + d0 * 32 + 16 * gp) = w; }
#undef ATT_LOADT
#undef ATT_WRITET
}
}

template <int ST>
__device__ __forceinline__ void attn_stage(Frame& F, const PA& A, int l) {
    LAS char* lds = (LAS char*)(F.lds + RING_OFF);
    const bf16* P = (const bf16*)(A.ws + WS_PB);
    const int wid = F.wave;
    if constexpr (ST == 0 && (ATT_MFMA_TYPES & 1) != 0)
    for (int item = A.vcu; item < NBATCH * 8 * 4; item += A.G) {
        const int b = item >> 5, h = (item >> 2) & 7, pr = item & 3;
#pragma unroll 1
        for (int pass = 0; pass < 2; ++pass) { const int qb = pass ? 7 - pr : pr; const size_t row0 = (size_t)b * SEQ + qb * 256 + wid * 32;
            att::attn_unit<0>(lds, F.tid, (const bf16*)(A.ws + WS_QN) + row0 * 1024 + 128 * h, 1024, (const bf16*)(A.ws + WS_QR) + row0 * 512 + 64 * h,
                              (const bf16*)(A.ws + WS_KN) + (size_t)b * SEQ * 1024 + 128 * h, 1024, (const bf16*)(A.ws + WS_KR) + (size_t)b * SEQ * 64,
                              (const bf16*)(A.ws + WS_VM) + (size_t)b * SEQ * 1024 + 128 * h, 1024, (bf16*)(A.ws + WS_OM) + row0 * DM + 128 * h, DM,
                              qb * 256 + wid * 32, 0, 4 * (qb + 1), SEQ, nullptr, 0.f, 0.f, 0, 0.f); }
    }
    if constexpr (ST == 1 && (ATT_MFMA_TYPES & 4) != 0)
    for (int item = A.vcu; item < NBATCH * 8 * 4; item += A.G) {
        const int b = item >> 5, h = (item >> 2) & 7, pr = item & 3;
        const float* FCb = (const float*)(A.ws + WS_FC) + (size_t)b * SEQ * 8 + h;
#pragma unroll 1
        for (int pass = 0; pass < 2; ++pass) { const int qb = pass ? 7 - pr : pr; const size_t row0 = (size_t)b * SEQ + qb * 256 + wid * 32;
            const float fref = FCb[(size_t)(qb * 256) * 8];
            att::attn_unit<2>(lds, F.tid, P + row0 * NINP + PC_QFOX + 128 * h, NINP, nullptr,
                              P + (size_t)b * SEQ * NINP + PC_KFOX + 128 * h, NINP, nullptr,
                              P + (size_t)b * SEQ * NINP + PC_VFOX + 128 * h, NINP, (bf16*)(A.ws + WS_OM) + row0 * DM + 3072 + 128 * h, DM,
                              qb * 256 + wid * 32, 0, 4 * (qb + 1), SEQ, FCb, 11.313708498984761f, fref, 0, 0.f); }
    }
    if constexpr (ST == 2 && (ATT_MFMA_TYPES & 2) != 0)
    for (int u = A.vcu * 4; u < NBATCH * 2 * 64; u += A.G * 4) {
#pragma unroll 1
        for (int i = 0; i < 4; ++i) { const int uu = u + i, b = uu >> 7, kvh = (uu >> 6) & 1, blk = uu & 63, t0 = blk * 32, hq = kvh * 8 + wid;
            const size_t row0 = (size_t)b * SEQ + t0; const int* posb = A.pos + (size_t)b * SEQ;
            const float slope = exp2f(-0.5f * (float)(hq + 1)); const int pref = posb[t0];
            const int klo = t0 >= 127 ? t0 - 127 : 0;
            const float sink_raw = (A.swa_sinks[l * 16 + hq] + slope * (float)(posb[t0 + (F.lane & 31)] - pref)) * 11.313708498984761f;
            att::attn_unit<1>(lds, F.tid, P + row0 * NINP + PC_QSWA + 128 * hq, NINP, nullptr,
                              P + (size_t)b * SEQ * NINP + PC_KSWA + 128 * kvh, NINP, nullptr,
                              P + (size_t)b * SEQ * NINP + PC_VSWA + 128 * kvh, NINP, (bf16*)(A.ws + WS_OM) + row0 * DM + 1024 + 128 * hq, DM,
                              t0, klo >> 6, ((t0 + 31) >> 6) + 1, 128, posb, slope * 11.313708498984761f, 0.f, pref, sink_raw); }
    }
}
__device__ __forceinline__ void load_rs_table(Frame& F, const PA& A) {
    static_assert(M / 256 == 64, "row-panel ownership of StaticOrder");
    LAS float* rsl = (LAS float*)(F.lds + RS_OFF); const float* rsg = (const float*)(A.ws + WS_RS) + 2048 * (A.bx & 7);
    for (int i = F.tid; i < 2048; i += NWAVES * 64) rsl[i] = rsg[i];
    __syncthreads();
}
constexpr int PH_PER_LAYER = 10, N_PHASES = 1 + DEPTH * PH_PER_LAYER;
#ifndef PHMASK
#define PHMASK 0x7ff
#endif
__device__ __forceinline__ Frame make_frame(LAS unsigned char* lds) {
    Frame F; F.lds = lds; int t = threadIdx.x; asm volatile("" : "+v"(t)); F.tid = t; F.lane = t & 63; F.wave = __builtin_amdgcn_readfirstlane(t >> 6); return F;
}
#define IN(k) (((PHMASK >> ((k) == 0 ? 10 : ((k) - 1) % PH_PER_LAYER)) & 1) && lo <= (k) && (k) < hi)
#define SEAM(k) do { if (IN(k) && IN((k) + 1)) { if (!MK_PER_PHASE) xcd_barrier(bar); } } while (0)
#define WSP(T, off) ((T)(A.ws + (off)))
#define PHASE_BEGIN const PA A = load_args(argw); Frame F = make_frame(ldsb)
template <int l>
__device__ __forceinline__ void layer_phases(LAS unsigned char* ldsb, const LAS unsigned* argw, const XcdBarrier& bar, const int lo, const int hi) {
        constexpr int pb = 1 + l * PH_PER_LAYER;
        if (IN(pb + 0)) {
            PHASE_BEGIN; unsigned char* wl = A.ws + WS_W + (size_t)l * WL_SIZE; load_rs_table(F, A);
            pg8::Gemm g{WSP(const bf16*, WS_HB), (const bf16*)(wl + WL_WIN), M, NIN, DM}; pg8::StaticOrder S; S.init(M, NIN, A.G, A.bx);
            pg8::EpiInproj E{WSP(bf16*, WS_PB), WSP(float*, WS_MISC), NINP, GATE_TILE0, WSP(bf16*, WS_GT), (const LAS float*)(F.lds + RS_OFF), (int)((size_t)3 * M * DM * 2)};
            if constexpr (l == 0 && CONV_IN_GEMM) {
                const int rc = 1 + (A.vcu % 18);
                { pg8::RangeOrder R{S, 0, rc}; pg8::gemm_phase<pg8::EpiInproj, pg8::RangeOrder, true, true>(F.lds + RING_OFF, g, R, E); }
                __syncthreads();
                { const PA A2 = load_args(argw); Frame F2 = make_frame(ldsb); convert_items(F2, A2, 1); }
                __syncthreads();
                { pg8::RangeOrder R{S, rc, 1 << 30}; pg8::gemm_phase<pg8::EpiInproj, pg8::RangeOrder, true, true>(F.lds + RING_OFF, g, R, E); }
            } else {
                pg8::RangeOrder R{S, 0, S.nwg / A.G}; pg8::gemm_phase<pg8::EpiInproj, pg8::RangeOrder, true, true>(F.lds + RING_OFF, g, R, E); }
        }
#if PROBE_REPEAT & 4
        if (IN(pb + 0)) {
            __syncthreads(); PHASE_BEGIN; unsigned char* wl = A.ws + WS_W + (size_t)l * WL_SIZE; load_rs_table(F, A);
            pg8::Gemm g{WSP(const bf16*, WS_HB), (const bf16*)(wl + WL_WIN), M, NIN, DM}; pg8::StaticOrder S; S.init(M, NIN, A.G, A.bx);
            pg8::EpiInproj E{WSP(bf16*, WS_PB), WSP(float*, WS_MISC), NINP, GATE_TILE0, WSP(bf16*, WS_GT), (const LAS float*)(F.lds + RS_OFF), (int)((size_t)3 * M * DM * 2)};
            pg8::gemm_phase<pg8::EpiInproj, pg8::StaticOrder, true, true>(F.lds + RING_OFF, g, S, E);
        }
#endif
        SEAM(pb + 0);
        if (IN(pb + 1)) { PHASE_BEGIN; mla_prep_rows(F, A, l, A.vcu * NWAVES + F.wave, A.G * NWAVES); }
        SEAM(pb + 1);
        if (IN(pb + 2)) {
            int left; { PHASE_BEGIN; pg8::StaticOrder S; S.init(M, NIN, A.G, A.bx); left = CONV_IN_GEMM ? 0 : S.nwg % A.G; }
            static_assert(((M / 256) * (NIN / 256) / 256 * 256 / 8) / 8 >= GATE_TILE0, "the deferred units (grid of 256) must be gate tiles: nothing before L.4 reads them");
            bool mine; { PHASE_BEGIN; mine = A.bx < left; }
            if (mine) {
                PHASE_BEGIN; unsigned char* wl = A.ws + WS_W + (size_t)l * WL_SIZE; load_rs_table(F, A);
                pg8::Gemm g{WSP(const bf16*, WS_HB), (const bf16*)(wl + WL_WIN), M, NIN, DM}; pg8::StaticOrder S; S.init(M, NIN, A.G, A.bx);
                pg8::EpiInproj E{WSP(bf16*, WS_PB), WSP(float*, WS_MISC), NINP, GATE_TILE0, WSP(bf16*, WS_GT), (const LAS float*)(F.lds + RS_OFF), (int)((size_t)3 * M * DM * 2)};
                pg8::RangeOrder R{S, S.nwg / A.G, 1 << 30}; pg8::gemm_phase<pg8::EpiInproj, pg8::RangeOrder, true, true>(F.lds + RING_OFF, g, R, E);
            } else {
                { PHASE_BEGIN; const int nn = A.G - left, c = A.bx - left; for (int sw = c - (nn > NBATCH ? nn - NBATCH : 0); sw < NBATCH; sw += nn) if (sw >= 0) fox_scan(F, A, sw); }
                { PHASE_BEGIN; unsigned char* wl = A.ws + WS_W + (size_t)l * WL_SIZE;
                  pg8::Gemm g{WSP(const bf16*, WS_CQN), (const bf16*)(wl + WL_WUQ), M, 1536, 1024}; pg8::StaticOrder S; S.init(M, 1536, A.G - left, A.bx - left);
                  pg8::EpiQup E{WSP(bf16*, WS_QN), WSP(bf16*, WS_QR), WSP(const float*, WS_ROPE), WSP(const float*, WS_ROPE) + (size_t)M * 32};
                  pg8::gemm_phase<pg8::EpiQup, pg8::StaticOrder, true, true>(F.lds + RING_OFF, g, S, E); }
                __syncthreads();
                { PHASE_BEGIN; unsigned char* wl = A.ws + WS_W + (size_t)l * WL_SIZE;
                  pg8::Gemm g{WSP(const bf16*, WS_CKVN), (const bf16*)(wl + WL_WUKV), M, 2048, 512}; pg8::StaticOrder S; S.init(M, 2048, A.G - left, A.bx - left);
                  pg8::EpiSplitBf16 E{WSP(bf16*, WS_KN), WSP(bf16*, WS_VM), 4, 1024};
                  pg8::gemm_phase<pg8::EpiSplitBf16, pg8::StaticOrder, true, true>(F.lds + RING_OFF, g, S, E); }
            }
        }
        SEAM(pb + 2);
        if (IN(pb + 3)) {
            if (ATT_MFMA_TYPES != 0) {
                constexpr int cvl = l == 0 ? cv::O_B : cv::I_LAYER + cv::O_B, cvh = l == 0 ? cv::I_LAYER + cv::O_B : DEPTH * cv::I_LAYER;
#define CONV_SLOT(k) if (CONV_UNDER_ATTN && !CONV_IN_GEMM) { PHASE_BEGIN; if (((A.bx >> 3) & 3) == (k)) { __syncthreads(); convert_span(F, A, cvl, cvh, A.vcu * NWAVES + F.wave, A.G * NWAVES); __syncthreads(); } }
                CONV_SLOT(0) { PHASE_BEGIN; attn_stage<0>(F, A, l); }
                CONV_SLOT(1) { PHASE_BEGIN; attn_stage<1>(F, A, l); }
                CONV_SLOT(2) { PHASE_BEGIN; attn_stage<2>(F, A, l); }
                CONV_SLOT(3)
#undef CONV_SLOT
            }
#if PROBE_REPEAT & 1
            { __syncthreads(); { PHASE_BEGIN; attn_stage<0>(F, A, l); } { PHASE_BEGIN; attn_stage<1>(F, A, l); } { PHASE_BEGIN; attn_stage<2>(F, A, l); } }
#endif
            if (ATT_MFMA_TYPES != 7) { __syncthreads(); PHASE_BEGIN; naive_attn_phase(F, A, l); }
        }
        SEAM(pb + 3);
        if (IN(pb + 4)) {
            PHASE_BEGIN; const bf16* WB = (const bf16*)(A.ws + WS_W + (size_t)l * WL_SIZE + WL_WB);
            pg8::Gemm g{WSP(const bf16*, WS_OM), WB, M, DM, DM}; pg8::StaticOrder S; S.init(M, DM, A.G, A.bx);
            pg8::EpiBranchFused E{WSP(const bf16*, WS_GT), WSP(bf16*, WS_MRG), DM};
            pg8::gemm_phase<pg8::EpiBranchFused, pg8::StaticOrder, true, true>(F.lds + RING_OFF, g, S, E);
        }
#if PROBE_REPEAT & 128
        __syncthreads();
        if (IN(pb + 4)) {
            PHASE_BEGIN; const bf16* WB = (const bf16*)(A.ws + WS_W + (size_t)l * WL_SIZE + WL_WB);
            pg8::Gemm g{WSP(const bf16*, WS_OM), WB, M, DM, DM}; pg8::StaticOrder S; S.init(M, DM, A.G, A.bx);
            pg8::EpiBranchFused E{WSP(const bf16*, WS_GT), WSP(bf16*, WS_MRG), DM};
            pg8::gemm_phase<pg8::EpiBranchFused, pg8::StaticOrder, true, true>(F.lds + RING_OFF, g, S, E);
        }
#endif
        SEAM(pb + 4);
        if (IN(pb + 5)) {
            PHASE_BEGIN; unsigned char* wl = A.ws + WS_W + (size_t)l * WL_SIZE;
            pg8::Gemm g{WSP(const bf16*, WS_MRG), (const bf16*)(wl + WL_WOUT), M, DM, DM}; pg8::StaticOrder S; S.init(M, DM, A.G, A.bx);
            pg8::EpiSplitBf16 E{WSP(bf16*, WS_TM), WSP(bf16*, WS_TM), 1 << 30, DM};
            pg8::gemm_phase<pg8::EpiSplitBf16, pg8::StaticOrder, true, true>(F.lds + RING_OFF, g, S, E);
        }
#if PROBE_REPEAT & 256
        __syncthreads();
        if (IN(pb + 5)) {
            PHASE_BEGIN; unsigned char* wl = A.ws + WS_W + (size_t)l * WL_SIZE;
            pg8::Gemm g{WSP(const bf16*, WS_MRG), (const bf16*)(wl + WL_WOUT), M, DM, DM}; pg8::StaticOrder S; S.init(M, DM, A.G, A.bx);
            pg8::EpiSplitBf16 E{WSP(bf16*, WS_TM), WSP(bf16*, WS_TM), 1 << 30, DM};
            pg8::gemm_phase<pg8::EpiSplitBf16, pg8::StaticOrder, true, true>(F.lds + RING_OFF, g, S, E);
        }
#endif
        SEAM(pb + 5);
        if (IN(pb + 6)) { PHASE_BEGIN; resid_rows(F, A, WSP(bf16*, WS_HB), WSP(const bf16*, WS_TM), A.g_mix_post + (size_t)l * DM, WSP(float*, WS_RS), nullptr); }
        SEAM(pb + 6);
        if (IN(pb + 7)) {
            PHASE_BEGIN; unsigned char* wl = A.ws + WS_W + (size_t)l * WL_SIZE; load_rs_table(F, A);
            pg8::Gemm g{WSP(const bf16*, WS_HB), (const bf16*)(wl + WL_WGU), M, 2 * FF, DM}; pg8::StaticOrder S; S.init(M, 2 * FF, A.G, A.bx);
            pg8::EpiSwiglu E{WSP(bf16*, WS_PB), FF, (const LAS float*)(F.lds + RS_OFF)};
            pg8::gemm_phase<pg8::EpiSwiglu, pg8::StaticOrder, true, true>(F.lds + RING_OFF, g, S, E);
        }
#if PROBE_REPEAT & 32
        if (IN(pb + 7)) {
            __syncthreads(); PHASE_BEGIN; unsigned char* wl = A.ws + WS_W + (size_t)l * WL_SIZE; load_rs_table(F, A);
            pg8::Gemm g{WSP(const bf16*, WS_HB), (const bf16*)(wl + WL_WGU), M, 2 * FF, DM}; pg8::StaticOrder S; S.init(M, 2 * FF, A.G, A.bx);
            pg8::EpiSwiglu E{WSP(bf16*, WS_PB), FF, (const LAS float*)(F.lds + RS_OFF)};
            pg8::gemm_phase<pg8::EpiSwiglu, pg8::StaticOrder, true, true>(F.lds + RING_OFF, g, S, E);
        }
#endif
        SEAM(pb + 7);
        if (IN(pb + 8)) {
            PHASE_BEGIN; unsigned char* wl = A.ws + WS_W + (size_t)l * WL_SIZE;
            pg8::Gemm g{WSP(const bf16*, WS_PB), (const bf16*)(wl + WL_WD), M, DM, FF}; pg8::StaticOrder S; S.init(M, DM, A.G, A.bx);
            pg8::EpiSplitBf16 E{WSP(bf16*, WS_TM), WSP(bf16*, WS_TM), 1 << 30, DM};
            pg8::gemm_phase<pg8::EpiSplitBf16, pg8::StaticOrder, true, true>(F.lds + RING_OFF, g, S, E);
        }
#if PROBE_REPEAT & 64
        if (IN(pb + 8)) {
            __syncthreads(); PHASE_BEGIN; unsigned char* wl = A.ws + WS_W + (size_t)l * WL_SIZE;
            pg8::Gemm g{WSP(const bf16*, WS_PB), (const bf16*)(wl + WL_WD), M, DM, FF}; pg8::StaticOrder S; S.init(M, DM, A.G, A.bx);
            pg8::EpiSplitBf16 E{WSP(bf16*, WS_TM), WSP(bf16*, WS_TM), 1 << 30, DM};
            pg8::gemm_phase<pg8::EpiSplitBf16, pg8::StaticOrder, true, true>(F.lds + RING_OFF, g, S, E);
        }
#endif
        SEAM(pb + 8);
        if (IN(pb + 9)) { PHASE_BEGIN;
            resid_rows(F, A, WSP(bf16*, WS_HB), WSP(const bf16*, WS_TM), A.g_ffn_post + (size_t)l * DM, WSP(float*, WS_RS), l + 1 < DEPTH ? (float*)nullptr : A.out); }
        SEAM(pb + 9);
}
__global__ void __launch_bounds__(NWAVES * 64, 2) fwd_kernel(Ptrs A0) {
    extern __shared__ __attribute__((aligned(16))) unsigned char lds[];
    LAS unsigned char* ldsb = (LAS unsigned char*)lds;
    LAS unsigned* argw = (LAS unsigned*)(ldsb + LDSCTL_OFF);
    volatile LAS unsigned* MISC = (volatile LAS unsigned*)(ldsb + MISC_OFF);
    for (int u = threadIdx.x; u < (LDS_BYTES - LDSCTL_OFF) / 4; u += NWAVES * 64) ((LAS unsigned*)(ldsb + LDSCTL_OFF))[u] = 0u;
    __syncthreads();
    if (threadIdx.x == 0) park_args(A0, argw);
    const int lo = A0.ph_lo, hi = A0.ph_hi;
    unsigned* barw = (unsigned*)(A0.ws + WS_CTL) + CW_BAR;
    __syncthreads();
    XcdBarrier bar; bar.bar = barw; bar.x = 0; bar.st = nullptr;
    if (!MK_PER_PHASE) bar = xcd_barrier_post(barw, MISC + 8);

    if (IN(0)) { PHASE_BEGIN; convert_items(F, A, 0); if (!CONV_IN_GEMM) convert_span(F, A, cv::I_IN, CONV_UNDER_ATTN ? cv::O_B : DEPTH * cv::I_LAYER, A.vcu * NWAVES + F.wave, A.G * NWAVES); rope_tables(F, A); x_in_rows(F, A, A.x, WSP(bf16*, WS_HB), WSP(float*, WS_RS)); }
#if PROBE_REPEAT & 8
    if (IN(0)) { for (int rep = 0; rep < 4; ++rep) { __syncthreads(); PHASE_BEGIN; x_in_rows(F, A, A.x, WSP(bf16*, WS_HB), WSP(float*, WS_RS)); } }
#endif
#if PROBE_REPEAT & 16
    if (IN(0)) { for (int rep = 0; rep < 20; ++rep) xcd_barrier(bar); }
#endif
#if PROBE_REPEAT & 2
    if (IN(0)) { __syncthreads(); PHASE_BEGIN; convert_items(F, A, 0); convert_items(F, A, 1); }
#endif
    SEAM(0);
    layer_phases<0>(ldsb, argw, bar, lo, hi);
    layer_phases<1>(ldsb, argw, bar, lo, hi);
    static_assert(DEPTH == 2, "two layers written out");
}
#undef IN
#undef SEAM
#undef WSP
#undef PHASE_BEGIN

extern "C" void kernel_launch(void* const* d_in, const int* in_sizes, int n_in, void* d_out, int out_size, void* d_ws, size_t ws_size, hipStream_t stream) {
    static int grid = 0;
    if (grid == 0) {
        if (n_in != 17 || in_sizes[0] != M * DM || out_size != M * DM || ws_size < WS_END) { fprintf(stderr, "kernel_launch: unexpected shapes (n_in %d, in0 %d, out %d, ws %zu < %zu); nothing launched\n", n_in, n_in > 0 ? in_sizes[0] : -1, out_size, ws_size, (size_t)WS_END); grid = -1; return; }
        int dev = 0, cus = 0, per_cu = 0;
        if (hipGetDevice(&dev) != hipSuccess || hipDeviceGetAttribute(&cus, hipDeviceAttributeMultiprocessorCount, dev) != hipSuccess) { fprintf(stderr, "kernel_launch: device query failed\n"); grid = -1; return; }
        if (hipFuncSetAttribute((const void*)fwd_kernel, hipFuncAttributeMaxDynamicSharedMemorySize, LDS_BYTES) != hipSuccess) { fprintf(stderr, "kernel_launch: hipFuncSetAttribute failed\n"); grid = -1; return; }
        if (hipOccupancyMaxActiveBlocksPerMultiprocessor(&per_cu, (const void*)fwd_kernel, NWAVES * 64, LDS_BYTES) != hipSuccess || per_cu < 1) { fprintf(stderr, "kernel_launch: occupancy query reports %d workgroups per CU\n", per_cu); }
        (void)hipGetLastError();
        if (cus % 8 != 0) { fprintf(stderr, "kernel_launch: %d CUs: the row-panel ownership the epilogues rely on needs a grid that is a multiple of 8; nothing launched\n", cus); grid = -1; return; }
        grid = cus;
    }
    if (grid < 0) return;
    if (hipMemsetAsync((char*)d_ws + WS_CTL, 0, CTL_ZERO_BYTES, stream) != hipSuccess) { fprintf(stderr, "kernel_launch: memset failed\n"); return; }
    Ptrs a{};
    a.x = (const float*)d_in[0]; a.pos = (const int*)d_in[1]; a.g_mix_pre = (const float*)d_in[2]; a.g_mix_post = (const float*)d_in[3]; a.g_ffn_pre = (const float*)d_in[4]; a.g_ffn_post = (const float*)d_in[5];
    a.w_in = (const float*)d_in[6]; a.g_q_lora = (const float*)d_in[7]; a.w_uq = (const float*)d_in[8]; a.g_kv_lora = (const float*)d_in[9]; a.w_ukv = (const float*)d_in[10]; a.b_forget = (const float*)d_in[11];
    a.swa_sinks = (const float*)d_in[12]; a.w_branch = (const float*)d_in[13]; a.w_out = (const float*)d_in[14]; a.w_gate_up = (const float*)d_in[15]; a.w_down = (const float*)d_in[16];
    a.out = (float*)d_out; a.ws = (unsigned char*)d_ws;
#if MK_PER_PHASE
    for (int k = 0; k < N_PHASES; ++k) { a.ph_lo = k; a.ph_hi = k + 1; hipLaunchKernelGGL(fwd_kernel, dim3(grid), dim3(NWAVES * 64), LDS_BYTES, stream, a); }
#else
    a.ph_lo = 0; a.ph_hi = N_PHASES; hipLaunchKernelGGL(fwd_kernel, dim3(grid), dim3(NWAVES * 64), LDS_BYTES, stream, a);
#endif
    const hipError_t le = hipPeekAtLastError();
    if (le != hipSuccess) fprintf(stderr, "kernel_launch: launch failed: %s\n", hipGetErrorName(le));
}
```

```cpp
#include <hip/hip_runtime.h>
#include <cstdio>
#include <cstdint>
namespace pg8 {
#define PG8_LAS __attribute__((address_space(3)))
typedef unsigned short bf16_t;
typedef short bf16x8 __attribute__((ext_vector_type(8)));
typedef float f32x4 __attribute__((ext_vector_type(4)));
typedef unsigned u32x4 __attribute__((ext_vector_type(4)));
constexpr int BM = 256, BK = 64, HALF = 128, HTB = HALF * BK * 2  , STAGE_BYTES = 8 * HTB, NXCD = 8, WGM = 8;

__host__ __device__ __forceinline__ int lds_byte(int r, int c) { const int st = (r >> 4) * 2 + (c >> 5), rr = r & 15, cc = c & 31, ob = rr * 64 + cc * 2; return st * 1024 + (ob ^ (((ob >> 9) & 1) << 5)); }
__host__ __device__ __forceinline__ void stage_rc(int b, int& R, int& C) { const int st = b / 1024, sb = b % 1024, swz = sb ^ (((sb >> 9) & 1) << 5); R = (st >> 1) * 16 + swz / 64; C = (st & 1) * 32 + (swz % 64) / 2; }
__host__ __device__ __forceinline__ int perm32(int rho) { const int n = rho >> 4, i = rho & 15; return 8 * (i >> 2) + 4 * n + (i & 3); }

struct Unit { int pm, pn; };
struct Gemm { const bf16_t* A; const bf16_t* Bt; int M, N, K; };

struct StaticOrder {
    int nM, nN, nwg, G, c;
    __host__ __device__ void init(int M, int N, int G_, int c_) { nM = M / BM; nN = N / BM; nwg = nM * nN; G = G_; c = c_; }
    __host__ __device__ bool next(int i, Unit& u) const {
        const long L = (long)i * G + c; if (L >= nwg) return false;
        int wgid = (int)L; { const int q = nwg / NXCD, r = nwg % NXCD, xcd = wgid % NXCD, off = wgid / NXCD; wgid = (xcd < r ? xcd * (q + 1) : r * (q + 1) + (xcd - r) * q) + off; }
        const int nig = WGM * nN, gid = wgid / nig, fm = gid * WGM, gsz = (nM - fm) < WGM ? (nM - fm) : WGM;
        u.pm = fm + ((wgid % nig) % gsz); u.pn = (wgid % nig) / gsz; return true;
    }
    __device__ __forceinline__ void a_ready(const Unit&) const {}
    __device__ __forceinline__ void done(const Unit&) const {}
};
struct RangeOrder {
    StaticOrder S; int i0, i1;
    __host__ __device__ bool next(int i, Unit& u) const { return (i0 + i < i1) && S.next(i0 + i, u); }
    __device__ __forceinline__ void a_ready(const Unit&) const {}
    __device__ __forceinline__ void done(const Unit&) const {}
};
__device__ __forceinline__ unsigned cvt_pk_bf16(float lo, float hi) { unsigned r; asm volatile("v_cvt_pk_bf16_f32 %0, %1, %2" : "=v"(r) : "v"(lo), "v"(hi)); return r; }
typedef float f32x2 __attribute__((ext_vector_type(2)));
__device__ __forceinline__ float sigmoid_f(float v) { return __builtin_amdgcn_rcpf(1.0f + __builtin_amdgcn_exp2f(-1.4426950408889634f * v)); }
__device__ __forceinline__ u32x4 pack8_bf16(const f32x4 v0, const f32x4 v1) { u32x4 w; w.x = cvt_pk_bf16(v0[0], v0[1]); w.y = cvt_pk_bf16(v0[2], v0[3]); w.z = cvt_pk_bf16(v1[0], v1[1]); w.w = cvt_pk_bf16(v1[2], v1[3]); return w; }
__device__ __forceinline__ float bf_lo(unsigned w) { return __uint_as_float(w << 16); }
__device__ __forceinline__ float bf_hi(unsigned w) { return __uint_as_float(w & 0xffff0000u); }

__device__ __forceinline__ size_t gate_tile_elem(int gt, int pm, int wr, int wc, int fr, int fq) {
    const int i = gt >> 4, pn = gt & 15;
    return ((size_t)((i * 64 + pm) * 16 + pn) * 8 + (wr * 4 + wc)) * 8192 + (size_t)(fq * 16 + fr) * 8;
}
typedef unsigned v4u32_t __attribute__((__vector_size__(16)));
__device__ __forceinline__ void st_wt16(u32x4 v, __amdgpu_buffer_rsrc_t rsrc, int byte_off) { __builtin_amdgcn_raw_buffer_store_b128(__builtin_bit_cast(v4u32_t, v), rsrc, byte_off, 0, 16); }
struct EpiInproj {
    static constexpr bool PERM = true, AFTER_DRAIN = false, HAS_MID = false;
    bf16_t* P; float* misc; int ldp; int gate_t0; bf16_t* GT; PG8_LAS const float* rsl; int gt_bytes;
    __device__ __forceinline__ void operator()(const f32x4 (&acc)[2][2][4][2], const Unit& u, int wr, int wc, int fr, int fq) const {
        const int row0 = u.pm * BM + wr * 64 + fr, cl = wc * 32 + 8 * fq;
#define PG8_LOAD_RS float rs[2][4]; _Pragma("unroll") for (int ai = 0; ai < 2; ++ai) _Pragma("unroll") for (int m = 0; m < 4; ++m) rs[ai][m] = rsl[(u.pm & 7) * BM + wr * 64 + fr + ai * HALF + m * 16];
        if (u.pn == 6) {
            PG8_LOAD_RS
#pragma unroll
            for (int ai = 0; ai < 2; ++ai)
#pragma unroll
                for (int m = 0; m < 4; ++m) { float* rowp = misc + (size_t)(row0 + ai * HALF + m * 16) * 256 + cl;
#pragma unroll
                    for (int bj = 0; bj < 2; ++bj) { *(f32x4*)(rowp + bj * HALF) = acc[ai][bj][m][0] * rs[ai][m]; *(f32x4*)(rowp + bj * HALF + 4) = acc[ai][bj][m][1] * rs[ai][m]; } }
        } else if (u.pn < gate_t0) {
            PG8_LOAD_RS
#pragma unroll
            for (int ai = 0; ai < 2; ++ai)
#pragma unroll
                for (int m = 0; m < 4; ++m) { bf16_t* rowp = P + (size_t)(row0 + ai * HALF + m * 16) * ldp + u.pn * BM + cl;
#pragma unroll
                    for (int bj = 0; bj < 2; ++bj) *(u32x4*)(rowp + bj * HALF) = pack8_bf16(acc[ai][bj][m][0] * rs[ai][m], acc[ai][bj][m][1] * rs[ai][m]); }
        } else {
            PG8_LOAD_RS
            const size_t tpo = gate_tile_elem(u.pn - gate_t0, u.pm, wr, wc, fr, fq);
            const __amdgpu_buffer_rsrc_t gt_rsrc = __builtin_amdgcn_make_buffer_rsrc((void*)GT, 0, gt_bytes, 0x00020000);
#pragma unroll
            for (int ai = 0; ai < 2; ++ai)
#pragma unroll
                for (int m = 0; m < 4; ++m)
#pragma unroll
                    for (int bj = 0; bj < 2; ++bj) { f32x4 v0 = acc[ai][bj][m][0] * rs[ai][m], v1 = acc[ai][bj][m][1] * rs[ai][m];
#pragma unroll
                        for (int e = 0; e < 4; ++e) { v0[e] = fmaxf(sigmoid_f(v0[e]), 1e-20f); v1[e] = fmaxf(sigmoid_f(v1[e]), 1e-20f); }
                        st_wt16(pack8_bf16(v0, v1), gt_rsrc, (int)(tpo + (size_t)(((ai * 4 + m) * 2 + bj) * 512)) * 2); }
        }
    }
};
#undef PG8_LOAD_RS
struct EpiSplitBf16 {
    static constexpr bool PERM = true, AFTER_DRAIN = false, HAS_MID = false;
    bf16_t* O0; bf16_t* O1; int split; int ldc;
    __device__ __forceinline__ void operator()(const f32x4 (&acc)[2][2][4][2], const Unit& u, int wr, int wc, int fr, int fq) const {
        const int row0 = u.pm * BM + wr * 64 + fr; bf16_t* base = u.pn < split ? O0 : O1; const int col0 = (u.pn < split ? u.pn : u.pn - split) * BM + wc * 32 + 8 * fq;
#pragma unroll
        for (int ai = 0; ai < 2; ++ai)
#pragma unroll
            for (int m = 0; m < 4; ++m) { bf16_t* rowp = base + (size_t)(row0 + ai * HALF + m * 16) * ldc + col0;
#pragma unroll
                for (int bj = 0; bj < 2; ++bj) *(u32x4*)(rowp + bj * HALF) = pack8_bf16(acc[ai][bj][m][0], acc[ai][bj][m][1]); }
    }
};
struct EpiQup {
    static constexpr bool PERM = true, AFTER_DRAIN = false, HAS_MID = false;
    bf16_t* QN; bf16_t* QR; const float* cs; const float* sn;
    __device__ __forceinline__ void operator()(const f32x4 (&acc)[2][2][4][2], const Unit& u, int wr, int wc, int fr, int fq) const {
        const int row0 = u.pm * BM + wr * 64 + fr;
        if (u.pn < 4) {
            const int col0 = u.pn * BM + wc * 32 + 8 * fq;
#pragma unroll
            for (int ai = 0; ai < 2; ++ai)
#pragma unroll
                for (int m = 0; m < 4; ++m) { bf16_t* rowp = QN + (size_t)(row0 + ai * HALF + m * 16) * 1024 + col0;
#pragma unroll
                    for (int bj = 0; bj < 2; ++bj) *(u32x4*)(rowp + bj * HALF) = pack8_bf16(acc[ai][bj][m][0], acc[ai][bj][m][1]); }
        } else {
            const int col0 = (u.pn - 4) * BM + wc * 32 + 8 * fq;
#pragma unroll
            for (int ai = 0; ai < 2; ++ai)
#pragma unroll
                for (int m = 0; m < 4; ++m) { const int row = row0 + ai * HALF + m * 16;
#pragma unroll
                    for (int bj = 0; bj < 2; ++bj) { const int c = col0 + bj * HALF, i0 = (c & 63) >> 1;
                        const f32x4 cv = *(const f32x4*)(cs + (size_t)row * 32 + i0), sv = *(const f32x4*)(sn + (size_t)row * 32 + i0);
                        const f32x4 a = acc[ai][bj][m][0], b = acc[ai][bj][m][1]; f32x4 o0, o1;
                        o0[0] = a[0] * cv[0] - a[1] * sv[0]; o0[1] = a[1] * cv[0] + a[0] * sv[0]; o0[2] = a[2] * cv[1] - a[3] * sv[1]; o0[3] = a[3] * cv[1] + a[2] * sv[1];
                        o1[0] = b[0] * cv[2] - b[1] * sv[2]; o1[1] = b[1] * cv[2] + b[0] * sv[2]; o1[2] = b[2] * cv[3] - b[3] * sv[3]; o1[3] = b[3] * cv[3] + b[2] * sv[3];
                        *(u32x4*)(QR + (size_t)row * 512 + c) = pack8_bf16(o0, o1); } }
        }
    }
};
template <int MODE> struct EpiBranch {
    static constexpr bool PERM = true, AFTER_DRAIN = false, HAS_MID = false;
    const bf16_t* G; int ldg; float* T; bf16_t* MRG; int ldc;
    __device__ __forceinline__ void operator()(const f32x4 (&acc)[2][2][4][2], const Unit& u, int wr, int wc, int fr, int fq) const {
        const int row0 = u.pm * BM + wr * 64 + fr, col0 = u.pn * BM + wc * 32 + 8 * fq;
#pragma unroll
        for (int ai = 0; ai < 2; ++ai)
#pragma unroll
            for (int m = 0; m < 4; ++m) { const size_t row = (size_t)(row0 + ai * HALF + m * 16);
#pragma unroll
                for (int bj = 0; bj < 2; ++bj) { const int c = col0 + bj * HALF;
                    const u32x4 gw = *(const u32x4*)(G + row * ldg + c);
                    f32x4 v0 = acc[ai][bj][m][0], v1 = acc[ai][bj][m][1];
                    v0[0] *= bf_lo(gw.x); v0[1] *= bf_hi(gw.x); v0[2] *= bf_lo(gw.y); v0[3] *= bf_hi(gw.y);
                    v1[0] *= bf_lo(gw.z); v1[1] *= bf_hi(gw.z); v1[2] *= bf_lo(gw.w); v1[3] *= bf_hi(gw.w);
                    float* tp = T + row * ldc + c;
                    if (MODE >= 1) { v0 += *(const f32x4*)tp; v1 += *(const f32x4*)(tp + 4); }
                    if (MODE <= 1) { *(f32x4*)tp = v0; *(f32x4*)(tp + 4) = v1; }
                    else *(u32x4*)(MRG + row * ldc + c) = pack8_bf16(v0, v1); } }
    }
};
__device__ __forceinline__ void gate_load8(u32x4 (&g)[8], const bf16_t* tpm) {
    asm volatile(
        "global_load_dwordx4 %0, %8, off offset:-4096\n\t"  "global_load_dwordx4 %1, %8, off offset:-3072\n\t"
        "global_load_dwordx4 %2, %8, off offset:-2048\n\t"  "global_load_dwordx4 %3, %8, off offset:-1024\n\t"
        "global_load_dwordx4 %4, %8, off\n\t"               "global_load_dwordx4 %5, %8, off offset:1024\n\t"
        "global_load_dwordx4 %6, %8, off offset:2048\n\t"   "global_load_dwordx4 %7, %8, off offset:3072\n\t"
        "s_waitcnt vmcnt(0)"
        : "=&v"(g[0]), "=&v"(g[1]), "=&v"(g[2]), "=&v"(g[3]), "=&v"(g[4]), "=&v"(g[5]), "=&v"(g[6]), "=&v"(g[7])
        : "v"(tpm) : "memory");
}
__device__ __forceinline__ void gate_load16(u32x4 (&g)[16], const bf16_t* tp) {
    const bf16_t* tpa = tp + 4 * 512; const bf16_t* tpb = tp + 12 * 512;
    asm volatile(
        "global_load_dwordx4 %0, %16, off offset:-4096\n\t"  "global_load_dwordx4 %1, %16, off offset:-3072\n\t"
        "global_load_dwordx4 %2, %16, off offset:-2048\n\t"  "global_load_dwordx4 %3, %16, off offset:-1024\n\t"
        "global_load_dwordx4 %4, %16, off\n\t"               "global_load_dwordx4 %5, %16, off offset:1024\n\t"
        "global_load_dwordx4 %6, %16, off offset:2048\n\t"   "global_load_dwordx4 %7, %16, off offset:3072\n\t"
        "global_load_dwordx4 %8, %17, off offset:-4096\n\t"  "global_load_dwordx4 %9, %17, off offset:-3072\n\t"
        "global_load_dwordx4 %10, %17, off offset:-2048\n\t" "global_load_dwordx4 %11, %17, off offset:-1024\n\t"
        "global_load_dwordx4 %12, %17, off\n\t"              "global_load_dwordx4 %13, %17, off offset:1024\n\t"
        "global_load_dwordx4 %14, %17, off offset:2048\n\t"  "global_load_dwordx4 %15, %17, off offset:3072\n\t"
        "s_waitcnt vmcnt(0)"
        : "=&v"(g[0]), "=&v"(g[1]), "=&v"(g[2]), "=&v"(g[3]), "=&v"(g[4]), "=&v"(g[5]), "=&v"(g[6]), "=&v"(g[7]),
          "=&v"(g[8]), "=&v"(g[9]), "=&v"(g[10]), "=&v"(g[11]), "=&v"(g[12]), "=&v"(g[13]), "=&v"(g[14]), "=&v"(g[15])
        : "v"(tpa), "v"(tpb) : "memory");
}
struct EpiBranchFused {
    static constexpr bool PERM = true, AFTER_DRAIN = false, HAS_MID = true;
    static constexpr int T1 = 16, T2 = 48;
    const bf16_t* GT; bf16_t* MRG; int ldc;
    __device__ __forceinline__ void mid(f32x4 (&acc)[2][2][4][2], const Unit& u, int seg, int, int, int, int) const {
        int t_ = threadIdx.x; asm volatile("" : "+v"(t_));
        const int wid_ = __builtin_amdgcn_readfirstlane(t_ >> 6), wr = wid_ >> 2, wc = wid_ & 3, fr = t_ & 15, fq = (t_ & 63) >> 4;
#pragma unroll
        for (int pass = 0; pass < 2; ++pass) {
            u32x4 gw[16]; gate_load16(gw, GT + gate_tile_elem((seg + pass) * 16 + u.pn, u.pm, wr, wc, fr, fq));
#pragma unroll
            for (int ai = 0; ai < 2; ++ai)
#pragma unroll
                for (int m = 0; m < 4; ++m)
#pragma unroll
                    for (int bj = 0; bj < 2; ++bj) { const u32x4 w = gw[(ai * 4 + m) * 2 + bj];
                        f32x4 s0 = {bf_lo(w.x), bf_hi(w.x), bf_lo(w.y), bf_hi(w.y)}, s1 = {bf_lo(w.z), bf_hi(w.z), bf_lo(w.w), bf_hi(w.w)};
                        if (pass == 1) {
#pragma unroll
                            for (int e = 0; e < 4; ++e) { s0[e] = __builtin_amdgcn_rcpf(fmaxf(s0[e], 1e-30f)); s1[e] = __builtin_amdgcn_rcpf(fmaxf(s1[e], 1e-30f)); } }
                        acc[ai][bj][m][0] *= s0; acc[ai][bj][m][1] *= s1;
                        asm volatile("" : "+v"(acc[ai][bj][m][0]), "+v"(acc[ai][bj][m][1])); }
        }
    }
    __device__ __forceinline__ void operator()(const f32x4 (&acc)[2][2][4][2], const Unit& u, int, int, int, int) const {
        int t_ = threadIdx.x; asm volatile("" : "+v"(t_));
        const int wid_ = __builtin_amdgcn_readfirstlane(t_ >> 6), wr = wid_ >> 2, wc = wid_ & 3, fr = t_ & 15, fq = (t_ & 63) >> 4;
        const int row0 = u.pm * BM + wr * 64 + fr, col0 = u.pn * BM + wc * 32 + 8 * fq;
        u32x4 gw[16]; gate_load16(gw, GT + gate_tile_elem(2 * 16 + u.pn, u.pm, wr, wc, fr, fq));
#pragma unroll
        for (int ai = 0; ai < 2; ++ai) {
#pragma unroll
            for (int m = 0; m < 4; ++m) { const size_t row = (size_t)(row0 + ai * HALF + m * 16);
#pragma unroll
                for (int bj = 0; bj < 2; ++bj) { const int c = col0 + bj * HALF; const u32x4 g = gw[(ai * 4 + m) * 2 + bj];
                    f32x4 v0 = acc[ai][bj][m][0], v1 = acc[ai][bj][m][1];
                    v0[0] *= bf_lo(g.x); v0[1] *= bf_hi(g.x); v0[2] *= bf_lo(g.y); v0[3] *= bf_hi(g.y);
                    v1[0] *= bf_lo(g.z); v1[1] *= bf_hi(g.z); v1[2] *= bf_lo(g.w); v1[3] *= bf_hi(g.w);
                    *(u32x4*)(MRG + row * ldc + c) = pack8_bf16(v0, v1); } }
            __builtin_amdgcn_sched_barrier(0); }
    }
};
struct EpiSwiglu {
    static constexpr bool PERM = true, AFTER_DRAIN = false, HAS_MID = false;
    bf16_t* H; int ldh; PG8_LAS const float* rsl;
    __device__ __forceinline__ void operator()(const f32x4 (&acc)[2][2][4][2], const Unit& u, int wr, int wc, int fr, int fq) const {
        const int row0 = u.pm * BM + wr * 64 + fr, col0 = u.pn * HALF + wc * 32 + 8 * fq;
#pragma unroll
        for (int ai = 0; ai < 2; ++ai)
#pragma unroll
            for (int m = 0; m < 4; ++m) { f32x4 o0, o1; const float rs = rsl[(u.pm & 7) * BM + wr * 64 + fr + ai * HALF + m * 16]; const f32x4 g0 = acc[ai][0][m][0] * rs, g1 = acc[ai][0][m][1] * rs, u0 = acc[ai][1][m][0] * rs, u1 = acc[ai][1][m][1] * rs;
#pragma unroll
                for (int e = 0; e < 4; ++e) { o0[e] = g0[e] * sigmoid_f(g0[e]) * u0[e]; o1[e] = g1[e] * sigmoid_f(g1[e]) * u1[e]; }
                *(u32x4*)(H + (size_t)(row0 + ai * HALF + m * 16) * ldh + col0) = pack8_bf16(o0, o1); }
    }
};
struct EpiF32 {
    static constexpr bool PERM = false, AFTER_DRAIN = false, HAS_MID = false;
    float* C; int ldc;
    __device__ __forceinline__ void operator()(const f32x4 (&acc)[2][2][4][2], const Unit& u, int wr, int wc, int fr, int fq) const {
        const int row0 = u.pm * BM + wr * 64 + fr, col0 = u.pn * BM + wc * 32 + 4 * fq;
#pragma unroll
        for (int ai = 0; ai < 2; ++ai)
#pragma unroll
            for (int m = 0; m < 4; ++m) { float* rowp = C + (size_t)(row0 + ai * HALF + m * 16) * ldc + col0;
#pragma unroll
                for (int bj = 0; bj < 2; ++bj)
#pragma unroll
                    for (int n = 0; n < 2; ++n) *(f32x4*)(rowp + bj * HALF + n * 16) = acc[ai][bj][m][n]; }
    }
};

#define PG8_KTILE_PAIR \
            const bool last = (t == nt - 2); \
            const char* a1 = cA + (size_t)(t + 1) * kstepA; \
            const char* a2 = last ? nA : cA + (size_t)(t + 2) * kstepA; const char* b2 = last ? nB : cB + (size_t)(t + 2) * kstepB; \
            const char* a3 = a2 + kstepA; const char* b3 = b2 + kstepB; \
            if (last && has_next) S.a_ready(nxt); \
            if constexpr (SP2) { \
            PG8_LDB(B0, 0, 0); PG8_LDB(B1, 0, 1); PG8_SCHED; PG8_LDA(At, 0, 0); PG8_STAGE(PG8_SA(1, 1), a1 + hstepA, voffA); \
            PG8_WAIT_V(8); PG8_WAIT_L(0); PG8_BAR; PG8_MMA(0, 0, At, B0); PG8_MMA(0, 1, At, B1); PG8_BAR; PG8_SCHED; \
            PG8_LDA(At, 0, 1); PG8_STAGE(PG8_SB(0, 0), b2, voffB); PG8_STAGE(PG8_SB(0, 1), b2 + hstepB, voffB); PG8_STAGE(PG8_SA(0, 0), a2, voffA); \
            PG8_WAIT_V(8); PG8_WAIT_L(0); PG8_BAR; PG8_MMA(1, 0, At, B0); PG8_MMA(1, 1, At, B1); PG8_BAR; PG8_SCHED; \
            PG8_LDB(B0, 1, 0); PG8_LDB(B1, 1, 1); PG8_SCHED; PG8_LDA(At, 1, 0); PG8_STAGE(PG8_SA(0, 1), a2 + hstepA, voffA); \
            PG8_WAIT_V(8); PG8_WAIT_L(0); PG8_BAR; PG8_MMA(0, 0, At, B0); PG8_MMA(0, 1, At, B1); PG8_BAR; PG8_SCHED; \
            PG8_LDA(At, 1, 1); PG8_STAGE(PG8_SB(1, 0), b3, voffB); PG8_STAGE(PG8_SB(1, 1), b3 + hstepB, voffB); PG8_STAGE(PG8_SA(1, 0), a3, voffA); \
            PG8_WAIT_V(8); PG8_WAIT_L(0); PG8_BAR; PG8_MMA(1, 0, At, B0); PG8_MMA(1, 1, At, B1); PG8_BAR; PG8_SCHED; \
            } else { \
            PG8_LDB(B0, 0, 0); PG8_SCHED; PG8_LDA(At, 0, 0); PG8_STAGE(PG8_SA(1, 1), a1 + hstepA, voffA); \
            PG8_WAIT_L(8); PG8_BAR; PG8_WAIT_L(0); PG8_MMA(0, 0, At, B0); PG8_BAR; PG8_SCHED; \
            PG8_LDB(B1, 0, 1); PG8_STAGE(PG8_SB(0, 0), b2, voffB); \
            PG8_BAR; PG8_WAIT_L(0); PG8_MMA(0, 1, At, B1); PG8_BAR; \
            PG8_LDA(At, 0, 1); PG8_STAGE(PG8_SA(0, 0), a2, voffA); \
            PG8_BAR; PG8_WAIT_L(0); PG8_MMA(1, 0, At, B0); PG8_BAR; PG8_SCHED; \
            PG8_STAGE(PG8_SB(0, 1), b2 + hstepB, voffB); \
            PG8_WAIT_V(6); PG8_BAR; PG8_MMA(1, 1, At, B1); PG8_BAR; \
            PG8_LDB(B0, 1, 0); PG8_SCHED; PG8_LDA(At, 1, 0); PG8_STAGE(PG8_SA(0, 1), a2 + hstepA, voffA); \
            PG8_WAIT_L(8); PG8_BAR; PG8_WAIT_L(0); PG8_MMA(0, 0, At, B0); PG8_BAR; PG8_SCHED; \
            PG8_LDB(B1, 1, 1); PG8_STAGE(PG8_SB(1, 0), b3, voffB); \
            PG8_BAR; PG8_WAIT_L(0); PG8_MMA(0, 1, At, B1); PG8_BAR; \
            PG8_LDA(At, 1, 1); PG8_STAGE(PG8_SA(1, 0), a3, voffA); \
            PG8_BAR; PG8_WAIT_L(0); PG8_MMA(1, 0, At, B0); PG8_BAR; PG8_SCHED; \
            PG8_STAGE(PG8_SB(1, 1), b3 + hstepB, voffB); \
            PG8_WAIT_V(6); PG8_BAR; PG8_MMA(1, 1, At, B1); PG8_BAR; \
            }
template <class Epi, class Sched, bool ALIGN_EPI = false, bool SP2 = false>
__device__ __forceinline__ void gemm_phase(PG8_LAS unsigned char* lds, const Gemm g, const Sched& S, const Epi& E) {
    int tid_ = threadIdx.x; asm volatile("" : "+v"(tid_));
    const int tid = tid_, wid = __builtin_amdgcn_readfirstlane(tid >> 6), lane = tid & 63, wr = wid >> 2, wc = wid & 3, fr = lane & 15, fq = lane >> 4;
    const int K = g.K, nt = K / BK;
    unsigned voffA[2], voffB[2];
#define PG8_LANE_VOFF(tid__) do { _Pragma("unroll") for (int i = 0; i < 2; ++i) { int R, C; stage_rc((tid__) * 16 + i * 8192, R, C); const int Rb = Epi::PERM ? ((R & ~31) + perm32(R & 31)) : R; \
        voffA[i] = (unsigned)(R * K + C) * 2u; (void)Rb; voffB[i] = (unsigned)((tid__) * 16 + i * 8192); } } while (0)
    PG8_LANE_VOFF(tid);
    const size_t kstepA = (size_t)(BK * 2), kstepB = 2 * HTB;
    const size_t hstepA = (size_t)HALF * K * 2, hstepB = HTB;
    const size_t tstepA = 2 * hstepA, tstepB = (size_t)nt * 2 * HTB;
    const unsigned ldsw = (unsigned)wid * 1024u;
    int aoff = lds_byte(wr * 64 + fr, fq * 8), boff = lds_byte(wc * 32 + fr, fq * 8);
#define PG8_LANE_REBUILD() do { int t__ = threadIdx.x; asm volatile("" : "+v"(t__)); PG8_LANE_VOFF(t__); const int l__ = t__ & 63, w__ = __builtin_amdgcn_readfirstlane(t__ >> 6); \
        aoff = lds_byte((w__ >> 2) * 64 + (l__ & 15), (l__ >> 4) * 8); boff = lds_byte((w__ & 3) * 32 + (l__ & 15), (l__ >> 4) * 8); } while (0)
#define PG8_SA(b, h) (((b) * 2 + (h)) * HTB)
#define PG8_SB(b, h) ((4 + (b) * 2 + (h)) * HTB)
#define PG8_STAGE(bufoff, gbase, voff) do { _Pragma("unroll") for (int _i = 0; _i < 2; ++_i) \
        __builtin_amdgcn_global_load_lds((const unsigned*)((const char*)(gbase) + (voff)[_i]), (PG8_LAS unsigned*)(lds + (bufoff) + ldsw + _i * 8192), 16, 0, 0); } while (0)
#define PG8_LDA(dst, b, h) do { _Pragma("unroll") for (int m = 0; m < 4; ++m) _Pragma("unroll") for (int k = 0; k < 2; ++k) dst[m][k] = *(const PG8_LAS bf16x8*)(lds + PG8_SA(b, h) + aoff + m * 2048 + k * 1024); } while (0)
#define PG8_LDB(dst, b, h) do { _Pragma("unroll") for (int n = 0; n < 2; ++n) _Pragma("unroll") for (int k = 0; k < 2; ++k) dst[n][k] = *(const PG8_LAS bf16x8*)(lds + PG8_SB(b, h) + boff + n * 2048 + k * 1024); } while (0)
#define PG8_MMA(ai, bj, At, Bt) do { __builtin_amdgcn_s_setprio(1); _Pragma("unroll") for (int k = 0; k < 2; ++k) _Pragma("unroll") for (int m = 0; m < 4; ++m) _Pragma("unroll") for (int n = 0; n < 2; ++n) \
        acc[ai][bj][m][n] = __builtin_amdgcn_mfma_f32_16x16x32_bf16(Bt[n][k], At[m][k], acc[ai][bj][m][n], 0, 0, 0); __builtin_amdgcn_s_setprio(0); } while (0)
#define PG8_WAIT_V(n) asm volatile("s_waitcnt vmcnt(" #n ")" ::: "memory")
#define PG8_WAIT_L(n) asm volatile("s_waitcnt lgkmcnt(" #n ")" ::: "memory")
#define PG8_BAR __builtin_amdgcn_s_barrier()
#define PG8_SCHED __builtin_amdgcn_sched_barrier(0)
    Unit cur, nxt; int ui = 0;
    if (!S.next(0, cur)) return;
    f32x4 acc[2][2][4][2];
#pragma unroll
    for (int a = 0; a < 2; ++a)
#pragma unroll
        for (int b = 0; b < 2; ++b)
#pragma unroll
            for (int m = 0; m < 4; ++m)
#pragma unroll
                for (int n = 0; n < 2; ++n) acc[a][b][m][n] = (f32x4){0.f, 0.f, 0.f, 0.f};
    bf16x8 At[4][2], B0[2][2], B1[2][2];
    const char* cA = (const char*)g.A + (size_t)cur.pm * tstepA; const char* cB = (const char*)g.Bt + (size_t)cur.pn * tstepB;
    S.a_ready(cur);
    if constexpr (SP2) {
        PG8_STAGE(PG8_SB(0, 0), cB, voffB); PG8_STAGE(PG8_SB(0, 1), cB + hstepB, voffB); PG8_STAGE(PG8_SA(0, 0), cA, voffA); PG8_STAGE(PG8_SA(0, 1), cA + hstepA, voffA);
        if (wr == 1) PG8_BAR;
        PG8_WAIT_V(2); PG8_BAR;
        PG8_STAGE(PG8_SB(1, 0), cB + kstepB, voffB); PG8_STAGE(PG8_SA(1, 0), cA + kstepA, voffA); PG8_STAGE(PG8_SB(1, 1), cB + hstepB + kstepB, voffB);
        PG8_WAIT_V(6); PG8_BAR;
    } else {
        PG8_STAGE(PG8_SB(0, 0), cB, voffB); PG8_STAGE(PG8_SA(0, 0), cA, voffA); PG8_STAGE(PG8_SB(0, 1), cB + hstepB, voffB); PG8_STAGE(PG8_SA(0, 1), cA + hstepA, voffA);
        if (wr == 1) PG8_BAR;
        PG8_WAIT_V(4); PG8_BAR;
        PG8_STAGE(PG8_SB(1, 0), cB + kstepB, voffB); PG8_STAGE(PG8_SA(1, 0), cA + kstepA, voffA); PG8_STAGE(PG8_SB(1, 1), cB + hstepB + kstepB, voffB);
        PG8_WAIT_V(6); PG8_BAR;
    }
    for (;;) {
        const bool has_next = S.next(ui + 1, nxt);
        const char* nA = has_next ? (const char*)g.A + (size_t)nxt.pm * tstepA : cA; const char* nB = has_next ? (const char*)g.Bt + (size_t)nxt.pn * tstepB : cB;
        int t = 0;
        if constexpr (Epi::HAS_MID) {
            for (; t < Epi::T1; t += 2) { PG8_KTILE_PAIR }
            E.mid(acc, cur, 0, wr, wc, fr, fq); PG8_LANE_REBUILD();
            for (; t < Epi::T2; t += 2) { PG8_KTILE_PAIR }
            E.mid(acc, cur, 1, wr, wc, fr, fq); PG8_LANE_REBUILD();
        }
        for (; t < nt; t += 2) { PG8_KTILE_PAIR }
        if constexpr (ALIGN_EPI) { if (wr == 0) PG8_BAR; }
        if constexpr (!Epi::AFTER_DRAIN) { E(acc, cur, wr, wc, fr, fq); S.done(cur); }
        if (!has_next) break;
#pragma unroll
        for (int a = 0; a < 2; ++a)
#pragma unroll
            for (int b = 0; b < 2; ++b)
#pragma unroll
                for (int m = 0; m < 4; ++m)
#pragma unroll
                    for (int n = 0; n < 2; ++n) acc[a][b][m][n] = (f32x4){0.f, 0.f, 0.f, 0.f};
        cur = nxt; cA = nA; cB = nB; ++ui;
        if constexpr (ALIGN_EPI) { if (wr == 1) PG8_BAR; }
    }
    PG8_WAIT_V(0);
    if constexpr (!ALIGN_EPI) { if (wr == 0) PG8_BAR; }
    PG8_BAR;
    if constexpr (Epi::AFTER_DRAIN) { E.fused(acc, cur, wr, wc, fr, fq, lds, wid, lane); S.done(cur); }
#undef PG8_SA
#undef PG8_SB
#undef PG8_STAGE
#undef PG8_LDA
#undef PG8_LDB
#undef PG8_MMA
#undef PG8_WAIT_V
#undef PG8_WAIT_L
#undef PG8_BAR
#undef PG8_SCHED
#undef PG8_LANE_VOFF
#undef PG8_LANE_REBUILD
#undef PG8_KTILE_PAIR
}
}

constexpr int NWAVES = 8;
#ifndef ATT_MFMA_TYPES
#define ATT_MFMA_TYPES 7
#endif
#ifndef PROBE_REPEAT
#define PROBE_REPEAT 0
#endif
#ifndef CONV_IN_GEMM
#define CONV_IN_GEMM 0
#endif
#ifndef MK_PER_PHASE
#define MK_PER_PHASE 0
#endif

constexpr int DM = 4096, NBATCH = 8, SEQ = 2048, M = NBATCH * SEQ, DEPTH = 2;
constexpr int NIN_SRC = 19528, NIN = 19712;
constexpr int FF = 11008;
constexpr float RMS_EPS = 1e-6f;
constexpr int PC_CQ = 0, PC_CKV = 1024, PC_MISC = 1536  , PC_QSWA = 1792, PC_KSWA = 3840, PC_VSWA = 4096, PC_QFOX = 4352, PC_KFOX = 5376, PC_VFOX = 6400, PC_GATE = 7424;
constexpr int GATE_TILE0 = PC_GATE / 256;
static_assert(PC_GATE + 3 * DM == NIN && NIN % 256 == 0 && PC_MISC / 256 == 6, "in-projection map");
constexpr int NINP = PC_GATE;

constexpr size_t MiB = 1u << 20;
constexpr size_t WS_CTL = 0, CTL_ZERO_BYTES = 1 * MiB;
constexpr size_t SZ_WIN = (size_t)NIN * DM * 2, SZ_WUQ = (size_t)1536 * 1024 * 2, SZ_WUKV = (size_t)2048 * 512 * 2, SZ_WB = (size_t)DM * DM * 2, SZ_WOUT = (size_t)DM * DM * 2,
                 SZ_WGU = (size_t)2 * FF * DM * 2, SZ_WD = (size_t)DM * FF * 2;
constexpr size_t WL_WIN = 0, WL_WUQ = WL_WIN + SZ_WIN, WL_WUKV = WL_WUQ + SZ_WUQ, WL_WB = WL_WUKV + SZ_WUKV, WL_WOUT = WL_WB + SZ_WB, WL_WGU = WL_WOUT + SZ_WOUT, WL_WD = WL_WGU + SZ_WGU,
                 WL_SIZE = WL_WD + SZ_WD;
constexpr size_t WS_W = 1 * MiB;
constexpr size_t WS_ROPE = WS_W + DEPTH * WL_SIZE;
constexpr size_t WS_HB = WS_ROPE + 4 * MiB;
constexpr size_t WS_PB = WS_HB + (size_t)M * DM * 2;
constexpr size_t WS_GT = WS_PB + (size_t)M * NINP * 2;
constexpr size_t WS_MISC = WS_PB + (size_t)M * NIN * 2;
constexpr size_t WS_CQN = WS_MISC + (size_t)M * 256 * 4;
constexpr size_t WS_CKVN = WS_CQN + (size_t)M * 1024 * 2;
constexpr size_t WS_KR = WS_CKVN + (size_t)M * 512 * 2;
constexpr size_t WS_LF = WS_KR + (size_t)M * 64 * 2;
constexpr size_t WS_FC = WS_LF + (size_t)M * 8 * 4;
constexpr size_t WS_QN = WS_FC + (size_t)M * 8 * 4;
constexpr size_t WS_QR = WS_QN + (size_t)M * 1024 * 2;
constexpr size_t WS_KN = WS_QR + (size_t)M * 512 * 2;
constexpr size_t WS_VM = WS_KN + (size_t)M * 1024 * 2;
constexpr size_t WS_OM = WS_VM + (size_t)M * 1024 * 2;
constexpr size_t WS_OS = WS_OM + (size_t)M * 1024 * 2;
constexpr size_t WS_OF = WS_OS + (size_t)M * 2048 * 2;
constexpr size_t WS_TM = WS_OF + (size_t)M * 1024 * 2;
constexpr size_t WS_MRG = WS_TM + (size_t)M * DM * 4;
constexpr size_t WS_RS = WS_MRG + (size_t)M * DM * 2;
constexpr size_t WS_POSF = WS_RS + (size_t)M * 4;
constexpr size_t WS_END = WS_POSF + (size_t)M * 4;
static_assert(WS_END <= (size_t)2752 * MiB, "d_ws map exceeds the guaranteed workspace");
static_assert((size_t)M * FF * 2 <= (size_t)M * NIN * 2 && WS_GT + (size_t)3 * M * DM * 2 <= WS_MISC, "HID overlays P + GT");
constexpr int CW_TMO = 0, CW_CODE = 1;
constexpr int CW_BAR = 4096;

constexpr int RING_OFF = 0, RING_BYTES = 131072;
constexpr int LDSCTL_OFF = RING_BYTES, MISC_OFF = LDSCTL_OFF + 320;
constexpr int RS_OFF = 133120;
constexpr int LDS_BYTES = 147456;
static_assert(MISC_OFF + 128 <= RS_OFF && RS_OFF + 8192 <= LDS_BYTES, "LDS map");

#define GAS __attribute__((address_space(1)))
#define LAS __attribute__((address_space(3)))
typedef unsigned short bf16;
typedef unsigned v4u __attribute__((ext_vector_type(4)));
typedef unsigned v2u __attribute__((ext_vector_type(2)));
typedef float f32x4 __attribute__((ext_vector_type(4)));
typedef short bf16x8 __attribute__((ext_vector_type(8)));
typedef GAS unsigned gu32;
typedef GAS unsigned long long gu64;
#define RLX_AGENT __ATOMIC_RELAXED, __HIP_MEMORY_SCOPE_AGENT
#define LDS_WAIT() asm volatile("s_waitcnt lgkmcnt(0)" ::: "memory")
#define VM_WAIT() asm volatile("s_waitcnt vmcnt(0)" ::: "memory")
__device__ __forceinline__ unsigned long long rt() { return __builtin_amdgcn_s_memrealtime(); }
__device__ __forceinline__ unsigned f2bf(float f) { unsigned u = __builtin_bit_cast(unsigned, f); return (u + 0x7fffu + ((u >> 16) & 1u)) >> 16; }
__device__ __forceinline__ unsigned pk2(float lo, float hi) { return f2bf(lo) | (f2bf(hi) << 16); }

#define XB_TMO      128
#define XB_XCNT(j)  (256  + 64 * (j))
#define XB_XSUB(j)  (1280 + 64 * (j))
#define XB_XGEN(j)  (2304 + 64 * (j))
#define XB_TOP      3328
#define XB_TOPGEN   3392
#define XCD_BAR_WORDS 3456
#define XB_SPIN_CAP (1u << 23)

__device__ __forceinline__ unsigned xb_ld(unsigned* p)              { return __hip_atomic_load(p, __ATOMIC_RELAXED, __HIP_MEMORY_SCOPE_AGENT); }
__device__ __forceinline__ unsigned xb_add(unsigned* p, unsigned v) { return __hip_atomic_fetch_add(p, v, __ATOMIC_RELAXED, __HIP_MEMORY_SCOPE_AGENT); }
__device__ __forceinline__ unsigned xb_xcc_id() { return (unsigned)__builtin_amdgcn_s_getreg((3 << 11) | 20) & 0xFu; }
#define XB_SPIN(cond, bar) do { unsigned _sp = 0; while (cond) { __builtin_amdgcn_s_sleep(1); \
    if ((++_sp & 255u) == 0u) { if (xb_ld(&(bar)[XB_TMO])) break; if (_sp > XB_SPIN_CAP) { atomicAdd(&(bar)[XB_TMO], 1u); break; } } } } while (0)

struct XcdBarrier {
    unsigned* bar; unsigned x;
    volatile LAS unsigned* st;
};

__device__ __forceinline__ XcdBarrier xcd_barrier_post(unsigned* bar, volatile LAS unsigned* st) {
    XcdBarrier b; b.bar = bar; b.x = xb_xcc_id(); b.st = st;
    if (threadIdx.x == 0) (void)xb_add(&bar[XB_XCNT(b.x)], 1u);
    return b;
}
__device__ __forceinline__ void xcd_barrier_complete(unsigned* bar, unsigned x, unsigned& nloc, unsigned& nx) {
    const unsigned G = gridDim.x * gridDim.y * gridDim.z;
    unsigned sum, cnt, mine, sp = 0u;
    for (;;) {
        sum = 0u; cnt = 0u; mine = 0u;
#pragma unroll
        for (unsigned j = 0; j < 16; ++j) { const unsigned c = xb_ld(&bar[XB_XCNT(j)]); sum += c; cnt += (c > 0u) ? 1u : 0u; mine = (j == x) ? c : mine; }
        if (sum == G) break;
        __builtin_amdgcn_s_sleep(1);
        if ((++sp & 255u) == 0u) { if (xb_ld(&bar[XB_TMO])) break; if (sp > XB_SPIN_CAP) { atomicAdd(&bar[XB_TMO], 1u); break; } }
    }
    nloc = mine > 0u ? mine : 1u; nx = cnt > 0u ? cnt : 1u;
}

__device__ __forceinline__ void xcd_barrier(const XcdBarrier& b) {
    asm volatile("s_waitcnt vmcnt(0)" ::: "memory");
    __syncthreads();
    if (threadIdx.x == 0) {
        unsigned* bar = b.bar;
        __builtin_amdgcn_s_waitcnt(0);
        unsigned nloc = b.st[0], nx = b.st[1];
        if (nloc == 0u) { xcd_barrier_complete(bar, b.x, nloc, nx); b.st[0] = nloc; b.st[1] = nx; }
        const unsigned old = xb_add(&bar[XB_XSUB(b.x)], 1u);
        const unsigned gen = old / nloc;
        if (old + 1u == (gen + 1u) * nloc) {
            __builtin_amdgcn_fence(__ATOMIC_RELEASE, "agent");
            asm volatile("s_waitcnt vmcnt(0)" ::: "memory");
            const unsigned og = xb_add(&bar[XB_TOP], 1u);
            const unsigned tg = og / nx;
            if (og + 1u == (tg + 1u) * nx) xb_add(&bar[XB_TOPGEN], 1u);
            else XB_SPIN(xb_ld(&bar[XB_TOPGEN]) == tg, bar);
            __builtin_amdgcn_fence(__ATOMIC_ACQUIRE, "agent");
            xb_add(&bar[XB_XGEN(b.x)], 1u);
            asm volatile("s_waitcnt vmcnt(0)" ::: "memory");
        } else {
            XB_SPIN(xb_ld(&bar[XB_XGEN(b.x)]) == gen, bar);
            __builtin_amdgcn_fence(__ATOMIC_ACQUIRE, "agent");
            asm volatile("s_waitcnt vmcnt(0)" ::: "memory");
        }
    }
    __syncthreads();
}

struct Frame {
    LAS unsigned char* lds;
    int tid, lane, wave;
};
__device__ __forceinline__ float wave_sum(float v) {
#pragma unroll
    for (int o = 1; o < 64; o <<= 1) v += __shfl_xor(v, o);
    return v;
}
__device__ __forceinline__ float wave_max(float v) {
#pragma unroll
    for (int o = 1; o < 64; o <<= 1) v = fmaxf(v, __shfl_xor(v, o));
    return v;
}
__device__ __forceinline__ float bfl(unsigned w) { return __uint_as_float(w << 16); }
__device__ __forceinline__ float bfh(unsigned w) { return __uint_as_float(w & 0xffff0000u); }

__device__ __forceinline__ void sincos_f(float x, float& s, float& c) {
    const float k = rintf(x * 0.636619772367581f);
    float r = fmaf(k, -1.5703125f, x); r = fmaf(k, -4.837512969970703125e-4f, r); r = fmaf(k, -7.549789948768648e-8f, r);
    const int q = (int)k & 3; const float z = r * r;
    const float sp = fmaf(r * z, fmaf(z, fmaf(z, -1.9515295891e-4f, 8.3321608736e-3f), -1.6666654611e-1f), r);
    const float cp = fmaf(z * z, fmaf(z, fmaf(z, 2.443315711809948e-5f, -1.388731625493765e-3f), 4.166664568298827e-2f), fmaf(z, -0.5f, 1.0f));
    float ss = (q & 1) ? cp : sp, cc = (q & 1) ? sp : cp;
    if (q & 2) ss = -ss; if ((q + 1) & 2) cc = -cc;
    s = ss; c = cc;
}

#ifndef WEIGHT_DROP_BITS
#define WEIGHT_DROP_BITS 2
#endif
__device__ __forceinline__ unsigned f2bfw(float f, unsigned drop) { const unsigned SH = 16u + drop; unsigned u = __builtin_bit_cast(unsigned, f); return ((u + ((1u << (SH - 1u)) - 1u) + ((u >> SH) & 1u)) >> SH) << drop; }
__device__ __forceinline__ unsigned pk2w(float lo, float hi, unsigned drop) { return f2bfw(lo, drop) | (f2bfw(hi, drop) << 16); }
__device__ __forceinline__ void tr_item(const float* W, int ldw, int K, bf16* WT, int k0, int dst_row0, int src_col0, int nvalid, int mode, LAS float* scr, int lane, const float* gk = nullptr, unsigned drop = WEIGHT_DROP_BITS) {
    if (mode == 0) {
        const int r8 = lane >> 3, c4 = (lane & 7) * 4; const bool ok = c4 < nvalid;
        const float* src = W + (size_t)(k0 + r8) * ldw + src_col0 + c4;
        f32x4 v[8];
#pragma unroll
        for (int i = 0; i < 8; ++i) v[i] = ok ? *(const GAS f32x4*)(src + (size_t)(8 * i) * ldw) : (f32x4){0.f, 0.f, 0.f, 0.f};
        if (gk) {
#pragma unroll
            for (int i = 0; i < 8; ++i) v[i] = v[i] * gk[k0 + 8 * i + r8]; }
#pragma unroll
        for (int i = 0; i < 8; ++i) { LAS float* dd = scr + (8 * i + r8) * 33 + c4; dd[0] = v[i].x; dd[1] = v[i].y; dd[2] = v[i].z; dd[3] = v[i].w; }
    } else {
        const int c = lane & 31; const int scol = src_col0 + 32 * (c & 1) + (c >> 1);
        const float* src = W + (size_t)(k0 + (lane >> 5)) * ldw + scol;
#pragma unroll 8
        for (int i = 0; i < 32; ++i) { const int kk = 2 * i + (lane >> 5); scr[kk * 33 + c] = src[(size_t)(2 * i) * ldw]; }
    }
    LDS_WAIT(); asm volatile("" ::: "memory");
    const int cc = lane & 7;
#pragma unroll
    for (int j = 0; j < 4; ++j) { const int n = (lane >> 3) + 8 * j; const LAS float* s = scr + (8 * cc) * 33 + n;
        v4u o; o.x = pk2w(s[0 * 33], s[1 * 33], drop); o.y = pk2w(s[2 * 33], s[3 * 33], drop); o.z = pk2w(s[4 * 33], s[5 * 33], drop); o.w = pk2w(s[6 * 33], s[7 * 33], drop);
        const int w = dst_row0 + n, wl = w & 127, x = wl & 31, R = (wl & ~31) + ((((x >> 2) & 1) << 4) | ((x >> 3) << 2) | (x & 3));
        *(GAS v4u*)((GAS unsigned char*)WT + ((size_t)((w >> 8) * (K >> 6) + (k0 >> 6)) * 2 + ((w >> 7) & 1)) * 16384 + pg8::lds_byte(R, 8 * cc)) = o; }
    LDS_WAIT(); asm volatile("" ::: "memory");
}
#define PTR_FIELDS(X) X(const float*, x) X(const int*, pos) X(const float*, g_mix_pre) X(const float*, g_mix_post) X(const float*, g_ffn_pre) X(const float*, g_ffn_post) X(const float*, w_in) \
    X(const float*, g_q_lora) X(const float*, w_uq) X(const float*, g_kv_lora) X(const float*, w_ukv) X(const float*, b_forget) X(const float*, swa_sinks) X(const float*, w_branch) X(const float*, w_out) \
    X(const float*, w_gate_up) X(const float*, w_down) X(float*, out) X(unsigned char*, ws)
constexpr int N_PTRS = 19;
struct Ptrs {
#define X(T, n) T n;
    PTR_FIELDS(X)
#undef X
    int ph_lo, ph_hi;
};
static_assert(sizeof(Ptrs) == N_PTRS * 8 + 8, "Ptrs has no padding");
struct PA : Ptrs { int G, bx, vcu; };
__device__ __forceinline__ unsigned long long ld_u64u(const LAS unsigned* w) { const unsigned lo = (unsigned)__builtin_amdgcn_readfirstlane((int)w[0]), hi = (unsigned)__builtin_amdgcn_readfirstlane((int)w[1]); return ((unsigned long long)hi << 32) | lo; }
__device__ __forceinline__ void park_args(const Ptrs& A0, LAS unsigned* argw) {
    LAS unsigned long long* a64 = (LAS unsigned long long*)argw; int i = 0;
#define X(T, n) a64[i++] = (unsigned long long)A0.n;
    PTR_FIELDS(X)
#undef X
    const int G = gridDim.x, bx = blockIdx.x;
    argw[2 * N_PTRS + 0] = (unsigned)G; argw[2 * N_PTRS + 1] = (unsigned)bx; argw[2 * N_PTRS + 2] = (unsigned)((G % 8 == 0) ? (bx % 8) * (G / 8) + bx / 8 : bx);
}
__device__ __forceinline__ PA load_args(const LAS unsigned* argw) {
    asm volatile("" ::: "memory");
    PA A; int i = 0;
#define X(T, n) A.n = (T)(GAS unsigned char*)ld_u64u(argw + 2 * (i++));
    PTR_FIELDS(X)
#undef X
    A.G = __builtin_amdgcn_readfirstlane((int)argw[2 * N_PTRS + 0]); A.bx = __builtin_amdgcn_readfirstlane((int)argw[2 * N_PTRS + 1]); A.vcu = __builtin_amdgcn_readfirstlane((int)argw[2 * N_PTRS + 2]);
    A.ph_lo = 0; A.ph_hi = 0;
    return A;
}
namespace cv {
constexpr int NB_IN = NIN / 32, NB_UQ = 1536 / 32, NB_UKV = 2048 / 32, NB_D = DM / 32, NB_GU = 2 * FF / 32;
constexpr int I_IN = (DM / 64) * NB_IN, I_UQ = (1024 / 64) * NB_UQ, I_UKV = (512 / 64) * NB_UKV, I_B0 = (1024 / 64) * NB_D, I_B1 = (2048 / 64) * NB_D, I_B2 = I_B0,
              I_OUT = (DM / 64) * NB_D, I_GU = (DM / 64) * NB_GU, I_D = (FF / 64) * NB_D;
constexpr int O_B = I_IN + I_UQ + I_UKV, O_GU = O_B + I_B0 + I_B1 + I_B2 + I_OUT, O_D = O_GU + I_GU;
constexpr int I_LAYER = O_D + I_D;
#ifndef CONV_UNDER_ATTN
#define CONV_UNDER_ATTN 1
#endif
#ifndef TAIL_T0
#define TAIL_T0 30208
#endif
#ifndef TAIL_T1
#define TAIL_T1 16384
#endif
#ifndef TAIL_T2
#define TAIL_T2 28000
#endif
#ifndef TAIL_T3
#define TAIL_T3 16384
#endif
constexpr int T0_LO = I_LAYER - TAIL_T0, T0_HI = I_LAYER;
constexpr int T1_LO = I_LAYER + O_B, T1_HI = T1_LO + TAIL_T1;
constexpr int T2_LO = I_LAYER + O_GU, T2_HI = T2_LO + TAIL_T2;
constexpr int T3_LO = I_LAYER + O_D, T3_HI = T3_LO + TAIL_T3;
static_assert(T0_LO >= O_GU && T1_HI <= I_LAYER + O_GU && T2_HI <= I_LAYER + O_D && T3_HI <= 2 * I_LAYER && DEPTH == 2, "tail slots");
}
__device__ __forceinline__ void convert_one(const PA& A, const int it, LAS float* scr, const int lane) {
    using namespace cv;
        const int l = it / I_LAYER; int r = it - l * I_LAYER;
        unsigned char* wl = A.ws + WS_W + (size_t)l * WL_SIZE;
        if (r < I_IN) { const int kb = r / NB_IN, nb = r - kb * NB_IN, n0 = nb * 32; int sc, nv;
            if (n0 < 1600) { sc = n0; nv = 32; } else if (n0 < 1632) { sc = 7232; nv = 8; } else if (n0 < PC_QSWA) { sc = 0; nv = 0; } else if (n0 < PC_GATE) { sc = n0 - 192; nv = 32; } else { sc = n0 - 184; nv = 32; }
            tr_item(A.w_in + (size_t)l * DM * NIN_SRC, NIN_SRC, DM, (bf16*)(wl + WL_WIN), kb * 64, n0, sc, nv, 0, scr, lane, A.g_mix_pre + (size_t)l * DM, WEIGHT_DROP_BITS); return; } r -= I_IN;
        if (r < I_UQ) { const int kb = r / NB_UQ, nb = r - kb * NB_UQ, n0 = nb * 32; int sc, mode;
            if (n0 < 1024) { sc = 192 * (n0 >> 7) + (n0 & 127); mode = 0; } else { const int q = n0 - 1024; sc = 192 * (q >> 6) + 128 + 16 * ((q >> 5) & 1); mode = 1; }
            tr_item(A.w_uq + (size_t)l * 1024 * 1536, 1536, 1024, (bf16*)(wl + WL_WUQ), kb * 64, n0, sc, 32, mode, scr, lane, nullptr, 0u); return; } r -= I_UQ;
        if (r < I_UKV) { const int kb = r / NB_UKV, nb = r - kb * NB_UKV, n0 = nb * 32; const int q = n0 & 1023;
            const int sc = 256 * (q >> 7) + (q & 127) + (n0 >= 1024 ? 128 : 0);
            tr_item(A.w_ukv + (size_t)l * 512 * 2048, 2048, 512, (bf16*)(wl + WL_WUKV), kb * 64, n0, sc, 32, 0, scr, lane, nullptr, 0u); return; } r -= I_UKV;
        if (r < I_B0 + I_B1 + I_B2) { const int kb = r / NB_D, nb = r - kb * NB_D;
            tr_item(A.w_branch + (size_t)l * DM * DM, DM, DM, (bf16*)(wl + WL_WB), kb * 64, nb * 32, nb * 32, 32, 0, scr, lane); return; } r -= I_B0 + I_B1 + I_B2;
        if (r < I_OUT) { const int kb = r / NB_D, nb = r - kb * NB_D;
            tr_item(A.w_out + (size_t)l * DM * DM, DM, DM, (bf16*)(wl + WL_WOUT), kb * 64, nb * 32, nb * 32, 32, 0, scr, lane); return; } r -= I_OUT;
        if (r < I_GU) { const int kb = r / NB_GU, nb = r - kb * NB_GU, n0 = nb * 32;
            const int sc = ((n0 >> 7) & 1) * FF + 128 * (n0 >> 8) + (n0 & 127);
            tr_item(A.w_gate_up + (size_t)l * DM * 2 * FF, 2 * FF, DM, (bf16*)(wl + WL_WGU), kb * 64, n0, sc, 32, 0, scr, lane, A.g_ffn_pre + (size_t)l * DM, WEIGHT_DROP_BITS); return; } r -= I_GU;
        { const int kb = r / NB_D, nb = r - kb * NB_D;
            tr_item(A.w_down + (size_t)l * FF * DM, DM, FF, (bf16*)(wl + WL_WD), kb * 64, nb * 32, nb * 32, 32, 0, scr, lane, nullptr, WEIGHT_DROP_BITS); }
}
__device__ __forceinline__ void convert_span(Frame& F, const PA& A, const int lo, const int hi, const int gw, const int NGW) {
    LAS float* scr = (LAS float*)(F.lds + RING_OFF + F.wave * 16384);
    for (int it = lo + gw; it < hi; it += NGW) convert_one(A, it, scr, F.lane);
}
__device__ __forceinline__ void convert_items(Frame& F, const PA& A, const int mode) {
    using namespace cv;
    const int gw = A.vcu * NWAVES + F.wave, NGW = A.G * NWAVES;
    if (mode == 0) { convert_span(F, A, 0, I_IN, gw, NGW); return; }
    if (mode == 1) { convert_span(F, A, I_IN, DEPTH * I_LAYER, gw, NGW); return; }
    LAS float* scr = (LAS float*)(F.lds + RING_OFF + F.wave * 16384);
    constexpr int n1 = T0_LO - I_IN, n2 = T1_LO - T0_HI, n3 = T2_LO - T1_HI, n4 = T3_LO - T2_HI, n5 = DEPTH * I_LAYER - T3_HI;
    for (int v = gw; v < n1 + n2 + n3 + n4 + n5; v += NGW) {
        const int it = v < n1 ? I_IN + v : v < n1 + n2 ? T0_HI + (v - n1) : v < n1 + n2 + n3 ? T1_HI + (v - n1 - n2) : v < n1 + n2 + n3 + n4 ? T2_HI + (v - n1 - n2 - n3) : T3_HI + (v - n1 - n2 - n3 - n4);
        convert_one(A, it, scr, F.lane); }
}
__device__ __forceinline__ void convert_tail(Frame& F, const PA& A, const int lo, const int hi, const int first_idle) {
    if (A.G != 256 || A.bx < first_idle) return;
    convert_span(F, A, lo, hi, (A.bx - first_idle) * NWAVES + F.wave, (256 - first_idle) * NWAVES);
}
__device__ __forceinline__ void rope_tables(Frame& F, const PA& A) {
    float* cs = (float*)(A.ws + WS_ROPE); float* sn = cs + (size_t)M * 32;
    for (int e = (A.vcu * NWAVES * 64) + F.tid; e < M * 32; e += A.G * NWAVES * 64) { const int m = e >> 5, i = e & 31;
        const float inv = __builtin_amdgcn_exp2f(-(float)i * 0.41524101186092f); const float ang = (float)A.pos[m] * inv; float s, c; sincos_f(ang, s, c); cs[e] = c; sn[e] = s;
        if (i == 0) ((float*)(A.ws + WS_POSF))[m] = (float)A.pos[m]; }
}
__device__ __forceinline__ void x_in_rows(Frame& F, const PA& A, const float* x, bf16* xb, float* rs) {
    const int gw = A.vcu * NWAVES + F.wave, NGW = A.G * NWAVES;
    for (int m = gw; m < M; m += NGW) {
        const GAS f32x4* xr = (const GAS f32x4*)(x + (size_t)m * DM) + F.lane;
        f32x4 v[16]; float s = 0.f;
#pragma unroll
        for (int j = 0; j < 16; ++j) { v[j] = xr[64 * j]; s += (v[j].x * v[j].x + v[j].y * v[j].y) + (v[j].z * v[j].z + v[j].w * v[j].w); }
        const float rstd = 1.0f / sqrtf(wave_sum(s) * (1.f / DM) + RMS_EPS);
        GAS unsigned long long* o8 = (GAS unsigned long long*)(xb + (size_t)m * DM) + F.lane;
#pragma unroll
        for (int j = 0; j < 16; ++j) o8[64 * j] = (unsigned long long)pk2(v[j].x, v[j].y) | ((unsigned long long)pk2(v[j].z, v[j].w) << 32);
        if (F.lane == 0) rs[m] = rstd;
    }
}
__device__ __forceinline__ void resid_rows(Frame& F, const PA& A, bf16* xb, const bf16* mo, const float* ga, float* rs, float* out) {
    const int gw = A.vcu * NWAVES + F.wave, NGW = A.G * NWAVES;
    for (int m = gw; m < M; m += NGW) {
        const GAS v2u* mr = (const GAS v2u*)(mo + (size_t)m * DM) + F.lane; GAS v2u* xr = (GAS v2u*)(xb + (size_t)m * DM) + F.lane;
        const GAS f32x4* gar = (const GAS f32x4*)ga + F.lane;
        f32x4 v[16]; v2u xw[16]; float s = 0.f;
#pragma unroll
        for (int j = 0; j < 16; ++j) { const v2u w = mr[64 * j]; xw[j] = xr[64 * j]; v[j] = (f32x4){bfl(w.x), bfh(w.x), bfl(w.y), bfh(w.y)}; s += (v[j].x * v[j].x + v[j].y * v[j].y) + (v[j].z * v[j].z + v[j].w * v[j].w); }
        const float rstd = 1.0f / sqrtf(wave_sum(s) * (1.f / DM) + RMS_EPS);
        float s2 = 0.f;
#pragma unroll
        for (int j = 0; j < 16; ++j) { const f32x4 gg = gar[64 * j]; f32x4 o;
            o.x = bfl(xw[j].x) + v[j].x * rstd * gg.x; o.y = bfh(xw[j].x) + v[j].y * rstd * gg.y; o.z = bfl(xw[j].y) + v[j].z * rstd * gg.z; o.w = bfh(xw[j].y) + v[j].w * rstd * gg.w;
            v[j] = o; s2 += (o.x * o.x + o.y * o.y) + (o.z * o.z + o.w * o.w); }
        if (out) { GAS f32x4* oo = (GAS f32x4*)(out + (size_t)m * DM) + F.lane;
#pragma unroll
            for (int j = 0; j < 16; ++j) oo[64 * j] = v[j]; }
        else {
#pragma unroll
            for (int j = 0; j < 16; ++j) { v2u w; w.x = pk2(v[j].x, v[j].y); w.y = pk2(v[j].z, v[j].w); xr[64 * j] = w; }
            const float rstd2 = 1.0f / sqrtf(wave_sum(s2) * (1.f / DM) + RMS_EPS);
            if (F.lane == 0) rs[m] = rstd2; }
    }
}
__device__ __forceinline__ void mla_prep_rows(Frame& F, const PA& A, int l, const int gw, const int NGW) {
    const bf16* P = (const bf16*)(A.ws + WS_PB); const float* misc = (const float*)(A.ws + WS_MISC);
    bf16* CQN = (bf16*)(A.ws + WS_CQN); bf16* CKVN = (bf16*)(A.ws + WS_CKVN); bf16* KR = (bf16*)(A.ws + WS_KR); float* LF = (float*)(A.ws + WS_LF);
    const float* cs = (const float*)(A.ws + WS_ROPE); const float* sn = cs + (size_t)M * 32;
    const float* gq = A.g_q_lora + (size_t)l * 1024; const float* gkv = A.g_kv_lora + (size_t)l * 512; const float* bf = A.b_forget + (size_t)l * 8;
    for (int m = gw; m < M; m += NGW) {
        const bf16* pr = P + (size_t)m * NINP;
        {
            const v4u a = *(const GAS v4u*)(pr + PC_CQ + 8 * F.lane), b = *(const GAS v4u*)(pr + PC_CQ + 512 + 8 * F.lane);
            float v[16] = {bfl(a.x), bfh(a.x), bfl(a.y), bfh(a.y), bfl(a.z), bfh(a.z), bfl(a.w), bfh(a.w), bfl(b.x), bfh(b.x), bfl(b.y), bfh(b.y), bfl(b.z), bfh(b.z), bfl(b.w), bfh(b.w)};
            float s = 0.f;
#pragma unroll
            for (int j = 0; j < 16; ++j) s += v[j] * v[j];
            const float rstd = 1.0f / sqrtf(wave_sum(s) * (1.f / 1024.f) + RMS_EPS);
            const f32x4 g0 = *(const GAS f32x4*)(gq + 8 * F.lane), g1 = *(const GAS f32x4*)(gq + 8 * F.lane + 4), g2 = *(const GAS f32x4*)(gq + 512 + 8 * F.lane), g3 = *(const GAS f32x4*)(gq + 512 + 8 * F.lane + 4);
            v4u o0, o1;
            o0.x = pk2(v[0] * rstd * g0.x, v[1] * rstd * g0.y); o0.y = pk2(v[2] * rstd * g0.z, v[3] * rstd * g0.w); o0.z = pk2(v[4] * rstd * g1.x, v[5] * rstd * g1.y); o0.w = pk2(v[6] * rstd * g1.z, v[7] * rstd * g1.w);
            o1.x = pk2(v[8] * rstd * g2.x, v[9] * rstd * g2.y); o1.y = pk2(v[10] * rstd * g2.z, v[11] * rstd * g2.w); o1.z = pk2(v[12] * rstd * g3.x, v[13] * rstd * g3.y); o1.w = pk2(v[14] * rstd * g3.z, v[15] * rstd * g3.w);
            *(GAS v4u*)(CQN + (size_t)m * 1024 + 8 * F.lane) = o0; *(GAS v4u*)(CQN + (size_t)m * 1024 + 512 + 8 * F.lane) = o1;
        }
        {
            const v4u a = *(const GAS v4u*)(pr + PC_CKV + 8 * F.lane);
            float v[8] = {bfl(a.x), bfh(a.x), bfl(a.y), bfh(a.y), bfl(a.z), bfh(a.z), bfl(a.w), bfh(a.w)};
            float s = 0.f;
#pragma unroll
            for (int j = 0; j < 8; ++j) s += v[j] * v[j];
            const float rstd = 1.0f / sqrtf(wave_sum(s) * (1.f / 512.f) + RMS_EPS);
            const f32x4 g0 = *(const GAS f32x4*)(gkv + 8 * F.lane), g1 = *(const GAS f32x4*)(gkv + 8 * F.lane + 4);
            v4u o0;
            o0.x = pk2(v[0] * rstd * g0.x, v[1] * rstd * g0.y); o0.y = pk2(v[2] * rstd * g0.z, v[3] * rstd * g0.w); o0.z = pk2(v[4] * rstd * g1.x, v[5] * rstd * g1.y); o0.w = pk2(v[6] * rstd * g1.z, v[7] * rstd * g1.w);
            *(GAS v4u*)(CKVN + (size_t)m * 512 + 8 * F.lane) = o0;
        }
        const float* mr = misc + (size_t)m * 256;
        if (F.lane < 32) { const int i = F.lane; const float x1 = mr[i], x2 = mr[32 + i], c = cs[(size_t)m * 32 + i], s = sn[(size_t)m * 32 + i];
            *(GAS unsigned*)(KR + (size_t)m * 64 + 2 * i) = pk2(x1 * c - x2 * s, x2 * c + x1 * s); }
        else if (F.lane < 40) { const int h = F.lane - 32; const float z = mr[64 + h] + bf[h];
            LF[(size_t)m * 8 + h] = fminf(z, 0.f) - log1pf(expf(-fabsf(z))); }
    }
}
__device__ __forceinline__ void fox_scan(Frame& F, const PA& A, const int sw) {
    const int gw = sw * NWAVES + F.wave;
    const int b = gw >> 3, h = gw & 7;
    const float* LF = (const float*)(A.ws + WS_LF) + ((size_t)b * SEQ + 32 * F.lane) * 8 + h; float* FC = (float*)(A.ws + WS_FC) + ((size_t)b * SEQ + 32 * F.lane) * 8 + h;
    float v[32]; float run = 0.f;
#pragma unroll
    for (int j = 0; j < 32; ++j) { run += LF[j * 8]; v[j] = run; }
    float incl = run;
#pragma unroll
    for (int o = 1; o < 64; o <<= 1) { const float t = __shfl_up(incl, o); if (F.lane >= o) incl += t; }
    const float excl = incl - run;
#pragma unroll
    for (int j = 0; j < 32; ++j) FC[j * 8] = v[j] + excl;
}

template <int TYPE>
__device__ __forceinline__ void naive_attn_unit(const PA& A, int l, int m, int head, LAS float* qs, LAS float* sc, int lane) {
    constexpr int DK = TYPE == 0 ? 192 : 128;
    const int b = m / SEQ, t = m - b * SEQ;
    const bf16* P = (const bf16*)(A.ws + WS_PB);
    const float scale = TYPE == 0 ? 0.07216878364870323f : 0.08838834764831845f;
    if (TYPE == 0) { const bf16* qn = (const bf16*)(A.ws + WS_QN) + (size_t)m * 1024 + 128 * head; const bf16* qr = (const bf16*)(A.ws + WS_QR) + (size_t)m * 512 + 64 * head;
        qs[lane] = bfl((unsigned)qn[lane]) * scale; qs[64 + lane] = bfl((unsigned)qn[64 + lane]) * scale; qs[128 + lane] = bfl((unsigned)qr[lane]) * scale; }
    else { const bf16* q = P + (size_t)m * NINP + (TYPE == 1 ? PC_QSWA : PC_QFOX) + 128 * head; qs[lane] = bfl((unsigned)q[lane]) * scale; qs[64 + lane] = bfl((unsigned)q[64 + lane]) * scale; }
    LDS_WAIT(); asm volatile("" ::: "memory");
    const int s_lo = TYPE == 1 ? (t >= 127 ? t - 127 : 0) : 0;
    const int nk = t - s_lo + 1;
    const float slope = TYPE == 1 ? exp2f(-8.0f * (float)(head + 1) / 16.0f) : 0.f;
    const float sink = TYPE == 1 ? A.swa_sinks[l * 16 + head] : 0.f;
    const float* FC = (const float*)(A.ws + WS_FC);
    float mx = -3.0e38f;
    for (int i = lane; i < nk; i += 64) {
        const int s = s_lo + i; const size_t row = (size_t)b * SEQ + s;
        float dot = 0.f;
        if (TYPE == 0) {
            const bf16* kn = (const bf16*)(A.ws + WS_KN) + row * 1024 + 128 * head; const bf16* kr = (const bf16*)(A.ws + WS_KR) + row * 64;
            for (int d = 0; d < 128; d += 8) { const v4u w = *(const GAS v4u*)(kn + d); const LAS float* q = qs + d;
                dot += q[0] * bfl(w.x) + q[1] * bfh(w.x) + q[2] * bfl(w.y) + q[3] * bfh(w.y) + q[4] * bfl(w.z) + q[5] * bfh(w.z) + q[6] * bfl(w.w) + q[7] * bfh(w.w); }
            for (int d = 0; d < 64; d += 8) { const v4u w = *(const GAS v4u*)(kr + d); const LAS float* q = qs + 128 + d;
                dot += q[0] * bfl(w.x) + q[1] * bfh(w.x) + q[2] * bfl(w.y) + q[3] * bfh(w.y) + q[4] * bfl(w.z) + q[5] * bfh(w.z) + q[6] * bfl(w.w) + q[7] * bfh(w.w); }
        } else {
            const bf16* k = P + row * NINP + (TYPE == 1 ? PC_KSWA + 128 * (head >> 3) : PC_KFOX + 128 * head);
            for (int d = 0; d < 128; d += 8) { const v4u w = *(const GAS v4u*)(k + d); const LAS float* q = qs + d;
                dot += q[0] * bfl(w.x) + q[1] * bfh(w.x) + q[2] * bfl(w.y) + q[3] * bfh(w.y) + q[4] * bfl(w.z) + q[5] * bfh(w.z) + q[6] * bfl(w.w) + q[7] * bfh(w.w); }
            if (TYPE == 1) dot -= slope * (float)(A.pos[m] - A.pos[row]);
            if (TYPE == 2) dot += FC[(size_t)m * 8 + head] - FC[row * 8 + head];
        }
        sc[i] = dot; mx = fmaxf(mx, dot);
    }
    mx = wave_max(mx); if (TYPE == 1) mx = fmaxf(mx, sink);
    float sum = 0.f;
    for (int i = lane; i < nk; i += 64) { const float e = __expf(sc[i] - mx); sc[i] = e; sum += e; }
    sum = wave_sum(sum); if (TYPE == 1) sum += __expf(sink - mx);
    LDS_WAIT(); asm volatile("" ::: "memory");
    const bf16* vbase; int ldv;
    if (TYPE == 0) { vbase = (const bf16*)(A.ws + WS_VM) + 128 * head; ldv = 1024; } else if (TYPE == 1) { vbase = P + PC_VSWA + 128 * (head >> 3); ldv = NINP; } else { vbase = P + PC_VFOX + 128 * head; ldv = NINP; }
    vbase += ((size_t)b * SEQ + s_lo) * ldv + 2 * lane;
    float o0 = 0.f, o1 = 0.f;
    int i = 0;
    for (; i + 4 <= nk; i += 4) {
        const unsigned w0 = *(const GAS unsigned*)(vbase + (size_t)(i + 0) * ldv), w1 = *(const GAS unsigned*)(vbase + (size_t)(i + 1) * ldv), w2 = *(const GAS unsigned*)(vbase + (size_t)(i + 2) * ldv), w3 = *(const GAS unsigned*)(vbase + (size_t)(i + 3) * ldv);
        const float p0 = sc[i], p1 = sc[i + 1], p2 = sc[i + 2], p3 = sc[i + 3];
        o0 += p0 * bfl(w0) + p1 * bfl(w1) + p2 * bfl(w2) + p3 * bfl(w3); o1 += p0 * bfh(w0) + p1 * bfh(w1) + p2 * bfh(w2) + p3 * bfh(w3);
    }
    for (; i < nk; ++i) { const unsigned w0 = *(const GAS unsigned*)(vbase + (size_t)i * ldv); const float p0 = sc[i]; o0 += p0 * bfl(w0); o1 += p0 * bfh(w0); }
    const float inv = 1.0f / sum;
    bf16* op = (bf16*)(A.ws + WS_OM) + (size_t)m * DM + (TYPE == 0 ? 0 : TYPE == 1 ? 1024 : 3072) + 128 * head;
    *(GAS unsigned*)(op + 2 * lane) = pk2(o0 * inv, o1 * inv);
    LDS_WAIT(); asm volatile("" ::: "memory");
}
__device__ __forceinline__ void naive_attn_phase(Frame& F, const PA& A, int l) {
    LAS float* qs = (LAS float*)(F.lds + RING_OFF + F.wave * 9216); LAS float* sc = qs + 256;
    const int gw = A.vcu * NWAVES + F.wave, NGW = A.G * NWAVES;
    for (int u = gw; u < M * 32; u += NGW) {
        const int head = (u + (u >> 11)) & 31, m = u >> 5;
        if (head < 8) { if (!(ATT_MFMA_TYPES & 1)) naive_attn_unit<0>(A, l, m, head, qs, sc, F.lane); }
        else if (head < 24) { if (!(ATT_MFMA_TYPES & 2)) naive_attn_unit<1>(A, l, m, head - 8, qs, sc, F.lane); }
        else { if (!(ATT_MFMA_TYPES & 4)) naive_attn_unit<2>(A, l, m, head - 24, qs, sc, F.lane); }
    }
}


namespace att {
typedef short bf16x8 __attribute__((ext_vector_type(8)));
typedef short s16x4 __attribute__((ext_vector_type(4)));
typedef float f32x16 __attribute__((ext_vector_type(16)));
typedef unsigned u32x4 __attribute__((ext_vector_type(4)));
constexpr int KVBLK = 64, QBLK = 32, SHM_V = 16384, SHM_K = 16384, SHM_KR = 8192;
constexpr int NSLOT = 3;
constexpr int L_V = 0, L_K = NSLOT * SHM_V, L_KR = L_K + NSLOT * SHM_K, L_KB = L_KR + NSLOT * SHM_KR, L_WS = L_KB + NSLOT * 256, L_END = L_WS + 8 * 256;
static_assert(L_END <= RING_BYTES, "attention LDS fits the ring region");
#define ATT_KSWZ(row, colB) ((row) * 256 + ((colB) ^ (((row) & 7) << 4)))
#define ATT_KRSWZ(row, colB) ((row) * 128 + ((colB) ^ (((row) & 7) << 4)))
#define ATT_SBAR() __builtin_amdgcn_sched_barrier(0)
__device__ __forceinline__ int v_st(int k, int c) { const int kk = (k & ~0xC) | ((k & 4) << 1) | ((k & 8) >> 1); return ((kk >> 3) * 4 + (c >> 5)) * 512 + ((kk & 7) * 32 + (c & 31)) * 2; }
__device__ __forceinline__ int v_rd_base(int lane) { return ((lane & 3) << 3) | (((lane >> 2) & 3) << 6) | (((lane >> 4) & 1) << 5) | (((lane >> 5) & 1) << 8); }
__device__ __forceinline__ int crow(int r, int hi) { return (r & 3) + 8 * (r >> 2) + 4 * hi; }
__device__ __forceinline__ unsigned cvtpk(float lo, float hi) { unsigned r; asm volatile("v_cvt_pk_bf16_f32 %0, %1, %2" : "=v"(r) : "v"(lo), "v"(hi)); return r; }
__device__ __forceinline__ void mask_tile(f32x16& p0, f32x16& p1, int dq, unsigned W) {
    const float NEG = -__builtin_inff();
#pragma unroll
    for (int r = 0; r < 16; ++r) { const int c = (r & 3) + 8 * (r >> 2);
        if ((unsigned)(dq - c) >= W) p0[r] = NEG;
        if ((unsigned)(dq - c - 32) >= W) p1[r] = NEG; }
}
template <int SC>
__device__ __forceinline__ float softmax_tile(f32x16& p0, f32x16& p1, float& m_reg, float& l_reg, bf16x8& pa0, bf16x8& pa1, bf16x8& pa2, bf16x8& pa3) {
    constexpr float SCALE = SC == 0 ? 0.07216878364870323f : 0.08838834764831845f, C2 = 1.4426950408889634f * SCALE, THR = 8.f;
    float pmax = p0[0];
#pragma unroll
    for (int r = 1; r < 16; ++r) pmax = fmaxf(pmax, p0[r]);
#pragma unroll
    for (int r = 0; r < 16; ++r) pmax = fmaxf(pmax, p1[r]);
    { auto rr = __builtin_amdgcn_permlane32_swap(__float_as_uint(pmax), __float_as_uint(pmax), false, false);
      pmax = fmaxf(__uint_as_float(rr[0]), __uint_as_float(rr[1])); }
    float mn, alpha;
    if (__builtin_expect(__all((pmax - m_reg) * SCALE <= THR), 1)) { mn = m_reg; alpha = 1.f; }
    else { mn = fmaxf(m_reg, pmax); alpha = __builtin_amdgcn_exp2f((m_reg - mn) * C2); m_reg = mn; }
    const float mnL = -mn * C2;
#pragma unroll
    for (int r = 0; r < 16; ++r) { p0[r] = __builtin_amdgcn_exp2f(fmaf(p0[r], C2, mnL)); p1[r] = __builtin_amdgcn_exp2f(fmaf(p1[r], C2, mnL)); }
    float ps = 0.f;
#pragma unroll
    for (int r = 0; r < 16; ++r) ps += p0[r] + p1[r];
    { auto rr = __builtin_amdgcn_permlane32_swap(__float_as_uint(ps), __float_as_uint(ps), false, false);
      ps = __uint_as_float(rr[0]) + __uint_as_float(rr[1]); }
    l_reg = l_reg * alpha + ps;
#define ATT_PK4(P, B_, OUT) do { unsigned a0 = cvtpk(P[B_+0], P[B_+1]), a1 = cvtpk(P[B_+2], P[B_+3]);                          \
        unsigned b0 = cvtpk(P[B_+4], P[B_+5]), b1 = cvtpk(P[B_+6], P[B_+7]);                                             \
        auto r0 = __builtin_amdgcn_permlane32_swap(a0, b0, false, false); auto r1 = __builtin_amdgcn_permlane32_swap(a1, b1, false, false); \
        u32x4 w = {r0[0], r1[0], r0[1], r1[1]}; OUT = __builtin_bit_cast(bf16x8, w); } while (0)
    ATT_PK4(p0, 0, pa0); ATT_PK4(p0, 8, pa1); ATT_PK4(p1, 0, pa2); ATT_PK4(p1, 8, pa3);
#undef ATT_PK4
    return alpha;
}
template <bool ROPE, bool BIAS>
__device__ __forceinline__ void qkt(f32x16& p0, f32x16& p1, LAS const char* lds, int buf, int r32, int hi, const bf16x8* qr, const bf16x8* qrr, float kbmul, float kbadd) {
    if (BIAS) { LAS const float* kb = (LAS const float*)(lds + L_KB + buf * 256) + 4 * hi;
#pragma unroll
        for (int g = 0; g < 4; ++g) { const f32x4 a = *(LAS const f32x4*)(kb + 8 * g) * kbmul + kbadd, b = *(LAS const f32x4*)(kb + 32 + 8 * g) * kbmul + kbadd;
            p0[4 * g] = a[0]; p0[4 * g + 1] = a[1]; p0[4 * g + 2] = a[2]; p0[4 * g + 3] = a[3]; p1[4 * g] = b[0]; p1[4 * g + 1] = b[1]; p1[4 * g + 2] = b[2]; p1[4 * g + 3] = b[3]; } }
    else { p0 = f32x16{}; p1 = f32x16{}; }
    LAS const char* kbase = lds + L_K + buf * SHM_K;
#pragma unroll
    for (int d0 = 0; d0 < 8; ++d0) { LAS const char* a = kbase + ATT_KSWZ(r32, ((d0 & 3) * 16 + hi * 8) * 2) + (d0 >> 2) * 128;
        const bf16x8 b0 = *(LAS const bf16x8*)a, b1 = *(LAS const bf16x8*)(a + 32 * 256);
        p0 = __builtin_amdgcn_mfma_f32_32x32x16_bf16(b0, qr[d0], p0, 0, 0, 0);
        p1 = __builtin_amdgcn_mfma_f32_32x32x16_bf16(b1, qr[d0], p1, 0, 0, 0); }
    if (ROPE) { LAS const char* rbase = lds + L_KR + buf * SHM_KR;
#pragma unroll
        for (int d0 = 0; d0 < 4; ++d0) { LAS const char* a = rbase + ATT_KRSWZ(r32, (d0 * 16 + hi * 8) * 2);
            const bf16x8 b0 = *(LAS const bf16x8*)a, b1 = *(LAS const bf16x8*)(a + 32 * 128);
            p0 = __builtin_amdgcn_mfma_f32_32x32x16_bf16(b0, qrr[d0], p0, 0, 0, 0);
            p1 = __builtin_amdgcn_mfma_f32_32x32x16_bf16(b1, qrr[d0], p1, 0, 0, 0); } }
}
__device__ __forceinline__ void pv_tile(f32x16* o, int vb, bf16x8 pa0, bf16x8 pa1, bf16x8 pa2, bf16x8 pa3) {
#define ATT_TRRD(dst, off) asm volatile("ds_read_b64_tr_b16 %0, %1 offset:%2" : "=&v"(dst) : "v"(vb), "i"(off) : "memory")
#define ATT_PV_D0(d0) do { s16x4 l0, l1, l2, l3, h0, h1, h2, h3; constexpr int b_ = (d0) * 512;   \
        ATT_TRRD(l0, b_); ATT_TRRD(h0, b_ + 2048); ATT_TRRD(l1, b_ + 4096); ATT_TRRD(h1, b_ + 6144); ATT_TRRD(l2, b_ + 8192); ATT_TRRD(h2, b_ + 10240); ATT_TRRD(l3, b_ + 12288); ATT_TRRD(h3, b_ + 14336); \
        asm volatile("s_waitcnt lgkmcnt(0)" ::: "memory"); ATT_SBAR();   \
        o[d0] = __builtin_amdgcn_mfma_f32_32x32x16_bf16((bf16x8){l0[0], l0[1], l0[2], l0[3], h0[0], h0[1], h0[2], h0[3]}, pa0, o[d0], 0, 0, 0);   \
        o[d0] = __builtin_amdgcn_mfma_f32_32x32x16_bf16((bf16x8){l1[0], l1[1], l1[2], l1[3], h1[0], h1[1], h1[2], h1[3]}, pa1, o[d0], 0, 0, 0);   \
        o[d0] = __builtin_amdgcn_mfma_f32_32x32x16_bf16((bf16x8){l2[0], l2[1], l2[2], l2[3], h2[0], h2[1], h2[2], h2[3]}, pa2, o[d0], 0, 0, 0);   \
        o[d0] = __builtin_amdgcn_mfma_f32_32x32x16_bf16((bf16x8){l3[0], l3[1], l3[2], l3[3], h3[0], h3[1], h3[2], h3[3]}, pa3, o[d0], 0, 0, 0); } while (0)
    ATT_PV_D0(0); ATT_PV_D0(1); ATT_PV_D0(2); ATT_PV_D0(3);
#undef ATT_PV_D0
#undef ATT_TRRD
}
template <int TYPE>
__device__ __forceinline__ void attn_unit(LAS char* lds, int tid, const bf16* Qw, int ldq, const bf16* QRw, const bf16* Kh, int ldk, const bf16* KRb, const bf16* Vh, int ldv, bf16* Ow, int ldo,
                                          int qlo, int j_lo, int j_hi, int W, const float* kbp, int kbstride, float kbmul, float kbadd, float sink_raw) {
    constexpr bool ROPE = TYPE == 0, BIAS = TYPE != 0; constexpr int SC = TYPE == 0 ? 0 : 1;
    constexpr float SCALE = SC == 0 ? 0.07216878364870323f : 0.08838834764831845f, C2 = 1.4426950408889634f * SCALE;
    const int wid = __builtin_amdgcn_readfirstlane(tid >> 6), lane = tid & 63, r32 = lane & 31, hi = lane >> 5;
    const int NT = j_hi - j_lo;
    bf16x8 qr[8], qrr[4];
#pragma unroll
    for (int d0 = 0; d0 < 8; ++d0) qr[d0] = *(const GAS bf16x8*)(Qw + (size_t)r32 * ldq + d0 * 16 + hi * 8);
    if (ROPE) {
#pragma unroll
        for (int d0 = 0; d0 < 4; ++d0) qrr[d0] = *(const GAS bf16x8*)(QRw + (size_t)r32 * 512 + d0 * 16 + hi * 8); }
    int kof[2], vof[2], krof = 0, kbof = 0;
#pragma unroll
    for (int i = 0; i < 2; ++i) {
        const int r = (2 * wid + i) * 4 + (lane >> 4), ch = (lane & 15) ^ (r & 7);
        kof[i] = r * ldk + ch * 8;
        const int q = (2 * wid + i) * 64 + lane, blk = q >> 5, qin = q & 31, kk = ((blk >> 2) << 3) | (qin >> 2), c = (blk & 3) * 32 + (qin & 3) * 8;
        const int k = (kk & ~0xC) | ((kk & 4) << 1) | ((kk & 8) >> 1);
        vof[i] = k * ldv + c; }
    if (ROPE) { const int r = wid * 8 + (lane >> 3), ch = (lane & 7) ^ (r & 7); krof = r * 64 + ch * 8; }
    if (BIAS) kbof = lane * kbstride;
#define ATT_DMA(j, s) do { const size_t k0_ = (size_t)(j) * KVBLK;                                                                                          \
        _Pragma("unroll") for (int i = 0; i < 2; ++i)                                                                                                      \
            __builtin_amdgcn_global_load_lds((const unsigned*)(Kh + k0_ * ldk + kof[i]), (LAS unsigned*)(lds + L_K + (s) * SHM_K + (2 * wid + i) * 1024), 16, 0, 0);   \
        _Pragma("unroll") for (int i = 0; i < 2; ++i)                                                                                                      \
            __builtin_amdgcn_global_load_lds((const unsigned*)(Vh + k0_ * ldv + vof[i]), (LAS unsigned*)(lds + L_V + (s) * SHM_V + (2 * wid + i) * 1024), 16, 0, 0);   \
        if (ROPE) __builtin_amdgcn_global_load_lds((const unsigned*)(KRb + k0_ * 64 + krof), (LAS unsigned*)(lds + L_KR + (s) * SHM_KR + wid * 1024), 16, 0, 0);         \
        if (BIAS) __builtin_amdgcn_global_load_lds((const unsigned*)(kbp + k0_ * kbstride + kbof), (LAS unsigned*)(lds + L_KB + (s) * 256), 4, 0, 0); } while (0)
    float m_reg = -1e30f, l_reg = 0.f; f32x16 o[4] = {};
    const int vb0 = (int)(unsigned)(size_t)(lds + L_V) + v_rd_base(lane);
    const int qm = qlo + r32 - 4 * hi;
    ATT_DMA(j_lo, 0);
    asm volatile("s_waitcnt vmcnt(0)" ::: "memory");
#pragma unroll
    for (int d0 = 0; d0 < 8; ++d0) asm volatile("" : "+v"(qr[d0]));
    if (ROPE) {
#pragma unroll
        for (int d0 = 0; d0 < 4; ++d0) asm volatile("" : "+v"(qrr[d0])); }
    __builtin_amdgcn_s_barrier(); asm volatile("" ::: "memory");
    if (NT > 1) { ATT_DMA(j_lo + 1, 1); }
    int s0 = 0, s1 = 1, s2 = 2;
    for (int t = 0; t < NT; ++t) {
        const int kb_ = (j_lo + t) * KVBLK;
        if (t + 2 < NT) { ATT_DMA(j_lo + t + 2, s2); }
        ATT_SBAR();
        const bool act = kb_ <= qlo + QBLK - 1 && kb_ + KVBLK - 1 >= qlo - W + 1;
        if (act) {
            f32x16 p0, p1; bf16x8 pa0, pa1, pa2, pa3;
            qkt<ROPE, BIAS>(p0, p1, lds, s0, r32, hi, qr, qrr, kbmul, kbadd);
            if (kb_ + KVBLK - 1 > qlo || kb_ <= qlo + QBLK - 1 - W) mask_tile(p0, p1, qm - kb_, (unsigned)W);
            const float alpha = softmax_tile<SC>(p0, p1, m_reg, l_reg, pa0, pa1, pa2, pa3);
            if (__any(alpha < 1.f)) {
#pragma unroll
                for (int d_ = 0; d_ < 4; ++d_)
#pragma unroll
                    for (int r = 0; r < 16; ++r) o[d_][r] *= alpha; }
            pv_tile(o, vb0 + s0 * SHM_V, pa0, pa1, pa2, pa3);
        }
        ATT_SBAR();
        if (t + 2 < NT) asm volatile("s_waitcnt vmcnt(5)" ::: "memory"); else asm volatile("s_waitcnt vmcnt(0)" ::: "memory");
        asm volatile("s_waitcnt lgkmcnt(0)" ::: "memory"); __builtin_amdgcn_s_barrier(); asm volatile("" ::: "memory");
        { const int x = s0; s0 = s1; s1 = s2; s2 = x; }
    }
    if (TYPE == 1) l_reg += __builtin_amdgcn_exp2f((sink_raw - m_reg) * C2);
    const float rl = __builtin_amdgcn_rcpf(l_reg);
    bf16* orow = Ow + (size_t)r32 * ldo + 8 * hi;
#pragma unroll
    for (int d0 = 0; d0 < 4; ++d0)
#pragma unroll
        for (int gp = 0; gp < 2; ++gp) { const int ra = 8 * gp, rb = 8 * gp + 4;
            const unsigned a0 = cvtpk(o[d0][ra] * rl, o[d0][ra + 1] * rl), a1 = cvtpk(o[d0][ra + 2] * rl, o[d0][ra + 3] * rl), b0 = cvtpk(o[d0][rb] * rl, o[d0][rb + 1] * rl), b1 = cvtpk(o[d0][rb + 2] * rl, o[d0][rb + 3] * rl);
            auto r0 = __builtin_amdgcn_permlane32_swap(a0, b0, false, false); auto r1 = __builtin_amdgcn_permlane32_swap(a1, b1, false, false);
            const u32x4 w = {r0[0], r1[0], r0[1], r1[1]};
            *(GAS u32x4*)(orow + d0 * 32 + 16 * gp) = w; }
#undef ATT_DMA
}
}

template <int ST>
__device__ __forceinline__ void attn_stage(Frame& F, const PA& A, int l) {
    LAS char* lds = (LAS char*)(F.lds + RING_OFF);
    const bf16* P = (const bf16*)(A.ws + WS_PB);
    const int wid = F.wave;
    if constexpr (ST == 0 && (ATT_MFMA_TYPES & 1) != 0)
    for (int item = A.vcu; item < NBATCH * 8 * 4; item += A.G) {
        const int b = item >> 5, h = (item >> 2) & 7, pr = item & 3;
#pragma unroll 1
        for (int pass = 0; pass < 2; ++pass) { const int qb = pass ? 7 - pr : pr; const size_t row0 = (size_t)b * SEQ + qb * 256 + wid * 32;
            att::attn_unit<0>(lds, F.tid, (const bf16*)(A.ws + WS_QN) + row0 * 1024 + 128 * h, 1024, (const bf16*)(A.ws + WS_QR) + row0 * 512 + 64 * h,
                              (const bf16*)(A.ws + WS_KN) + (size_t)b * SEQ * 1024 + 128 * h, 1024, (const bf16*)(A.ws + WS_KR) + (size_t)b * SEQ * 64,
                              (const bf16*)(A.ws + WS_VM) + (size_t)b * SEQ * 1024 + 128 * h, 1024, (bf16*)(A.ws + WS_OM) + row0 * DM + 128 * h, DM,
                              qb * 256 + wid * 32, 0, 4 * (qb + 1), SEQ, nullptr, 0, 0.f, 0.f, 0.f); }
    }
    if constexpr (ST == 1 && (ATT_MFMA_TYPES & 4) != 0)
    for (int item = A.vcu; item < NBATCH * 8 * 4; item += A.G) {
        const int b = item >> 5, h = (item >> 2) & 7, pr = item & 3;
        const float* FCb = (const float*)(A.ws + WS_FC) + (size_t)b * SEQ * 8 + h;
#pragma unroll 1
        for (int pass = 0; pass < 2; ++pass) { const int qb = pass ? 7 - pr : pr; const size_t row0 = (size_t)b * SEQ + qb * 256 + wid * 32;
            const float fref = FCb[(size_t)(qb * 256) * 8];
            att::attn_unit<2>(lds, F.tid, P + row0 * NINP + PC_QFOX + 128 * h, NINP, nullptr,
                              P + (size_t)b * SEQ * NINP + PC_KFOX + 128 * h, NINP, nullptr,
                              P + (size_t)b * SEQ * NINP + PC_VFOX + 128 * h, NINP, (bf16*)(A.ws + WS_OM) + row0 * DM + 3072 + 128 * h, DM,
                              qb * 256 + wid * 32, 0, 4 * (qb + 1), SEQ, FCb, 8, -11.313708498984761f, fref * 11.313708498984761f, 0.f); }
    }
    if constexpr (ST == 2 && (ATT_MFMA_TYPES & 2) != 0)
    for (int u = A.vcu * 4; u < NBATCH * 2 * 64; u += A.G * 4) {
#pragma unroll 1
        for (int i = 0; i < 4; ++i) { const int uu = u + i, b = uu >> 7, kvh = (uu >> 6) & 1, blk = uu & 63, t0 = blk * 32, hq = kvh * 8 + wid;
            const size_t row0 = (size_t)b * SEQ + t0; const int* posb = A.pos + (size_t)b * SEQ;
            const float slope = exp2f(-0.5f * (float)(hq + 1)); const int pref = posb[t0];
            const int klo = t0 >= 127 ? t0 - 127 : 0;
            const float sink_raw = (A.swa_sinks[l * 16 + hq] + slope * (float)(posb[t0 + (F.lane & 31)] - pref)) * 11.313708498984761f;
            att::attn_unit<1>(lds, F.tid, P + row0 * NINP + PC_QSWA + 128 * hq, NINP, nullptr,
                              P + (size_t)b * SEQ * NINP + PC_KSWA + 128 * kvh, NINP, nullptr,
                              P + (size_t)b * SEQ * NINP + PC_VSWA + 128 * kvh, NINP, (bf16*)(A.ws + WS_OM) + row0 * DM + 1024 + 128 * hq, DM,
                              t0, klo >> 6, ((t0 + 31) >> 6) + 1, 128, (const float*)(A.ws + WS_POSF) + (size_t)b * SEQ, 1, slope * 11.313708498984761f, -(float)pref * slope * 11.313708498984761f, sink_raw); }
    }
}
__device__ __forceinline__ void load_rs_table(Frame& F, const PA& A) {
    static_assert(M / 256 == 64, "row-panel ownership of StaticOrder");
    LAS float* rsl = (LAS float*)(F.lds + RS_OFF); const float* rsg = (const float*)(A.ws + WS_RS) + 2048 * (A.bx & 7);
    for (int i = F.tid; i < 2048; i += NWAVES * 64) rsl[i] = rsg[i];
    __syncthreads();
}
constexpr int PH_PER_LAYER = 10, N_PHASES = 1 + DEPTH * PH_PER_LAYER;
#ifndef PHMASK
#define PHMASK 0x7ff
#endif
__device__ __forceinline__ Frame make_frame(LAS unsigned char* lds) {
    Frame F; F.lds = lds; int t = threadIdx.x; asm volatile("" : "+v"(t)); F.tid = t; F.lane = t & 63; F.wave = __builtin_amdgcn_readfirstlane(t >> 6); return F;
}
#define IN(k) (((PHMASK >> ((k) == 0 ? 10 : ((k) - 1) % PH_PER_LAYER)) & 1) && lo <= (k) && (k) < hi)
#define SEAM(k) do { if (IN(k) && IN((k) + 1)) { if (!MK_PER_PHASE) xcd_barrier(bar); } } while (0)
#define WSP(T, off) ((T)(A.ws + (off)))
#define PHASE_BEGIN const PA A = load_args(argw); Frame F = make_frame(ldsb)
template <int l>
__device__ __forceinline__ void layer_phases(LAS unsigned char* ldsb, const LAS unsigned* argw, const XcdBarrier& bar, const int lo, const int hi) {
        constexpr int pb = 1 + l * PH_PER_LAYER;
        if (IN(pb + 0)) {
            PHASE_BEGIN; unsigned char* wl = A.ws + WS_W + (size_t)l * WL_SIZE; load_rs_table(F, A);
            pg8::Gemm g{WSP(const bf16*, WS_HB), (const bf16*)(wl + WL_WIN), M, NIN, DM}; pg8::StaticOrder S; S.init(M, NIN, A.G, A.bx);
            pg8::EpiInproj E{WSP(bf16*, WS_PB), WSP(float*, WS_MISC), NINP, GATE_TILE0, WSP(bf16*, WS_GT), (const LAS float*)(F.lds + RS_OFF), (int)((size_t)3 * M * DM * 2)};
            if constexpr (l == 0 && CONV_IN_GEMM) {
                const int rc = 1 + (A.vcu % 18);
                { pg8::RangeOrder R{S, 0, rc}; pg8::gemm_phase<pg8::EpiInproj, pg8::RangeOrder, true, true>(F.lds + RING_OFF, g, R, E); }
                __syncthreads();
                { const PA A2 = load_args(argw); Frame F2 = make_frame(ldsb); convert_items(F2, A2, 1); }
                __syncthreads();
                { pg8::RangeOrder R{S, rc, 1 << 30}; pg8::gemm_phase<pg8::EpiInproj, pg8::RangeOrder, true, true>(F.lds + RING_OFF, g, R, E); }
            } else {
                pg8::RangeOrder R{S, 0, S.nwg / A.G}; pg8::gemm_phase<pg8::EpiInproj, pg8::RangeOrder, true, true>(F.lds + RING_OFF, g, R, E); }
        }
#if PROBE_REPEAT & 4
        if (IN(pb + 0)) {
            __syncthreads(); PHASE_BEGIN; unsigned char* wl = A.ws + WS_W + (size_t)l * WL_SIZE; load_rs_table(F, A);
            pg8::Gemm g{WSP(const bf16*, WS_HB), (const bf16*)(wl + WL_WIN), M, NIN, DM}; pg8::StaticOrder S; S.init(M, NIN, A.G, A.bx);
            pg8::EpiInproj E{WSP(bf16*, WS_PB), WSP(float*, WS_MISC), NINP, GATE_TILE0, WSP(bf16*, WS_GT), (const LAS float*)(F.lds + RS_OFF), (int)((size_t)3 * M * DM * 2)};
            pg8::gemm_phase<pg8::EpiInproj, pg8::StaticOrder, true, true>(F.lds + RING_OFF, g, S, E);
        }
#endif
        SEAM(pb + 0);
        if (IN(pb + 1)) { PHASE_BEGIN; mla_prep_rows(F, A, l, A.vcu * NWAVES + F.wave, A.G * NWAVES); }
        SEAM(pb + 1);
        if (IN(pb + 2)) {
            int left; { PHASE_BEGIN; pg8::StaticOrder S; S.init(M, NIN, A.G, A.bx); left = CONV_IN_GEMM ? 0 : S.nwg % A.G; }
            static_assert(((M / 256) * (NIN / 256) / 256 * 256 / 8) / 8 >= GATE_TILE0, "the deferred units (grid of 256) must be gate tiles: nothing before L.4 reads them");
            bool mine; { PHASE_BEGIN; mine = A.bx < left; }
            if (mine) {
                PHASE_BEGIN; unsigned char* wl = A.ws + WS_W + (size_t)l * WL_SIZE; load_rs_table(F, A);
                pg8::Gemm g{WSP(const bf16*, WS_HB), (const bf16*)(wl + WL_WIN), M, NIN, DM}; pg8::StaticOrder S; S.init(M, NIN, A.G, A.bx);
                pg8::EpiInproj E{WSP(bf16*, WS_PB), WSP(float*, WS_MISC), NINP, GATE_TILE0, WSP(bf16*, WS_GT), (const LAS float*)(F.lds + RS_OFF), (int)((size_t)3 * M * DM * 2)};
                pg8::RangeOrder R{S, S.nwg / A.G, 1 << 30}; pg8::gemm_phase<pg8::EpiInproj, pg8::RangeOrder, true, true>(F.lds + RING_OFF, g, R, E);
            } else {
                { PHASE_BEGIN; const int nn = A.G - left, c = A.bx - left; for (int sw = c - (nn > NBATCH ? nn - NBATCH : 0); sw < NBATCH; sw += nn) if (sw >= 0) fox_scan(F, A, sw); }
                { PHASE_BEGIN; unsigned char* wl = A.ws + WS_W + (size_t)l * WL_SIZE;
                  pg8::Gemm g{WSP(const bf16*, WS_CQN), (const bf16*)(wl + WL_WUQ), M, 1536, 1024}; pg8::StaticOrder S; S.init(M, 1536, A.G - left, A.bx - left);
                  pg8::EpiQup E{WSP(bf16*, WS_QN), WSP(bf16*, WS_QR), WSP(const float*, WS_ROPE), WSP(const float*, WS_ROPE) + (size_t)M * 32};
                  pg8::gemm_phase<pg8::EpiQup, pg8::StaticOrder, true, true>(F.lds + RING_OFF, g, S, E); }
                __syncthreads();
                { PHASE_BEGIN; unsigned char* wl = A.ws + WS_W + (size_t)l * WL_SIZE;
                  pg8::Gemm g{WSP(const bf16*, WS_CKVN), (const bf16*)(wl + WL_WUKV), M, 2048, 512}; pg8::StaticOrder S; S.init(M, 2048, A.G - left, A.bx - left);
                  pg8::EpiSplitBf16 E{WSP(bf16*, WS_KN), WSP(bf16*, WS_VM), 4, 1024};
                  pg8::gemm_phase<pg8::EpiSplitBf16, pg8::StaticOrder, true, true>(F.lds + RING_OFF, g, S, E); }
            }
        }
        SEAM(pb + 2);
        if (IN(pb + 3)) {
            if (ATT_MFMA_TYPES != 0) {
                constexpr int cvl = l == 0 ? cv::O_B : cv::I_LAYER + cv::O_B, cvh = l == 0 ? cv::I_LAYER + cv::O_B : DEPTH * cv::I_LAYER;
#define CONV_SLOT(k) if (CONV_UNDER_ATTN && !CONV_IN_GEMM) { PHASE_BEGIN; if (((A.bx >> 3) & 3) == (k)) { __syncthreads(); convert_span(F, A, cvl, cvh, A.vcu * NWAVES + F.wave, A.G * NWAVES); __syncthreads(); } }
                CONV_SLOT(0) { PHASE_BEGIN; attn_stage<0>(F, A, l); }
                CONV_SLOT(1) { PHASE_BEGIN; attn_stage<1>(F, A, l); }
                CONV_SLOT(2) { PHASE_BEGIN; attn_stage<2>(F, A, l); }
                CONV_SLOT(3)
#undef CONV_SLOT
            }
#if PROBE_REPEAT & 1
            { __syncthreads(); { PHASE_BEGIN; attn_stage<0>(F, A, l); } { PHASE_BEGIN; attn_stage<1>(F, A, l); } { PHASE_BEGIN; attn_stage<2>(F, A, l); } }
#endif
            if (ATT_MFMA_TYPES != 7) { __syncthreads(); PHASE_BEGIN; naive_attn_phase(F, A, l); }
        }
        SEAM(pb + 3);
        if (IN(pb + 4)) {
            PHASE_BEGIN; const bf16* WB = (const bf16*)(A.ws + WS_W + (size_t)l * WL_SIZE + WL_WB);
            pg8::Gemm g{WSP(const bf16*, WS_OM), WB, M, DM, DM}; pg8::StaticOrder S; S.init(M, DM, A.G, A.bx);
            pg8::EpiBranchFused E{WSP(const bf16*, WS_GT), WSP(bf16*, WS_MRG), DM};
            pg8::gemm_phase<pg8::EpiBranchFused, pg8::StaticOrder, true, true>(F.lds + RING_OFF, g, S, E);
        }
#if PROBE_REPEAT & 128
        __syncthreads();
        if (IN(pb + 4)) {
            PHASE_BEGIN; const bf16* WB = (const bf16*)(A.ws + WS_W + (size_t)l * WL_SIZE + WL_WB);
            pg8::Gemm g{WSP(const bf16*, WS_OM), WB, M, DM, DM}; pg8::StaticOrder S; S.init(M, DM, A.G, A.bx);
            pg8::EpiBranchFused E{WSP(const bf16*, WS_GT), WSP(bf16*, WS_MRG), DM};
            pg8::gemm_phase<pg8::EpiBranchFused, pg8::StaticOrder, true, true>(F.lds + RING_OFF, g, S, E);
        }
#endif
        SEAM(pb + 4);
        if (IN(pb + 5)) {
            PHASE_BEGIN; unsigned char* wl = A.ws + WS_W + (size_t)l * WL_SIZE;
            pg8::Gemm g{WSP(const bf16*, WS_MRG), (const bf16*)(wl + WL_WOUT), M, DM, DM}; pg8::StaticOrder S; S.init(M, DM, A.G, A.bx);
            pg8::EpiSplitBf16 E{WSP(bf16*, WS_TM), WSP(bf16*, WS_TM), 1 << 30, DM};
            pg8::gemm_phase<pg8::EpiSplitBf16, pg8::StaticOrder, true, true>(F.lds + RING_OFF, g, S, E);
        }
#if PROBE_REPEAT & 256
        __syncthreads();
        if (IN(pb + 5)) {
            PHASE_BEGIN; unsigned char* wl = A.ws + WS_W + (size_t)l * WL_SIZE;
            pg8::Gemm g{WSP(const bf16*, WS_MRG), (const bf16*)(wl + WL_WOUT), M, DM, DM}; pg8::StaticOrder S; S.init(M, DM, A.G, A.bx);
            pg8::EpiSplitBf16 E{WSP(bf16*, WS_TM), WSP(bf16*, WS_TM), 1 << 30, DM};
            pg8::gemm_phase<pg8::EpiSplitBf16, pg8::StaticOrder, true, true>(F.lds + RING_OFF, g, S, E);
        }
#endif
        SEAM(pb + 5);
        if (IN(pb + 6)) { PHASE_BEGIN; resid_rows(F, A, WSP(bf16*, WS_HB), WSP(const bf16*, WS_TM), A.g_mix_post + (size_t)l * DM, WSP(float*, WS_RS), nullptr); }
        SEAM(pb + 6);
        if (IN(pb + 7)) {
            PHASE_BEGIN; unsigned char* wl = A.ws + WS_W + (size_t)l * WL_SIZE; load_rs_table(F, A);
            pg8::Gemm g{WSP(const bf16*, WS_HB), (const bf16*)(wl + WL_WGU), M, 2 * FF, DM}; pg8::StaticOrder S; S.init(M, 2 * FF, A.G, A.bx);
            pg8::EpiSwiglu E{WSP(bf16*, WS_PB), FF, (const LAS float*)(F.lds + RS_OFF)};
            pg8::gemm_phase<pg8::EpiSwiglu, pg8::StaticOrder, true, true>(F.lds + RING_OFF, g, S, E);
        }
#if PROBE_REPEAT & 32
        if (IN(pb + 7)) {
            __syncthreads(); PHASE_BEGIN; unsigned char* wl = A.ws + WS_W + (size_t)l * WL_SIZE; load_rs_table(F, A);
            pg8::Gemm g{WSP(const bf16*, WS_HB), (const bf16*)(wl + WL_WGU), M, 2 * FF, DM}; pg8::StaticOrder S; S.init(M, 2 * FF, A.G, A.bx);
            pg8::EpiSwiglu E{WSP(bf16*, WS_PB), FF, (const LAS float*)(F.lds + RS_OFF)};
            pg8::gemm_phase<pg8::EpiSwiglu, pg8::StaticOrder, true, true>(F.lds + RING_OFF, g, S, E);
        }
#endif
        SEAM(pb + 7);
        if (IN(pb + 8)) {
            PHASE_BEGIN; unsigned char* wl = A.ws + WS_W + (size_t)l * WL_SIZE;
            pg8::Gemm g{WSP(const bf16*, WS_PB), (const bf16*)(wl + WL_WD), M, DM, FF}; pg8::StaticOrder S; S.init(M, DM, A.G, A.bx);
            pg8::EpiSplitBf16 E{WSP(bf16*, WS_TM), WSP(bf16*, WS_TM), 1 << 30, DM};
            pg8::gemm_phase<pg8::EpiSplitBf16, pg8::StaticOrder, true, true>(F.lds + RING_OFF, g, S, E);
        }
#if PROBE_REPEAT & 64
        if (IN(pb + 8)) {
            __syncthreads(); PHASE_BEGIN; unsigned char* wl = A.ws + WS_W + (size_t)l * WL_SIZE;
            pg8::Gemm g{WSP(const bf16*, WS_PB), (const bf16*)(wl + WL_WD), M, DM, FF}; pg8::StaticOrder S; S.init(M, DM, A.G, A.bx);
            pg8::EpiSplitBf16 E{WSP(bf16*, WS_TM), WSP(bf16*, WS_TM), 1 << 30, DM};
            pg8::gemm_phase<pg8::EpiSplitBf16, pg8::StaticOrder, true, true>(F.lds + RING_OFF, g, S, E);
        }
#endif
        SEAM(pb + 8);
        if (IN(pb + 9)) { PHASE_BEGIN;
            resid_rows(F, A, WSP(bf16*, WS_HB), WSP(const bf16*, WS_TM), A.g_ffn_post + (size_t)l * DM, WSP(float*, WS_RS), l + 1 < DEPTH ? (float*)nullptr : A.out); }
        SEAM(pb + 9);
}
__global__ void __launch_bounds__(NWAVES * 64, 2) fwd_kernel(Ptrs A0) {
    extern __shared__ __attribute__((aligned(16))) unsigned char lds[];
    LAS unsigned char* ldsb = (LAS unsigned char*)lds;
    LAS unsigned* argw = (LAS unsigned*)(ldsb + LDSCTL_OFF);
    volatile LAS unsigned* MISC = (volatile LAS unsigned*)(ldsb + MISC_OFF);
    for (int u = threadIdx.x; u < (LDS_BYTES - LDSCTL_OFF) / 4; u += NWAVES * 64) ((LAS unsigned*)(ldsb + LDSCTL_OFF))[u] = 0u;
    __syncthreads();
    if (threadIdx.x == 0) park_args(A0, argw);
    const int lo = A0.ph_lo, hi = A0.ph_hi;
    unsigned* barw = (unsigned*)(A0.ws + WS_CTL) + CW_BAR;
    __syncthreads();
    XcdBarrier bar; bar.bar = barw; bar.x = 0; bar.st = nullptr;
    if (!MK_PER_PHASE) bar = xcd_barrier_post(barw, MISC + 8);

    if (IN(0)) { PHASE_BEGIN; convert_items(F, A, 0); if (!CONV_IN_GEMM) convert_span(F, A, cv::I_IN, CONV_UNDER_ATTN ? cv::O_B : DEPTH * cv::I_LAYER, A.vcu * NWAVES + F.wave, A.G * NWAVES); rope_tables(F, A); x_in_rows(F, A, A.x, WSP(bf16*, WS_HB), WSP(float*, WS_RS)); }
#if PROBE_REPEAT & 8
    if (IN(0)) { for (int rep = 0; rep < 4; ++rep) { __syncthreads(); PHASE_BEGIN; x_in_rows(F, A, A.x, WSP(bf16*, WS_HB), WSP(float*, WS_RS)); } }
#endif
#if PROBE_REPEAT & 16
    if (IN(0)) { for (int rep = 0; rep < 20; ++rep) xcd_barrier(bar); }
#endif
#if PROBE_REPEAT & 2
    if (IN(0)) { __syncthreads(); PHASE_BEGIN; convert_items(F, A, 0); convert_items(F, A, 1); }
#endif
    SEAM(0);
    layer_phases<0>(ldsb, argw, bar, lo, hi);
    layer_phases<1>(ldsb, argw, bar, lo, hi);
    static_assert(DEPTH == 2, "two layers written out");
}
#undef IN
#undef SEAM
#undef WSP
#undef PHASE_BEGIN

extern "C" void kernel_launch(void* const* d_in, const int* in_sizes, int n_in, void* d_out, int out_size, void* d_ws, size_t ws_size, hipStream_t stream) {
    static int grid = 0;
    if (grid == 0) {
        if (n_in != 17 || in_sizes[0] != M * DM || out_size != M * DM || ws_size < WS_END) { fprintf(stderr, "kernel_launch: unexpected shapes (n_in %d, in0 %d, out %d, ws %zu < %zu); nothing launched\n", n_in, n_in > 0 ? in_sizes[0] : -1, out_size, ws_size, (size_t)WS_END); grid = -1; return; }
        int dev = 0, cus = 0, per_cu = 0;
        if (hipGetDevice(&dev) != hipSuccess || hipDeviceGetAttribute(&cus, hipDeviceAttributeMultiprocessorCount, dev) != hipSuccess) { fprintf(stderr, "kernel_launch: device query failed\n"); grid = -1; return; }
        if (hipFuncSetAttribute((const void*)fwd_kernel, hipFuncAttributeMaxDynamicSharedMemorySize, LDS_BYTES) != hipSuccess) { fprintf(stderr, "kernel_launch: hipFuncSetAttribute failed\n"); grid = -1; return; }
        if (hipOccupancyMaxActiveBlocksPerMultiprocessor(&per_cu, (const void*)fwd_kernel, NWAVES * 64, LDS_BYTES) != hipSuccess || per_cu < 1) { fprintf(stderr, "kernel_launch: occupancy query reports %d workgroups per CU\n", per_cu); }
        (void)hipGetLastError();
        if (cus % 8 != 0) { fprintf(stderr, "kernel_launch: %d CUs: the row-panel ownership the epilogues rely on needs a grid that is a multiple of 8; nothing launched\n", cus); grid = -1; return; }
        grid = cus;
    }
    if (grid < 0) return;
    if (hipMemsetAsync((char*)d_ws + WS_CTL, 0, CTL_ZERO_BYTES, stream) != hipSuccess) { fprintf(stderr, "kernel_launch: memset failed\n"); return; }
    Ptrs a{};
    a.x = (const float*)d_in[0]; a.pos = (const int*)d_in[1]; a.g_mix_pre = (const float*)d_in[2]; a.g_mix_post = (const float*)d_in[3]; a.g_ffn_pre = (const float*)d_in[4]; a.g_ffn_post = (const float*)d_in[5];
    a.w_in = (const float*)d_in[6]; a.g_q_lora = (const float*)d_in[7]; a.w_uq = (const float*)d_in[8]; a.g_kv_lora = (const float*)d_in[9]; a.w_ukv = (const float*)d_in[10]; a.b_forget = (const float*)d_in[11];
    a.swa_sinks = (const float*)d_in[12]; a.w_branch = (const float*)d_in[13]; a.w_out = (const float*)d_in[14]; a.w_gate_up = (const float*)d_in[15]; a.w_down = (const float*)d_in[16];
    a.out = (float*)d_out; a.ws = (unsigned char*)d_ws;
#if MK_PER_PHASE
    for (int k = 0; k < N_PHASES; ++k) { a.ph_lo = k; a.ph_hi = k + 1; hipLaunchKernelGGL(fwd_kernel, dim3(grid), dim3(NWAVES * 64), LDS_BYTES, stream, a); }
#else
    a.ph_lo = 0; a.ph_hi = N_PHASES; hipLaunchKernelGGL(fwd_kernel, dim3(grid), dim3(NWAVES * 64), LDS_BYTES, stream, a);
#endif
    const hipError_t le = hipPeekAtLastError();
    if (le != hipSuccess) fprintf(stderr, "kernel_launch: launch failed: %s\n", hipGetErrorName(le));
}
```
